# Optimizing an MI355X kernel written in HIP

```python
import math
import jax, jax.numpy as jnp
from jax import lax
import numpy as np

D_MODEL = 1024
BATCH = 2
SEQ = 8192
DEPTH = 1

GRID_W = 64
CTX_LEN = 256
EPS = 1e-6
M_HEADS = 4
M_HEAD_DIM = 256
M_WIDTH = M_HEADS * M_HEAD_DIM
M_CHUNK = 64
H_WIDTH = 1024
H_POS_BANDS = 16
H_POS_DIM = 1 + 2 * H_POS_BANDS
H_FILTER_HIDDEN = 64
H_FAST_DECAY_PCT = 0.3
H_SLOW_DECAY_PCT = 1.5
H_DECAY_TARGET = 1e-2
SHORT_CONV = 3
N_GROUPS = 8
EXPERTS_PER_GROUP = 8
N_EXPERTS = N_GROUPS * EXPERTS_PER_GROUP
TOP_K_IN_GROUP = 2
D_EXPERT = 512
MOE_BLOCK = 128
Q0 = 0
K0 = Q0 + M_WIDTH
V0 = K0 + M_WIDTH
O0 = V0 + M_WIDTH
IG0 = O0 + M_WIDTH
FG0 = IG0 + 2 * M_HEADS
M_COLS = FG0 + 2 * M_HEADS
HY0 = M_COLS
GA0 = HY0 + 3 * H_WIDTH
GB0 = GA0 + D_MODEL
IN_COLS = GB0 + D_MODEL

kernel_name = 'hybrid_mlstm_hyena_hmoe_dit_block'


def rmsnorm(x, g):
    xf = x.astype(jnp.float32)
    y = xf * lax.rsqrt(jnp.mean(xf * xf, axis=-1, keepdims=True) + EPS)
    return (y * g.astype(jnp.float32)).astype(x.dtype)


def adaln(cond, w_mod, b_mod):
    m = jax.nn.silu(cond) @ w_mod + b_mod
    return m.reshape(*cond.shape[:-1], 6, D_MODEL)


def modulate(x, g, mod, i):
    return rmsnorm(x, g) * (1 + mod[..., i + 1, :]) + mod[..., i, :]


def short_conv(u, w, b, rows):
    bsz, L, ch = u.shape
    u4 = u.reshape(bsz, rows, L // rows, ch)
    up = jnp.pad(u4, ((0, 0), (0, 0), (1, 1), (0, 0)))
    y = up[:, :, :-2] * w[0] + up[:, :, 1:-1] * w[1] + up[:, :, 2:] * w[2] + b
    return y.reshape(bsz, L, ch)


def mlstm_chunkwise(q, k, v, ig, lf, c0, n0, m0):
    bsz, grp, L, dh = q.shape
    nc = L // M_CHUNK

    def chunks(t):
        return jnp.moveaxis(t.reshape(bsz, grp, nc, M_CHUNK, *t.shape[3:]), 2, 0)

    tril = jnp.tril(jnp.ones((M_CHUNK, M_CHUNK), bool))

    def step(carry, inp):
        cmat, nvec, m = carry
        qc, kc, vc, ic, fc = inp
        b = jnp.cumsum(fc, axis=-1)
        dmat = jnp.where(tril, b[..., :, None] - b[..., None, :] + ic[..., None, :], -jnp.inf)
        inter = b + m[..., None]
        m_t = jnp.maximum(inter, jnp.max(dmat, axis=-1))
        s = jnp.einsum('bgtd,bgsd->bgts', qc, kc) * jnp.exp(dmat - m_t[..., None])
        carry_scale = jnp.exp(inter - m_t)
        num = (jnp.einsum('bgts,bgse->bgte', s, vc)
               + carry_scale[..., None] * jnp.einsum('bged,bgtd->bgte', cmat, qc))
        den = jnp.sum(s, axis=-1) + carry_scale * jnp.einsum('bgd,bgtd->bgt', nvec, qc)
        h = num / jnp.maximum(jnp.abs(den), jnp.exp(-m_t))[..., None]
        b_last = b[..., -1]
        g = b_last[..., None] - b + ic
        m_new = jnp.maximum(b_last + m, jnp.max(g, axis=-1))
        wgt = jnp.exp(g - m_new[..., None])
        decay = jnp.exp(b_last + m - m_new)
        c_new = decay[..., None, None] * cmat + jnp.einsum('bgs,bgse,bgsd->bged', wgt, vc, kc)
        n_new = decay[..., None] * nvec + jnp.einsum('bgs,bgsd->bgd', wgt, kc)
        return (c_new, n_new, m_new), h

    (cf, nf, mf), hs = lax.scan(step, (c0, n0, m0),
                                (chunks(q), chunks(k), chunks(v), chunks(ig), chunks(lf)))
    h = jnp.moveaxis(hs, 0, 2).reshape(bsz, grp, L, dh)
    return h, (cf, nf, mf)


def mlstm_branch(z, w_conv, b_conv, rows, state):
    bsz, L, _ = z.shape
    f32 = jnp.float32
    qk = jax.nn.silu(short_conv(z[..., Q0:V0], w_conv, b_conv, rows))
    q = qk[..., :M_WIDTH]
    k = qk[..., M_WIDTH:] * (M_HEAD_DIM ** -0.5)
    v = z[..., V0:O0]
    o = jax.nn.sigmoid(z[..., O0:IG0])
    ig = z[..., IG0:FG0]
    lf = jax.nn.log_sigmoid(z[..., FG0:M_COLS].astype(f32))

    def heads_dirs(t):
        t = t.astype(f32).reshape(bsz, L, M_HEADS, M_HEAD_DIM)
        t = jnp.stack([t, t[:, ::-1]], axis=1)
        return t.transpose(0, 1, 3, 2, 4).reshape(bsz, 2 * M_HEADS, L, M_HEAD_DIM)

    def gates_dirs(g):
        g = g.astype(f32).reshape(bsz, L, 2, M_HEADS)
        g = jnp.stack([g[:, :, 0], g[:, ::-1, 1]], axis=1)
        return g.transpose(0, 1, 3, 2).reshape(bsz, 2 * M_HEADS, L)

    h, state_out = mlstm_chunkwise(heads_dirs(q), heads_dirs(k), heads_dirs(v),
                                   gates_dirs(ig), gates_dirs(lf), *state)
    h = h.reshape(bsz, 2, M_HEADS, L, M_HEAD_DIM)
    h = h[:, 0] + h[:, 1, :, ::-1]
    h = h.transpose(0, 2, 1, 3).reshape(bsz, L, M_WIDTH)
    return o * h.astype(z.dtype), state_out


def hyena_filter(L, w1, b1, w2, b2, w3, freq):
    f32 = jnp.float32
    pos = jnp.arange(L, dtype=f32)
    t = (pos / max(L - 1, 1))[:, None]
    bands = jnp.linspace(1e-4, H_POS_BANDS - 1, H_POS_BANDS, dtype=f32)
    ang = (2 * math.pi / L) * pos[:, None] * bands[None]
    feats = jnp.concatenate([t, jnp.cos(ang), -jnp.sin(ang)], axis=-1)
    freq = freq.astype(f32)
    hid = jnp.sin(freq * (feats @ w1.astype(f32) + b1.astype(f32)))
    hid = jnp.sin(freq * (hid @ w2.astype(f32) + b2.astype(f32)))
    filt = hid @ w3.astype(f32)
    max_decay = math.log(H_DECAY_TARGET) / H_FAST_DECAY_PCT
    min_decay = math.log(H_DECAY_TARGET) / H_SLOW_DECAY_PCT
    deltas = jnp.linspace(min_decay, max_decay, H_WIDTH, dtype=f32)
    window = jnp.exp(-t * jnp.abs(deltas)[None])
    fwd = filt[:, :H_WIDTH] * window
    bwd = filt[:, H_WIDTH:] * window
    kern = jnp.concatenate([fwd, jnp.zeros((1, H_WIDTH), f32), bwd[:0:-1]], axis=0)
    return kern * lax.rsqrt(jnp.sum(kern * kern, axis=0, keepdims=True) + EPS)


def hyena_branch(z, w_conv, b_conv, f_w1, f_b1, f_w2, f_b2, f_w3, f_freq, h_bias, rows):
    bsz, L, _ = z.shape
    u = short_conv(z[..., HY0:GA0], w_conv, b_conv, rows)
    x0 = u[..., :H_WIDTH]
    x1 = u[..., H_WIDTH:2 * H_WIDTH]
    v = u[..., 2 * H_WIDTH:]
    s = (x1 * v).astype(jnp.float32)
    kern = hyena_filter(L, f_w1, f_b1, f_w2, f_b2, f_w3, f_freq)
    n_fft = 2 * L
    y = jnp.fft.irfft(jnp.fft.rfft(s, n=n_fft, axis=1) * jnp.fft.rfft(kern, n=n_fft, axis=0)[None],
                      n=n_fft, axis=1)[:, :L]
    y = y + h_bias.astype(jnp.float32) * s
    return x0 * y.astype(z.dtype)


def merge_branches(z, a, hy, w_a, w_b, w_out):
    ga = jax.nn.sigmoid(z[..., GA0:GB0])
    gb = jax.nn.sigmoid(z[..., GB0:IN_COLS])
    return (ga * (a @ w_a) + gb * (hy @ w_b)) @ w_out


def hier_moe(h, w_group, b_group, w_router, b_router, w1_e, w3_e, w2_e):
    bsz, L, d = h.shape
    n_tok = bsz * L
    xt = h.reshape(n_tok, d)
    f32 = jnp.float32
    glog = (xt @ w_group).astype(f32) + b_group.astype(f32)
    gprob = jax.nn.softmax(glog, axis=-1)
    gsel = jnp.argmax(glog, axis=-1)
    gw = jnp.take_along_axis(gprob, gsel[:, None], axis=1)
    elog = ((xt @ w_router).astype(f32) + b_router.astype(f32)).reshape(n_tok, N_GROUPS, EXPERTS_PER_GROUP)
    elog = jnp.take_along_axis(elog, gsel[:, None, None], axis=1)[:, 0]
    eprob = jax.nn.softmax(elog, axis=-1)
    topv, topi = lax.top_k(eprob, TOP_K_IN_GROUP)
    weights = gw * topv / jnp.sum(topv, axis=-1, keepdims=True)
    experts = gsel[:, None].astype(jnp.int32) * EXPERTS_PER_GROUP + topi.astype(jnp.int32)

    n_assign = n_tok * TOP_K_IN_GROUP
    e_flat = experts.reshape(n_assign)
    w_flat = weights.reshape(n_assign)
    tok = jnp.repeat(jnp.arange(n_tok, dtype=jnp.int32), TOP_K_IN_GROUP)
    order = jnp.argsort(e_flat)
    e_s, tok_s, w_s = e_flat[order], tok[order], w_flat[order]
    counts = jax.ops.segment_sum(jnp.ones_like(e_flat), e_flat, num_segments=N_EXPERTS)
    starts = jnp.cumsum(counts) - counts
    padded = ((counts + MOE_BLOCK - 1) // MOE_BLOCK) * MOE_BLOCK
    pend = jnp.cumsum(padded)
    pstart = pend - padded
    dest = pstart[e_s] + jnp.arange(n_assign, dtype=jnp.int32) - starts[e_s]
    n_blocks = -(-n_assign // MOE_BLOCK) + N_EXPERTS
    n_slots = n_blocks * MOE_BLOCK
    slot_tok = jnp.zeros((n_slots,), jnp.int32).at[dest].set(tok_s)
    slot_w = jnp.zeros((n_slots,), f32).at[dest].set(w_s)
    block_e = jnp.clip(jnp.searchsorted(pend, jnp.arange(n_blocks, dtype=jnp.int32) * MOE_BLOCK,
                                        side='right'), 0, N_EXPERTS - 1)
    xs = xt[slot_tok].reshape(n_blocks, MOE_BLOCK, d)

    def expert_block(args):
        xb, e = args
        return (jax.nn.silu(xb @ w1_e[e]) * (xb @ w3_e[e])) @ w2_e[e]

    ys = lax.map(expert_block, (xs, block_e)).reshape(n_slots, d)
    y = jnp.zeros((n_tok, d), f32).at[slot_tok].add(ys.astype(f32) * slot_w[:, None])
    return y.astype(h.dtype).reshape(bsz, L, d)


def trunk_layer(x, xc, rows, c, c_ctx, w_mod, b_mod, g_norm1, g_norm2, w_in, b_in, w_qk_conv, b_qk_conv,
                w_h_conv, b_h_conv, hf_w1, hf_b1, hf_w2, hf_b2, hf_w3, hf_freq, h_bias, w_a, w_b, w_out,
                w_group, b_group, w_router, b_router, w1_e, w3_e, w2_e, last):
    mod = adaln(c, w_mod, b_mod)[:, None]
    modc = adaln(c_ctx, w_mod, b_mod)[None, None]
    bsz = xc.shape[0]
    f32 = jnp.float32
    hc = modulate(xc, g_norm1, modc, 0)
    cols = M_COLS if last else IN_COLS
    zc = hc @ w_in[:, :cols] + b_in[:cols]
    zero_state = (jnp.zeros((bsz, 2 * M_HEADS, M_HEAD_DIM, M_HEAD_DIM), f32),
                  jnp.zeros((bsz, 2 * M_HEADS, M_HEAD_DIM), f32),
                  jnp.zeros((bsz, 2 * M_HEADS), f32))
    ac, ctx_state = mlstm_branch(zc, w_qk_conv, b_qk_conv, 1, zero_state)
    h = modulate(x, g_norm1, mod, 0)
    z = h @ w_in + b_in
    a, _ = mlstm_branch(z, w_qk_conv, b_qk_conv, rows, ctx_state)
    hy = hyena_branch(z, w_h_conv, b_h_conv, hf_w1, hf_b1, hf_w2, hf_b2, hf_w3, hf_freq, h_bias, rows)
    x = x + mod[..., 2, :] * merge_branches(z, a, hy, w_a, w_b, w_out)
    h2 = modulate(x, g_norm2, mod, 3)
    x = x + mod[..., 5, :] * hier_moe(h2, w_group, b_group, w_router, b_router, w1_e, w3_e, w2_e)
    if not last:
        hyc = hyena_branch(zc, w_h_conv, b_h_conv, hf_w1, hf_b1, hf_w2, hf_b2, hf_w3, hf_freq, h_bias, 1)
        xc = xc + modc[..., 2, :] * merge_branches(zc, ac, hyc, w_a, w_b, w_out)
        hc2 = modulate(xc, g_norm2, modc, 3)
        xc = xc + modc[..., 5, :] * hier_moe(hc2, w_group, b_group, w_router, b_router, w1_e, w3_e, w2_e)
    return x, xc


def setup_inputs(seed: int = 0) -> dict:
    key = jax.random.key(seed)
    ks = jax.random.split(key, 40)

    def nrm(k, shape, s):
        return jax.random.normal(k, shape, jnp.float32) * s

    forget_bias = jnp.tile(jnp.linspace(3.0, 6.0, M_HEADS, dtype=jnp.float32), 2)
    return {
        'x': nrm(ks[0], (BATCH, SEQ, D_MODEL), 1.0),
        'c': nrm(ks[1], (BATCH, D_MODEL), 1.0),
        'ctx': nrm(ks[2], (BATCH, CTX_LEN, D_MODEL), 1.0),
        'c_ctx': nrm(ks[3], (D_MODEL,), 1.0),
        'w_mod': nrm(ks[4], (DEPTH, D_MODEL, 6 * D_MODEL), 0.5 * D_MODEL ** -0.5),
        'b_mod': nrm(ks[5], (DEPTH, 6 * D_MODEL), 0.02),
        'g_norm1': 1.0 + nrm(ks[6], (DEPTH, D_MODEL), 0.02),
        'g_norm2': 1.0 + nrm(ks[7], (DEPTH, D_MODEL), 0.02),
        'w_in': nrm(ks[8], (DEPTH, D_MODEL, IN_COLS), D_MODEL ** -0.5),
        'b_in': nrm(ks[9], (DEPTH, IN_COLS), 0.02).at[:, FG0:M_COLS].add(forget_bias),
        'w_qk_conv': nrm(ks[10], (DEPTH, SHORT_CONV, 2 * M_WIDTH), SHORT_CONV ** -0.5),
        'b_qk_conv': nrm(ks[11], (DEPTH, 2 * M_WIDTH), 0.02),
        'w_h_conv': nrm(ks[12], (DEPTH, SHORT_CONV, 3 * H_WIDTH), SHORT_CONV ** -0.5),
        'b_h_conv': nrm(ks[13], (DEPTH, 3 * H_WIDTH), 0.02),
        'hf_w1': nrm(ks[14], (DEPTH, H_POS_DIM, H_FILTER_HIDDEN), H_POS_DIM ** -0.5),
        'hf_b1': nrm(ks[15], (DEPTH, H_FILTER_HIDDEN), 0.1),
        'hf_w2': nrm(ks[16], (DEPTH, H_FILTER_HIDDEN, H_FILTER_HIDDEN), H_FILTER_HIDDEN ** -0.5),
        'hf_b2': nrm(ks[17], (DEPTH, H_FILTER_HIDDEN), 0.1),
        'hf_w3': nrm(ks[18], (DEPTH, H_FILTER_HIDDEN, 2 * H_WIDTH), H_FILTER_HIDDEN ** -0.5),
        'hf_freq': 1.0 + nrm(ks[19], (DEPTH, H_FILTER_HIDDEN), 0.02),
        'h_bias': nrm(ks[20], (DEPTH, H_WIDTH), 1.0),
        'w_a': nrm(ks[21], (DEPTH, M_WIDTH, D_MODEL), M_WIDTH ** -0.5),
        'w_b': nrm(ks[22], (DEPTH, H_WIDTH, D_MODEL), H_WIDTH ** -0.5),
        'w_out': nrm(ks[23], (DEPTH, D_MODEL, D_MODEL), D_MODEL ** -0.5),
        'w_group': nrm(ks[24], (DEPTH, D_MODEL, N_GROUPS), D_MODEL ** -0.5),
        'b_group': nrm(ks[25], (DEPTH, N_GROUPS), 0.01),
        'w_router': nrm(ks[26], (DEPTH, D_MODEL, N_EXPERTS), D_MODEL ** -0.5),
        'b_router': nrm(ks[27], (DEPTH, N_EXPERTS), 0.01),
        'w1_e': nrm(ks[28], (DEPTH, N_EXPERTS, D_MODEL, D_EXPERT), D_MODEL ** -0.5),
        'w3_e': nrm(ks[29], (DEPTH, N_EXPERTS, D_MODEL, D_EXPERT), D_MODEL ** -0.5),
        'w2_e': nrm(ks[30], (DEPTH, N_EXPERTS, D_EXPERT, D_MODEL), D_EXPERT ** -0.5),
        'g_final': 1.0 + nrm(ks[31], (D_MODEL,), 0.02),
    }


def reference(x, c, ctx, c_ctx, w_mod, b_mod, g_norm1, g_norm2, w_in, b_in, w_qk_conv, b_qk_conv,
              w_h_conv, b_h_conv, hf_w1, hf_b1, hf_w2, hf_b2, hf_w3, hf_freq, h_bias, w_a, w_b, w_out,
              w_group, b_group, w_router, b_router, w1_e, w3_e, w2_e, g_final):
    rows = x.shape[1] // GRID_W
    xc = ctx
    for l in range(DEPTH):
        x, xc = trunk_layer(x, xc, rows, c, c_ctx, w_mod[l], b_mod[l], g_norm1[l], g_norm2[l], w_in[l],
                            b_in[l], w_qk_conv[l], b_qk_conv[l], w_h_conv[l], b_h_conv[l], hf_w1[l],
                            hf_b1[l], hf_w2[l], hf_b2[l], hf_w3[l], hf_freq[l], h_bias[l], w_a[l], w_b[l],
                            w_out[l], w_group[l], b_group[l], w_router[l], b_router[l], w1_e[l], w3_e[l],
                            w2_e[l], l == DEPTH - 1)
    return rmsnorm(x, g_final)
```

```cpp
#include <hip/hip_runtime.h>
#include <cstdio>
#include <cstdint>

#define LAS __attribute__((address_space(3)))
#define GAS __attribute__((address_space(1)))
typedef unsigned short bf16_t;
typedef short bf16x8 __attribute__((ext_vector_type(8)));
typedef short s16x4 __attribute__((ext_vector_type(4)));
typedef float f32x4 __attribute__((ext_vector_type(4)));
typedef float f32x2 __attribute__((ext_vector_type(2)));
typedef unsigned u32x4 __attribute__((ext_vector_type(4)));
typedef unsigned u32x2 __attribute__((ext_vector_type(2)));
typedef GAS unsigned gu32;

constexpr int D = 1024, BATCH = 2, SEQ = 8192, CTXL = 256;
constexpr int M_LAT = BATCH * SEQ, M_CTX = BATCH * CTXL, M_ALL = M_LAT + M_CTX;
constexpr int IN_COLS = 9232, IG0 = 4096, HY0 = 4112, GA0 = 7184, GB0 = 8208;
constexpr int ZC = 9216;
constexpr int ZC_X0 = 4096, ZC_PAIR = 5120, ZC_GA = 7168, ZC_GB = 8192;
constexpr int N_IN = 9472;
constexpr int NEXP = 64, DEXP = 512;
constexpr float EPS = 1e-6f;
constexpr int MAX_TILES = 192, MAX_SLOTS = MAX_TILES * 256;

constexpr size_t MiB = 1u << 20;
constexpr size_t WS_CTL = 0, CTL_ZERO_BYTES = 1 * MiB;
constexpr size_t WS_MODS = 1 * MiB;
constexpr size_t WS_BIASP = WS_MODS + 81920;
constexpr size_t WS_CST = WS_MODS + 122880;
constexpr size_t WS_RSTD2 = WS_MODS + 131072;
constexpr size_t WS_ROUTE = WS_MODS + 262144;
constexpr size_t WS_TOKSLOT = WS_MODS + 524288;
constexpr size_t WS_WR72 = WS_MODS + 720896;
constexpr size_t WS_GATES = 2 * MiB;
constexpr size_t WS_HID2 = 4 * MiB;
constexpr size_t WS_WIN_T = 8 * MiB;
constexpr size_t WS_WA2_T = 27 * MiB;
constexpr size_t WS_WB_T = 31 * MiB;
constexpr size_t WS_WOUT_T = 33 * MiB;
constexpr size_t WS_H = 36 * MiB;
constexpr size_t WS_FSPEC = 70 * MiB;
constexpr int FS_PITCH = 8200;
constexpr size_t WS_SCM = 136 * MiB;
constexpr size_t WS_Z = 168 * MiB;
constexpr size_t WS_W13T = 168 * MiB;
constexpr size_t WS_W2T = 296 * MiB;
constexpr size_t WS_XS = 360 * MiB;
constexpr size_t WS_END = 465 * MiB;
static_assert(WS_Z + (size_t)M_ALL * ZC * 2 <= WS_END && WS_XS + (size_t)MAX_SLOTS * 1024 * 2 <= WS_END, "ws map");
static_assert(WS_FSPEC + (size_t)1024 * FS_PITCH * 8 <= WS_SCM && WS_H + (size_t)M_ALL * D * 2 <= WS_FSPEC, "ws map");
constexpr int CW_BAR = 4096;
constexpr int CW_CNT = 16384, CW_CUR = 16384 + 64;

constexpr int LDS_BYTES = 160 * 1024;
constexpr int MISC_OFF = 159 * 1024;

#define RLX_AGENT __ATOMIC_RELAXED, __HIP_MEMORY_SCOPE_AGENT
__device__ __forceinline__ unsigned f2bf(float f) { unsigned u = __builtin_bit_cast(unsigned, f); return (u + 0x7fffu + ((u >> 16) & 1u)) >> 16; }
__device__ __forceinline__ unsigned pk2(float lo, float hi) { return f2bf(lo) | (f2bf(hi) << 16); }
__device__ __forceinline__ float bf2f(unsigned short u) { return __builtin_bit_cast(float, (unsigned)u << 16); }
__device__ __forceinline__ float bflo(unsigned w) { return __builtin_bit_cast(float, w << 16); }
__device__ __forceinline__ float bfhi(unsigned w) { return __builtin_bit_cast(float, w & 0xffff0000u); }
__device__ __forceinline__ float sigmoidf_(float x) { return 1.0f / (1.0f + __expf(-x)); }
__device__ __forceinline__ float siluf_(float x) { return x / (1.0f + __expf(-x)); }
__device__ __forceinline__ float wave_sum(float v) {
#pragma unroll
    for (int o = 1; o < 64; o <<= 1) v += __shfl_xor(v, o);
    return v;
}

namespace pg8 {
#define PG8_LAS __attribute__((address_space(3)))
constexpr int BM = 256, BK = 64, HALF = 128, HTB = HALF * BK * 2, STAGE_BYTES = 8 * HTB, NXCD = 8, WGM = 8;
__host__ __device__ __forceinline__ int lds_byte(int r, int c) { const int st = (r >> 4) * 2 + (c >> 5), rr = r & 15, cc = c & 31, ob = rr * 64 + cc * 2; return st * 1024 + (ob ^ (((ob >> 9) & 1) << 5)); }
__host__ __device__ __forceinline__ void stage_rc(int b, int& R, int& C) { const int st = b / 1024, sb = b % 1024, swz = sb ^ (((sb >> 9) & 1) << 5); R = (st >> 1) * 16 + swz / 64; C = (st & 1) * 32 + (swz % 64) / 2; }
__host__ __device__ __forceinline__ int perm32(int rho) { const int n = rho >> 4, i = rho & 15; return 8 * (i >> 2) + 4 * n + (i & 3); }

struct Unit { long aoff, boff; int pm, pn, e, pad; };
struct Gemm { const bf16_t* A; const bf16_t* Bt; int lda, ldb, K; };

struct StaticOrder {
    int nM, nN, nwg, G, c; long astep, bstep;
    __device__ void init(int nM_, int nN_, int G_, int c_, long astep_, long bstep_) { nM = nM_; nN = nN_; nwg = nM * nN; G = G_; c = c_; astep = astep_; bstep = bstep_; }
    __device__ bool map(long L, Unit& u) const {
        if (L >= nwg) return false;
        int wgid = (int)L; { const int q = nwg / NXCD, r = nwg % NXCD, xcd = wgid % NXCD, off = wgid / NXCD; wgid = (xcd < r ? xcd * (q + 1) : r * (q + 1) + (xcd - r) * q) + off; }
        const int nig = WGM * nN, gid = wgid / nig, fm = gid * WGM, gsz = (nM - fm) < WGM ? (nM - fm) : WGM;
        u.pm = fm + ((wgid % nig) % gsz); u.pn = (wgid % nig) / gsz; u.e = 0; u.pad = 0; u.aoff = u.pm * astep; u.boff = u.pn * bstep; return true;
    }
    __device__ bool next(int i, Unit& u) const { return map((long)i * G + c, u); }
};

typedef __bf16 bf16v2_t __attribute__((ext_vector_type(2)));
__device__ __forceinline__ unsigned cvt_pk_bf16(float lo, float hi) { const bf16v2_t v = __builtin_convertvector((f32x2){lo, hi}, bf16v2_t); return __builtin_bit_cast(unsigned, v); }

template <class Epi, class Sched, bool ALIGN_EPI>
__device__ __forceinline__ void gemm_phase(PG8_LAS unsigned char* lds, const Gemm g, const Sched& S, const Epi& E) {
    const int tid = threadIdx.x, wid = __builtin_amdgcn_readfirstlane(tid >> 6), lane = tid & 63, wr = wid >> 2, wc = wid & 3, fr = lane & 15, fq = lane >> 4;
    const int K = g.K, nt = K / BK;
    unsigned voffA[2], voffB[2];
#pragma unroll
    for (int i = 0; i < 2; ++i) { int R, C; stage_rc(tid * 16 + i * 8192, R, C); const int Rb = Epi::PERM ? ((R & ~31) + perm32(R & 31)) : R;
        voffA[i] = (unsigned)(R * g.lda + C) * 2u; voffB[i] = (unsigned)(Rb * g.ldb + C) * 2u; }
    const size_t kstep = (size_t)(BK * 2);
    const size_t hstepA = (size_t)HALF * g.lda * 2, hstepB = (size_t)HALF * g.ldb * 2;
    const unsigned ldsw = (unsigned)wid * 1024u;
    const int aoff = lds_byte(wr * 64 + fr, fq * 8), boff = lds_byte(wc * 32 + fr, fq * 8);
#define PG8_SA(b, h) (((b) * 2 + (h)) * HTB)
#define PG8_SB(b, h) ((4 + (b) * 2 + (h)) * HTB)
#define PG8_STAGE(bufoff, gbase, voff) do { _Pragma("unroll") for (int _i = 0; _i < 2; ++_i) \
        __builtin_amdgcn_global_load_lds((const unsigned*)((const char*)(gbase) + (voff)[_i]), (PG8_LAS unsigned*)(lds + (bufoff) + ldsw + _i * 8192), 16, 0, 0); } while (0)
#define PG8_LDA(dst, b, h) do { _Pragma("unroll") for (int m = 0; m < 4; ++m) _Pragma("unroll") for (int k = 0; k < 2; ++k) dst[m][k] = *(const PG8_LAS bf16x8*)(lds + PG8_SA(b, h) + aoff + m * 2048 + k * 1024); } while (0)
#define PG8_LDB(dst, b, h) do { _Pragma("unroll") for (int n = 0; n < 2; ++n) _Pragma("unroll") for (int k = 0; k < 2; ++k) dst[n][k] = *(const PG8_LAS bf16x8*)(lds + PG8_SB(b, h) + boff + n * 2048 + k * 1024); } while (0)
#define PG8_MMA(ai, bj, At, Bt) do { __builtin_amdgcn_s_setprio(1); _Pragma("unroll") for (int m = 0; m < 4; ++m) _Pragma("unroll") for (int n = 0; n < 2; ++n) _Pragma("unroll") for (int k = 0; k < 2; ++k) \
        acc[ai][bj][m][n] = __builtin_amdgcn_mfma_f32_16x16x32_bf16(Bt[n][k], At[m][k], acc[ai][bj][m][n], 0, 0, 0); __builtin_amdgcn_s_setprio(0); } while (0)
#define PG8_WAIT_V(n) asm volatile("s_waitcnt vmcnt(" #n ")" ::: "memory")
#define PG8_WAIT_L(n) asm volatile("s_waitcnt lgkmcnt(" #n ")" ::: "memory")
#define PG8_BAR __builtin_amdgcn_s_barrier()
#define PG8_SCHED __builtin_amdgcn_sched_barrier(0)
    Unit cur, nxt; int ui = 0;
    if (!S.next(0, cur)) return;
    f32x4 acc[2][2][4][2];
#pragma unroll
    for (int a = 0; a < 2; ++a)
#pragma unroll
        for (int b = 0; b < 2; ++b)
#pragma unroll
            for (int m = 0; m < 4; ++m)
#pragma unroll
                for (int n = 0; n < 2; ++n) acc[a][b][m][n] = (f32x4){0.f, 0.f, 0.f, 0.f};
    bf16x8 At[4][2], B0[2][2], B1[2][2];
    const char* cA = (const char*)g.A + cur.aoff; const char* cB = (const char*)g.Bt + cur.boff;
    PG8_STAGE(PG8_SB(0, 0), cB, voffB); PG8_STAGE(PG8_SB(0, 1), cB + hstepB, voffB); PG8_STAGE(PG8_SA(0, 0), cA, voffA); PG8_STAGE(PG8_SA(0, 1), cA + hstepA, voffA);
    if (wr == 1) PG8_BAR;
    PG8_WAIT_V(2); PG8_BAR;
    PG8_STAGE(PG8_SB(1, 0), cB + kstep, voffB); PG8_STAGE(PG8_SA(1, 0), cA + kstep, voffA); PG8_STAGE(PG8_SB(1, 1), cB + hstepB + kstep, voffB);
    PG8_WAIT_V(6); PG8_BAR;
    for (;;) {
        const bool has_next = S.next(ui + 1, nxt);
        const char* nA = has_next ? (const char*)g.A + nxt.aoff : cA; const char* nB = has_next ? (const char*)g.Bt + nxt.boff : cB;
        for (int t = 0; t < nt; t += 2) {
            const bool last = (t == nt - 2);
            const char* a1 = cA + (size_t)(t + 1) * kstep;
            const char* a2 = last ? nA : cA + (size_t)(t + 2) * kstep; const char* b2 = last ? nB : cB + (size_t)(t + 2) * kstep;
            const char* a3 = a2 + kstep; const char* b3 = b2 + kstep;
            PG8_LDB(B0, 0, 0); PG8_LDB(B1, 0, 1); PG8_SCHED; PG8_LDA(At, 0, 0); PG8_STAGE(PG8_SA(1, 1), a1 + hstepA, voffA);
            PG8_WAIT_V(8); PG8_WAIT_L(0); PG8_BAR; PG8_MMA(0, 0, At, B0); PG8_MMA(0, 1, At, B1); PG8_BAR; PG8_SCHED;
            PG8_LDA(At, 0, 1); PG8_STAGE(PG8_SB(0, 0), b2, voffB); PG8_STAGE(PG8_SB(0, 1), b2 + hstepB, voffB); PG8_STAGE(PG8_SA(0, 0), a2, voffA);
            PG8_WAIT_V(8); PG8_WAIT_L(0); PG8_BAR; PG8_MMA(1, 0, At, B0); PG8_MMA(1, 1, At, B1); PG8_BAR; PG8_SCHED;
            PG8_LDB(B0, 1, 0); PG8_LDB(B1, 1, 1); PG8_SCHED; PG8_LDA(At, 1, 0); PG8_STAGE(PG8_SA(0, 1), a2 + hstepA, voffA);
            PG8_WAIT_V(8); PG8_WAIT_L(0); PG8_BAR; PG8_MMA(0, 0, At, B0); PG8_MMA(0, 1, At, B1); PG8_BAR; PG8_SCHED;
            PG8_LDA(At, 1, 1); PG8_STAGE(PG8_SB(1, 0), b3, voffB); PG8_STAGE(PG8_SB(1, 1), b3 + hstepB, voffB); PG8_STAGE(PG8_SA(1, 0), a3, voffA);
            PG8_WAIT_V(8); PG8_WAIT_L(0); PG8_BAR; PG8_MMA(1, 0, At, B0); PG8_MMA(1, 1, At, B1); PG8_BAR; PG8_SCHED;
        }
        if constexpr (ALIGN_EPI) { if (wr == 0) PG8_BAR; }
        E(acc, cur, wr, wc, fr, fq);
        if (!has_next) break;
#pragma unroll
        for (int a = 0; a < 2; ++a)
#pragma unroll
            for (int b = 0; b < 2; ++b)
#pragma unroll
                for (int m = 0; m < 4; ++m)
#pragma unroll
                    for (int n = 0; n < 2; ++n) acc[a][b][m][n] = (f32x4){0.f, 0.f, 0.f, 0.f};
        cur = nxt; cA = nA; cB = nB; ++ui;
        if constexpr (ALIGN_EPI) { if (wr == 1) PG8_BAR; }
    }
    PG8_WAIT_V(0);
    if constexpr (!ALIGN_EPI) { if (wr == 0) PG8_BAR; }
    PG8_BAR;
#undef PG8_SA
#undef PG8_SB
#undef PG8_STAGE
#undef PG8_LDA
#undef PG8_LDB
#undef PG8_MMA
#undef PG8_WAIT_V
#undef PG8_WAIT_L
#undef PG8_BAR
#undef PG8_SCHED
}
}

#define XB_TMO      128
#define XB_XCNT(j)  (256  + 64 * (j))
#define XB_XSUB(j)  (1280 + 64 * (j))
#define XB_XGEN(j)  (2304 + 64 * (j))
#define XB_TOP      3328
#define XB_TOPGEN   3392
#define XCD_BAR_WORDS 3456
#define XB_SPIN_CAP (1u << 18)
__device__ __forceinline__ unsigned xb_ld(unsigned* p)              { return __hip_atomic_load(p, __ATOMIC_RELAXED, __HIP_MEMORY_SCOPE_AGENT); }
__device__ __forceinline__ unsigned xb_add(unsigned* p, unsigned v) { return __hip_atomic_fetch_add(p, v, __ATOMIC_RELAXED, __HIP_MEMORY_SCOPE_AGENT); }
__device__ __forceinline__ unsigned xb_xcc_id() { return (unsigned)__builtin_amdgcn_s_getreg((3 << 11) | 20) & 0xFu; }
#define XB_SPIN(cond, bar) do { unsigned _sp = 0; while (cond) { __builtin_amdgcn_s_sleep(1); \
    if ((++_sp & 255u) == 0u) { if (xb_ld(&(bar)[XB_TMO])) break; if (_sp > XB_SPIN_CAP) { atomicAdd(&(bar)[XB_TMO], 1u); break; } } } } while (0)
struct XcdBarrier { unsigned* bar; unsigned x; volatile LAS unsigned* st; };
__device__ __forceinline__ XcdBarrier xcd_barrier_post(unsigned* bar, volatile LAS unsigned* st) {
    XcdBarrier b; b.bar = bar; b.x = xb_xcc_id(); b.st = st;
    if (threadIdx.x == 0) (void)xb_add(&bar[XB_XCNT(b.x)], 1u);
    return b;
}
__device__ __forceinline__ void xcd_barrier_complete(unsigned* bar, unsigned x, unsigned& nloc, unsigned& nx) {
    const unsigned G = gridDim.x * gridDim.y * gridDim.z;
    unsigned sum, cnt, mine, sp = 0u;
    for (;;) {
        sum = 0u; cnt = 0u; mine = 0u;
#pragma unroll
        for (unsigned j = 0; j < 16; ++j) { const unsigned c = xb_ld(&bar[XB_XCNT(j)]); sum += c; cnt += (c > 0u) ? 1u : 0u; mine = (j == x) ? c : mine; }
        if (sum == G) break;
        __builtin_amdgcn_s_sleep(1);
        if ((++sp & 255u) == 0u) { if (xb_ld(&bar[XB_TMO])) break; if (sp > XB_SPIN_CAP) { atomicAdd(&bar[XB_TMO], 1u); break; } }
    }
    nloc = mine > 0u ? mine : 1u; nx = cnt > 0u ? cnt : 1u;
}
__device__ __forceinline__ void xcd_barrier(const XcdBarrier& b) {
    asm volatile("s_waitcnt vmcnt(0)" ::: "memory");
    __syncthreads();
    if (threadIdx.x == 0) {
        unsigned* bar = b.bar;
        __builtin_amdgcn_s_waitcnt(0);
        unsigned nloc = b.st[0], nx = b.st[1];
        if (nloc == 0u) { xcd_barrier_complete(bar, b.x, nloc, nx); b.st[0] = nloc; b.st[1] = nx; }
        const unsigned old = xb_add(&bar[XB_XSUB(b.x)], 1u);
        const unsigned gen = old / nloc;
        if (old + 1u == (gen + 1u) * nloc) {
            __builtin_amdgcn_fence(__ATOMIC_RELEASE, "agent");
            asm volatile("s_waitcnt vmcnt(0)" ::: "memory");
            const unsigned og = xb_add(&bar[XB_TOP], 1u);
            const unsigned tg = og / nx;
            if (og + 1u == (tg + 1u) * nx) xb_add(&bar[XB_TOPGEN], 1u);
            else XB_SPIN(xb_ld(&bar[XB_TOPGEN]) == tg, bar);
            __builtin_amdgcn_fence(__ATOMIC_ACQUIRE, "agent");
            xb_add(&bar[XB_XGEN(b.x)], 1u);
            asm volatile("s_waitcnt vmcnt(0)" ::: "memory");
        } else {
            XB_SPIN(xb_ld(&bar[XB_XGEN(b.x)]) == gen, bar);
            __builtin_amdgcn_fence(__ATOMIC_ACQUIRE, "agent");
            asm volatile("s_waitcnt vmcnt(0)" ::: "memory");
        }
    }
    __syncthreads();
}

struct Inputs {
    const float *x, *c, *ctx, *c_ctx, *w_mod, *b_mod, *g_norm1, *g_norm2, *w_in, *b_in, *w_qk_conv, *b_qk_conv, *w_h_conv, *b_h_conv,
        *hf_w1, *hf_b1, *hf_w2, *hf_b2, *hf_w3, *hf_freq, *h_bias, *w_a, *w_b, *w_out, *w_group, *b_group, *w_router, *b_router, *w1_e, *w3_e, *w2_e, *g_final;
};
struct Args { Inputs in; float* out; unsigned char* ws; int ph_lo, ph_hi; };
struct Frame {
    LAS unsigned char* lds;
    int tid, lane, wave, vcu, G;
    unsigned char* ws;
};
#define WSP(T, off) ((T*)(F.ws + (off)))

__device__ __forceinline__ int win_src(int rho) {
    if (rho < 4096) return rho;
    if (rho < ZC_PAIR) return HY0 + (rho - ZC_X0);
    if (rho < ZC_GA) { const int t = rho - ZC_PAIR, p = t >> 8, bj = (t >> 7) & 1, j = t & 127; return HY0 + 1024 + bj * 1024 + 128 * p + j; }
    if (rho < ZC_GB) return GA0 + (rho - ZC_GA);
    if (rho < ZC) return GB0 + (rho - ZC_GB);
    if (rho < ZC + 16) return IG0 + (rho - ZC);
    return -1;
}
template <class SrcCol>
__device__ __forceinline__ void transpose_item(const float* W, int N, int k0, SrcCol scol, bf16_t* WT, int ldt, int drow0, int kdst, LAS float* scr, int lane) {
    const int sc = scol(lane & 31);
#pragma unroll 8
    for (int i = 0; i < 32; ++i) { const int kk = 2 * i + (lane >> 5); scr[kk * 33 + (lane & 31)] = sc >= 0 ? W[(size_t)(k0 + kk) * N + sc] : 0.f; }
    asm volatile("s_waitcnt lgkmcnt(0)" ::: "memory");
    const int c = lane & 7;
#pragma unroll
    for (int j = 0; j < 4; ++j) { const int n = (lane >> 3) + 8 * j; const LAS float* s = scr + (8 * c) * 33 + n;
        u32x4 o; o.x = pk2(s[0 * 33], s[1 * 33]); o.y = pk2(s[2 * 33], s[3 * 33]); o.z = pk2(s[4 * 33], s[5 * 33]); o.w = pk2(s[6 * 33], s[7 * 33]);
        *(u32x4*)(WT + (size_t)(drow0 + n) * ldt + kdst + 8 * c) = o; }
    asm volatile("s_waitcnt lgkmcnt(0)" ::: "memory");
}

__device__ __forceinline__ void phase0(Frame& F, const Inputs& I) {
    LAS float* scr = (LAS float*)(F.lds + F.wave * 16384);
    const int gw = F.vcu * 8 + F.wave, NGW = F.G * 8;
    {
        constexpr int I_IN = (D / 64) * (N_IN / 32), I_SQ = (D / 64) * (D / 32);
        constexpr int NIT = I_IN + 3 * I_SQ;
        for (int it = gw; it < NIT; it += NGW) {
            int r = it;
            if (r < I_IN) { const int nblk = N_IN / 32, kb = r / nblk, nb = r % nblk;
                transpose_item(I.w_in, IN_COLS, 64 * kb, [&](int i) { return win_src(32 * nb + i); }, WSP(bf16_t, WS_WIN_T), D, 32 * nb, 64 * kb, scr, F.lane); continue; }
            r -= I_IN;
            const int m = r / I_SQ, rr = r % I_SQ, kb = rr / 32, nb = rr % 32;
            if (m == 0) { transpose_item(I.w_a, D, 64 * kb, [&](int i) { return 32 * nb + i; }, WSP(bf16_t, WS_WA2_T), 2 * D, 32 * nb, 64 * kb, scr, F.lane);
                          transpose_item(I.w_a, D, 64 * kb, [&](int i) { return 32 * nb + i; }, WSP(bf16_t, WS_WA2_T), 2 * D, 32 * nb, D + 64 * kb, scr, F.lane); }
            else if (m == 1) transpose_item(I.w_b, D, 64 * kb, [&](int i) { return 32 * nb + i; }, WSP(bf16_t, WS_WB_T), D, 32 * nb, 64 * kb, scr, F.lane);
            else transpose_item(I.w_out, D, 64 * kb, [&](int i) { return 32 * nb + i; }, WSP(bf16_t, WS_WOUT_T), D, 32 * nb, 64 * kb, scr, F.lane);
        }
    }
    __syncthreads();
    {
        LAS float* red = (LAS float*)F.lds;
        float* mods = WSP(float, WS_MODS);
        for (int it = F.vcu; it < 96; it += F.G) {
            const int n = it * 64 + F.lane; float a0 = 0.f, a1 = 0.f, a2 = 0.f;
            const int kbeg = F.wave * 128;
#pragma unroll 8
            for (int k = kbeg; k < kbeg + 128; ++k) { const float w = I.w_mod[(size_t)k * 6144 + n];
                a0 += siluf_(I.c[k]) * w; a1 += siluf_(I.c[D + k]) * w; a2 += siluf_(I.c_ctx[k]) * w; }
            red[(F.wave * 3 + 0) * 64 + F.lane] = a0; red[(F.wave * 3 + 1) * 64 + F.lane] = a1; red[(F.wave * 3 + 2) * 64 + F.lane] = a2;
            __syncthreads();
            if (F.tid < 192) { const int v = F.tid >> 6, l = F.tid & 63; float s = 0.f;
#pragma unroll
                for (int w = 0; w < 8; ++w) s += red[(w * 3 + v) * 64 + l];
                mods[v * 6144 + it * 64 + l] = s + I.b_mod[it * 64 + l]; }
            __syncthreads();
        }
    }
    for (int i = F.vcu * 512 + F.tid; i < N_IN; i += F.G * 512) { const int s = win_src(i); WSP(float, WS_BIASP)[i] = s >= 0 ? I.b_in[s] : 0.f; }
    for (int i = F.vcu * 512 + F.tid; i < 1024 * 72; i += F.G * 512) { const int k = i / 72, j = i % 72; WSP(float, WS_WR72)[i] = j < 8 ? I.w_group[k * 8 + j] : I.w_router[k * 64 + (j - 8)]; }
    {
        float* hid2 = WSP(float, WS_HID2);
        const int j = F.lane;
        const float fr = I.hf_freq[j], b1 = I.hf_b1[j], b2 = I.hf_b2[j];
        for (int pos = gw; pos < SEQ; pos += NGW) {
            const float t = (float)pos / (float)(SEQ - 1);
            float a = b1 + t * I.hf_w1[0 * 64 + j];
#pragma unroll 4
            for (int i = 0; i < 16; ++i) { const float band = 1e-4f + (float)i * ((15.0f - 1e-4f) / 15.0f);
                const float ang = (6.283185307179586f / (float)SEQ) * (float)pos * band;
                float sn, cs; sincosf(ang, &sn, &cs);
                a += cs * I.hf_w1[(1 + i) * 64 + j] - sn * I.hf_w1[(17 + i) * 64 + j]; }
            const float h1 = sinf(fr * a);
            float a2 = b2;
#pragma unroll 8
            for (int i = 0; i < 64; ++i) a2 += __shfl(h1, i) * I.hf_w2[i * 64 + j];
            hid2[pos * 64 + j] = sinf(fr * a2);
        }
    }
}

constexpr int FFT_N = 16384;
__device__ __forceinline__ int PADI(int i) { return i + (i >> 5); }
__device__ __forceinline__ constexpr int bitrev(int x, int bits) { int r = 0; for (int i = 0; i < bits; ++i) r = (r << 1) | ((x >> i) & 1); return r; }
template <int R, int LOG2R>
__device__ __forceinline__ void dft_dif(f32x2 (&v)[R]) {
    constexpr float C32[16] = {1.000000000e+00f, 9.807852804e-01f, 9.238795325e-01f, 8.314696123e-01f, 7.071067812e-01f, 5.555702330e-01f, 3.826834324e-01f, 1.950903220e-01f,
                               0.0f, -1.950903220e-01f, -3.826834324e-01f, -5.555702330e-01f, -7.071067812e-01f, -8.314696123e-01f, -9.238795325e-01f, -9.807852804e-01f};
    constexpr float S32[16] = {0.0f, 1.950903220e-01f, 3.826834324e-01f, 5.555702330e-01f, 7.071067812e-01f, 8.314696123e-01f, 9.238795325e-01f, 9.807852804e-01f,
                               1.0f, 9.807852804e-01f, 9.238795325e-01f, 8.314696123e-01f, 7.071067812e-01f, 5.555702330e-01f, 3.826834324e-01f, 1.950903220e-01f};
#pragma unroll
    for (int st = 0; st < LOG2R; ++st) {
        const int half = R >> (st + 1);
#pragma unroll
        for (int blk = 0; blk < R; blk += 2 * half)
#pragma unroll
            for (int i = 0; i < half; ++i) {
                const f32x2 a = v[blk + i], b = v[blk + i + half];
                v[blk + i] = a + b;
                const f32x2 t = a - b;
                const int ti = i * (16 / half);
                if (ti == 0) v[blk + i + half] = t;
                else if (ti == 8) v[blk + i + half] = (f32x2){t.y, -t.x};
                else { const float c = C32[ti], s = S32[ti]; v[blk + i + half] = (f32x2){t.x * c + t.y * s, t.y * c - t.x * s}; }
            }
    }
}
__device__ __forceinline__ f32x2 cmul(f32x2 a, f32x2 b) { return (f32x2){a.x * b.x - a.y * b.y, a.x * b.y + a.y * b.x}; }
__device__ __forceinline__ f32x2 twid(float frac) { return (f32x2){__builtin_amdgcn_cosf(frac), -__builtin_amdgcn_sinf(frac)}; }
__device__ __forceinline__ void fft_pass_a_store(f32x2 (&v)[32], LAS f32x2* X, int j) {
    dft_dif<32, 5>(v);
    int jq = j; asm volatile("" : "+v"(jq));
    LAS f32x2* xb = X + 33 * jq;
#pragma unroll
    for (int p = 0; p < 32; ++p) xb[bitrev(p, 5)] = v[p];
}
__device__ __forceinline__ void fft_load32(f32x2 (&v)[32], const LAS f32x2* X, int j) {
    int jq = j; asm volatile("" : "+v"(jq));
    const LAS f32x2* xb = X + jq + (jq >> 5);
#pragma unroll
    for (int r = 0; r < 32; ++r) v[r] = xb[528 * r];
}
__device__ __forceinline__ void fft_pass_b(LAS f32x2* X, int j) {
    f32x2 v[32]; fft_load32(v, X, j);
    int jo = j; asm volatile("" : "+v"(jo));
    const int k = jo & 31; const float f1 = (float)k * (1.0f / 1024.0f);
    j = jo;
#pragma unroll
    for (int r = 1; r < 32; ++r) v[r] = cmul(v[r], twid((float)r * f1));
    dft_dif<32, 5>(v);
    __syncthreads();
    LAS f32x2* xb = X + (j >> 5) * 1056 + k;
#pragma unroll
    for (int p = 0; p < 32; ++p) xb[33 * bitrev(p, 5)] = v[p];
}
__device__ __forceinline__ void fft_pass_c_compute(f32x2 (&v)[32], const LAS f32x2* X, int tid) {
#pragma unroll
    for (int u = 0; u < 2; ++u) {
        int jj = tid + 512 * u; asm volatile("" : "+v"(jj)); f32x2 w[16];
#pragma unroll
        for (int r = 0; r < 16; ++r) w[r] = X[jj + (jj >> 5) + 1056 * r];
        const float f1 = (float)jj * (1.0f / 16384.0f);
#pragma unroll
        for (int r = 1; r < 16; ++r) w[r] = cmul(w[r], twid((float)r * f1));
        dft_dif<16, 4>(w);
#pragma unroll
        for (int p = 0; p < 16; ++p) v[16 * u + p] = w[p];
    }
}

__device__ __forceinline__ void filter_spec_item(Frame& F, const Inputs& I, int pair) {
    const int c = 2 * pair, tid = F.tid;
    LAS f32x2* X = (LAS f32x2*)F.lds;
    LAS float* red = (LAS float*)(F.lds + 140 * 1024);
    const float* hid2 = WSP(float, WS_HID2);
    const float dmin = -4.605170186f / 1.5f, dmax = -4.605170186f / 0.3f;
    const float dc0 = fabsf(dmin + (float)c * ((dmax - dmin) / 1023.0f)), dc1 = fabsf(dmin + (float)(c + 1) * ((dmax - dmin) / 1023.0f));
    float ss0 = 0.f, ss1 = 0.f;
    for (int i = 0; i < 16; ++i) {
        const int lag = tid + 512 * i;
        float f0 = 0.f, f1 = 0.f, g0 = 0.f, g1 = 0.f;
        const f32x4* hr = (const f32x4*)(hid2 + (size_t)lag * 64);
#pragma unroll 4
        for (int h4 = 0; h4 < 16; ++h4) { const f32x4 hv = hr[h4];
#pragma unroll
            for (int e = 0; e < 4; ++e) { const float* w = I.hf_w3 + (size_t)(4 * h4 + e) * 2048 + c;
                f0 += hv[e] * w[0]; f1 += hv[e] * w[1]; g0 += hv[e] * w[1024]; g1 += hv[e] * w[1025]; } }
        const float t = (float)lag / (float)(SEQ - 1);
        const float w0 = expf(-t * dc0), w1 = expf(-t * dc1);
        f0 *= w0; g0 *= w0; f1 *= w1; g1 *= w1;
        X[PADI(lag)] = (f32x2){f0, f1}; ss0 += f0 * f0; ss1 += f1 * f1;
        if (lag >= 1) { X[PADI(FFT_N - lag)] = (f32x2){g0, g1}; ss0 += g0 * g0; ss1 += g1 * g1; }
    }
    if (tid == 0) X[PADI(8192)] = (f32x2){0.f, 0.f};
    ss0 = wave_sum(ss0); ss1 = wave_sum(ss1);
    if (F.lane == 0) { red[F.wave * 2] = ss0; red[F.wave * 2 + 1] = ss1; }
    __syncthreads();
    float t0 = 0.f, t1 = 0.f;
#pragma unroll
    for (int w = 0; w < 8; ++w) { t0 += red[2 * w]; t1 += red[2 * w + 1]; }
    const float sc0 = (1.0f / sqrtf(t0 + EPS)) * (1.0f / 16384.0f), sc1 = (1.0f / sqrtf(t1 + EPS)) * (1.0f / 16384.0f);
    {   f32x2 v[32]; fft_load32(v, X, tid); __syncthreads(); fft_pass_a_store(v, X, tid); }
    __syncthreads();
    fft_pass_b(X, tid);
    __syncthreads();
    {   f32x2 v[32]; fft_pass_c_compute(v, X, tid); __syncthreads();
#pragma unroll
        for (int u = 0; u < 2; ++u) { int jj = tid + 512 * u; asm volatile("" : "+v"(jj)); LAS f32x2* xb = X + jj + (jj >> 5);
#pragma unroll
            for (int p = 0; p < 16; ++p) xb[1056 * bitrev(p, 4)] = v[16 * u + p]; } }
    __syncthreads();
    f32x2* fs = WSP(f32x2, WS_FSPEC);
    for (int k = tid; k <= 8192; k += 512) {
        const f32x2 zk = X[PADI(k)], zn = X[PADI((FFT_N - k) & (FFT_N - 1))];
        fs[(size_t)c * FS_PITCH + k] = (f32x2){0.5f * (zk.x + zn.x) * sc0, 0.5f * (zk.y - zn.y) * sc0};
        fs[(size_t)(c + 1) * FS_PITCH + k] = (f32x2){0.5f * (zk.y + zn.y) * sc1, -0.5f * (zk.x - zn.x) * sc1};
    }
    __syncthreads();
}
__device__ __forceinline__ void phase0b(Frame& F, const Inputs& I) {
    const int gw = F.vcu * 8 + F.wave, NGW = F.G * 8;
    const float* mods = WSP(float, WS_MODS);
    {
        bf16_t* H = WSP(bf16_t, WS_H);
        for (int row = gw; row < M_ALL; row += NGW) {
            const float* src = row < M_LAT ? I.x + (size_t)row * D : I.ctx + (size_t)(row - M_LAT) * D;
            const float* md = mods + (row < M_LAT ? row / SEQ : 2) * 6144;
            const f32x4* xr = (const f32x4*)src + F.lane;
            f32x4 v[4]; float s = 0.f;
#pragma unroll
            for (int j = 0; j < 4; ++j) { v[j] = xr[64 * j]; s += (v[j].x * v[j].x + v[j].y * v[j].y) + (v[j].z * v[j].z + v[j].w * v[j].w); }
            const float rstd = 1.0f / sqrtf(wave_sum(s) * (1.0f / D) + EPS);
            u32x2* o8 = (u32x2*)(H + (size_t)row * D) + F.lane;
#pragma unroll
            for (int j = 0; j < 4; ++j) { const int k = 4 * F.lane + 256 * j;
                const f32x4 g = *(const f32x4*)(I.g_norm1 + k), sh = *(const f32x4*)(md + k), sc = *(const f32x4*)(md + 1024 + k);
                const f32x4 h = v[j] * rstd * g * (sc + 1.0f) + sh;
                o8[64 * j] = (u32x2){pk2(h.x, h.y), pk2(h.z, h.w)}; }
        }
    }
    for (int it = gw; it < 144; it += NGW) { const int b = it / 72, j = it % 72; const float* sh2 = mods + b * 6144 + 3 * 1024; const float* w72 = WSP(float, WS_WR72);
        float s = 0.f;
        for (int k = F.lane; k < 1024; k += 64) s += sh2[k] * (j < 8 ? I.w_group[k * 8 + j] : I.w_router[k * 64 + (j - 8)]);
        (void)w72; s = wave_sum(s);
        if (F.lane == 0) WSP(float, WS_CST)[it] = s + (j < 8 ? I.b_group[j] : I.b_router[j - 8]); }
    __syncthreads();
    for (int pair = F.vcu; pair < 512; pair += F.G) filter_spec_item(F, I, pair);
}

using pg8::Unit; using pg8::cvt_pk_bf16;
struct EpiIn {
    static constexpr bool PERM = true;
    bf16_t* Z; const float* bias; float* gates;
    __device__ __forceinline__ void operator()(const f32x4 (&acc)[2][2][4][2], const Unit& u, int wr, int wc, int fr, int fq) const {
        const int row0 = u.pm * 256 + wr * 64 + fr;
        if (u.pn == 36) {
            if (wc == 0 && fq < 2) {
                const f32x4 b0 = *(const f32x4*)(bias + ZC + 8 * fq), b1 = *(const f32x4*)(bias + ZC + 8 * fq + 4);
#pragma unroll
                for (int ai = 0; ai < 2; ++ai)
#pragma unroll
                    for (int m = 0; m < 4; ++m) { float* gp = gates + (size_t)(row0 + ai * 128 + m * 16) * 16 + 8 * fq;
                        *(f32x4*)gp = acc[ai][0][m][0] + b0; *(f32x4*)(gp + 4) = acc[ai][0][m][1] + b1; }
            }
            return;
        }
        const int col0 = u.pn * 256 + wc * 32 + 8 * fq;
        f32x4 bv[2][2];
#pragma unroll
        for (int bj = 0; bj < 2; ++bj)
#pragma unroll
            for (int n = 0; n < 2; ++n) bv[bj][n] = *(const f32x4*)(bias + col0 + bj * 128 + 4 * n);
#pragma unroll
        for (int ai = 0; ai < 2; ++ai)
#pragma unroll
            for (int m = 0; m < 4; ++m) { bf16_t* rowp = Z + (size_t)(row0 + ai * 128 + m * 16) * ZC + col0;
#pragma unroll
                for (int bj = 0; bj < 2; ++bj) { const f32x4 v0 = acc[ai][bj][m][0] + bv[bj][0], v1 = acc[ai][bj][m][1] + bv[bj][1];
                    u32x4 w; w.x = cvt_pk_bf16(v0[0], v0[1]); w.y = cvt_pk_bf16(v0[2], v0[3]); w.z = cvt_pk_bf16(v1[0], v1[1]); w.w = cvt_pk_bf16(v1[2], v1[3]);
                    *(u32x4*)(rowp + bj * 128) = w; } }
    }
};
template <bool STEP_B> struct EpiMerge {
    static constexpr bool PERM = true;
    const bf16_t* Zg; float* T1; bf16_t* G;
    __device__ __forceinline__ void operator()(const f32x4 (&acc)[2][2][4][2], const Unit& u, int wr, int wc, int fr, int fq) const {
        const int row0 = u.pm * 256 + wr * 64 + fr, col0 = u.pn * 256 + wc * 32 + 8 * fq;
#pragma unroll
        for (int ai = 0; ai < 2; ++ai)
#pragma unroll
            for (int m = 0; m < 4; ++m) { const size_t row = (size_t)(row0 + ai * 128 + m * 16);
#pragma unroll
                for (int bj = 0; bj < 2; ++bj) {
                    const int col = col0 + bj * 128;
                    const u32x4 gw = *(const u32x4*)(Zg + row * ZC + col);
                    f32x4 g0 = {sigmoidf_(bflo(gw.x)), sigmoidf_(bfhi(gw.x)), sigmoidf_(bflo(gw.y)), sigmoidf_(bfhi(gw.y))};
                    f32x4 g1 = {sigmoidf_(bflo(gw.z)), sigmoidf_(bfhi(gw.z)), sigmoidf_(bflo(gw.w)), sigmoidf_(bfhi(gw.w))};
                    f32x4 v0 = g0 * acc[ai][bj][m][0], v1 = g1 * acc[ai][bj][m][1];
                    float* tp = T1 + row * D + col;
                    if constexpr (!STEP_B) { *(f32x4*)tp = v0; *(f32x4*)(tp + 4) = v1; }
                    else { v0 += *(const f32x4*)tp; v1 += *(const f32x4*)(tp + 4);
                        u32x4 w; w.x = cvt_pk_bf16(v0[0], v0[1]); w.y = cvt_pk_bf16(v0[2], v0[3]); w.z = cvt_pk_bf16(v1[0], v1[1]); w.w = cvt_pk_bf16(v1[2], v1[3]);
                        *(u32x4*)(G + row * D + col) = w; }
                } }
    }
};
struct EpiRes {
    static constexpr bool PERM = false;
    const float* x; const float* mods; float* out;
    __device__ __forceinline__ void operator()(const f32x4 (&acc)[2][2][4][2], const Unit& u, int wr, int wc, int fr, int fq) const {
        const int row0 = u.pm * 256 + wr * 64 + fr, col0 = u.pn * 256 + wc * 32 + 4 * fq;
        const float* gate = mods + (u.pm * 256 / SEQ) * 6144 + 2 * 1024;
        f32x4 gv[2][2];
#pragma unroll
        for (int bj = 0; bj < 2; ++bj)
#pragma unroll
            for (int n = 0; n < 2; ++n) gv[bj][n] = *(const f32x4*)(gate + col0 + bj * 128 + n * 16);
#pragma unroll
        for (int ai = 0; ai < 2; ++ai)
#pragma unroll
            for (int m = 0; m < 4; ++m) { const size_t off = (size_t)(row0 + ai * 128 + m * 16) * D + col0;
#pragma unroll
                for (int bj = 0; bj < 2; ++bj)
#pragma unroll
                    for (int n = 0; n < 2; ++n) *(f32x4*)(out + off + bj * 128 + n * 16) = *(const f32x4*)(x + off + bj * 128 + n * 16) + gv[bj][n] * acc[ai][bj][m][n]; }
    }
};
struct EpiMoe1 {
    static constexpr bool PERM = true;
    bf16_t* H2;
    __device__ __forceinline__ void operator()(const f32x4 (&acc)[2][2][4][2], const Unit& u, int wr, int wc, int fr, int fq) const {
        const int row0 = u.pm * 256 + wr * 64 + fr, col0 = u.pn * 128 + wc * 32 + 8 * fq;
#pragma unroll
        for (int ai = 0; ai < 2; ++ai)
#pragma unroll
            for (int m = 0; m < 4; ++m) { const size_t row = (size_t)(row0 + ai * 128 + m * 16);
                f32x4 v0, v1;
#pragma unroll
                for (int i = 0; i < 4; ++i) { v0[i] = siluf_(acc[ai][0][m][0][i]) * acc[ai][1][m][0][i]; v1[i] = siluf_(acc[ai][0][m][1][i]) * acc[ai][1][m][1][i]; }
                u32x4 w; w.x = cvt_pk_bf16(v0[0], v0[1]); w.y = cvt_pk_bf16(v0[2], v0[3]); w.z = cvt_pk_bf16(v1[0], v1[1]); w.w = cvt_pk_bf16(v1[2], v1[3]);
                *(u32x4*)(H2 + row * DEXP + col0) = w; }
    }
};
struct EpiBf {
    static constexpr bool PERM = true;
    bf16_t* O; int ldo;
    __device__ __forceinline__ void operator()(const f32x4 (&acc)[2][2][4][2], const Unit& u, int wr, int wc, int fr, int fq) const {
        const int row0 = u.pm * 256 + wr * 64 + fr, col0 = u.pn * 256 + wc * 32 + 8 * fq;
#pragma unroll
        for (int ai = 0; ai < 2; ++ai)
#pragma unroll
            for (int m = 0; m < 4; ++m) { bf16_t* rowp = O + (size_t)(row0 + ai * 128 + m * 16) * ldo + col0;
#pragma unroll
                for (int bj = 0; bj < 2; ++bj) { const f32x4 v0 = acc[ai][bj][m][0], v1 = acc[ai][bj][m][1];
                    u32x4 w; w.x = cvt_pk_bf16(v0[0], v0[1]); w.y = cvt_pk_bf16(v0[2], v0[3]); w.z = cvt_pk_bf16(v1[0], v1[1]); w.w = cvt_pk_bf16(v1[2], v1[3]);
                    *(u32x4*)(rowp + bj * 128) = w; } }
    }
};
struct InOrder {
    pg8::StaticOrder so; int G, c;
    __device__ bool next(int i, Unit& u) const {
        long L = (long)i * G + c;
        if (L < 64 * 37) return so.map(L, u);
        L -= 64 * 37; if (L >= 26) return false;
        const int j = (int)(L % 13); u.pm = 64 + (int)(L / 13); u.pn = j < 12 ? j : 36; u.e = 0; u.pad = 0; u.aoff = u.pm * so.astep; u.boff = u.pn * so.bstep; return true;
    }
};
struct MoeOrder {
    const LAS int* tile_e; int ntiles, G, c; long astep, bstep, estep;
    __device__ bool next(int i, Unit& u) const {
        const long L = (long)i * G + c; if (L >= (long)ntiles * 4) return false;
        u.pm = (int)(L >> 2); u.pn = (int)(L & 3); u.e = tile_e[u.pm]; u.pad = 0; u.aoff = u.pm * astep; u.boff = u.e * estep + u.pn * bstep; return true;
    }
};

template <int ROWS, int COLS>
__device__ __forceinline__ void qkconv_item(Frame& F, const Inputs& I, int row_base, int col_base) {
    constexpr int CPR = COLS / 8, PITCH = COLS * 2 + 16;
    static_assert(ROWS * CPR == 2048, "tile = 2048 chunks");
    bf16_t* Z = WSP(bf16_t, WS_Z);
    const int cc = F.tid % CPR, r0 = F.tid / CPR;
    float w[3][8], bs[8];
#pragma unroll
    for (int e = 0; e < 8; ++e) { const int col = col_base + 8 * cc + e;
        w[0][e] = I.w_qk_conv[col]; w[1][e] = I.w_qk_conv[2048 + col]; w[2][e] = I.w_qk_conv[4096 + col]; bs[e] = I.b_qk_conv[col]; }
    const float osc = col_base >= 1024 ? 0.0625f : 1.0f;
#pragma unroll
    for (int i = 0; i < 4; ++i) { const int r = r0 + (512 / CPR) * i;
        *(LAS u32x4*)(F.lds + r * PITCH + cc * 16) = *(const u32x4*)(Z + (size_t)(row_base + r) * ZC + col_base + 8 * cc); }
    __syncthreads();
#pragma unroll
    for (int i = 0; i < 4; ++i) { const int r = r0 + (512 / CPR) * i;
        const u32x4 z = {0u, 0u, 0u, 0u};
        const u32x4 c1 = *(const LAS u32x4*)(F.lds + r * PITCH + cc * 16);
        const u32x4 c0 = r > 0 ? *(const LAS u32x4*)(F.lds + (r - 1) * PITCH + cc * 16) : z;
        const u32x4 c2 = r < ROWS - 1 ? *(const LAS u32x4*)(F.lds + (r + 1) * PITCH + cc * 16) : z;
        float o[8];
#pragma unroll
        for (int h = 0; h < 4; ++h) {
            const float v0 = w[0][2 * h] * bflo(c0[h]) + w[1][2 * h] * bflo(c1[h]) + w[2][2 * h] * bflo(c2[h]) + bs[2 * h];
            const float v1 = w[0][2 * h + 1] * bfhi(c0[h]) + w[1][2 * h + 1] * bfhi(c1[h]) + w[2][2 * h + 1] * bfhi(c2[h]) + bs[2 * h + 1];
            o[2 * h] = siluf_(v0) * osc; o[2 * h + 1] = siluf_(v1) * osc; }
        u32x4 ov; ov.x = pk2(o[0], o[1]); ov.y = pk2(o[2], o[3]); ov.z = pk2(o[4], o[5]); ov.w = pk2(o[6], o[7]);
        *(u32x4*)(Z + (size_t)(row_base + r) * ZC + col_base + 8 * cc) = ov; }
    __syncthreads();
}
__device__ __forceinline__ void hyprep_item(Frame& F, const Inputs& I, int tb, int chb) {
    const bf16_t* Z = WSP(bf16_t, WS_Z); bf16_t* SCM = WSP(bf16_t, WS_SCM);
    constexpr int PITCH = 144;
    LAS unsigned char* X1T = F.lds; LAS unsigned char* VT = F.lds + 64 * PITCH;
    const int p = chb >> 1, j0 = (chb & 1) * 64;
    {   const int r = F.tid >> 3, cc = F.tid & 7; const bf16_t* src = Z + (size_t)(tb * 64 + r) * ZC + ZC_PAIR + 256 * p + j0 + 8 * cc;
        *(LAS u32x4*)(X1T + r * PITCH + cc * 16) = *(const u32x4*)src;
        *(LAS u32x4*)(VT + r * PITCH + cc * 16) = *(const u32x4*)(src + 128); }
    __syncthreads();
    {   const int ch = F.tid >> 3, t8 = (F.tid & 7) * 8, c = chb * 64 + ch;
        float wx[3], wv[3];
#pragma unroll
        for (int k = 0; k < 3; ++k) { wx[k] = I.w_h_conv[k * 3072 + 1024 + c]; wv[k] = I.w_h_conv[k * 3072 + 2048 + c]; }
        const float bx = I.b_h_conv[1024 + c], bv = I.b_h_conv[2048 + c];
        float xs[10], vs[10];
#pragma unroll
        for (int i = 0; i < 10; ++i) { const int r = t8 - 1 + i; const bool ok = r >= 0 && r < 64;
            xs[i] = ok ? bf2f(*(const LAS bf16_t*)(X1T + r * PITCH + ch * 2)) : 0.f; vs[i] = ok ? bf2f(*(const LAS bf16_t*)(VT + r * PITCH + ch * 2)) : 0.f; }
        float s[8];
#pragma unroll
        for (int i = 0; i < 8; ++i) s[i] = (wx[0] * xs[i] + wx[1] * xs[i + 1] + wx[2] * xs[i + 2] + bx) * (wv[0] * vs[i] + wv[1] * vs[i + 1] + wv[2] * vs[i + 2] + bv);
        u32x4 o; o.x = pk2(s[0], s[1]); o.y = pk2(s[2], s[3]); o.z = pk2(s[4], s[5]); o.w = pk2(s[6], s[7]);
        const int b = tb >> 7, t0 = (tb & 127) * 64;
        *(u32x4*)(SCM + ((size_t)(b * 1024 + c)) * SEQ + t0 + t8) = o; }
    __syncthreads();
}
__device__ __forceinline__ void phase2a(Frame& F, const Inputs& I) {
    for (int it = F.vcu; it < 2048 + 64; it += F.G) {
        if (it < 2048) qkconv_item<64, 256>(F, I, (it >> 3) * 64, (it & 7) * 256);
        else { const int j = it - 2048; qkconv_item<256, 64>(F, I, M_LAT + (j >> 5) * 256, (j & 31) * 64); }
    }
    for (int it = F.vcu; it < 4096; it += F.G) hyprep_item(F, I, it >> 4, it & 15);
}

__device__ __forceinline__ bf16x8 tr_frag(const LAS unsigned char* p0, const LAS unsigned char* p1) {
    const s16x4 a = __builtin_amdgcn_ds_read_tr16_b64_v4i16((LAS s16x4*)p0);
    const s16x4 b = __builtin_amdgcn_ds_read_tr16_b64_v4i16((LAS s16x4*)p1);
    return (bf16x8){a[0], a[1], a[2], a[3], b[0], b[1], b[2], b[3]};
}
__device__ __forceinline__ void mlstm_item(Frame& F, const Inputs& I, int item) {
    constexpr int QP = 528, VP = 80, PP = 144;
    constexpr int O_QS = 0, O_KS = 33792, O_VS = 67584, O_VW = 72704, O_PS = 77824, O_CS = 87040, CS_BYTES = 16896, O_DEN = 120832;
    const int b = item >> 7, g = (item >> 4) & 7, dir = g >> 2, head = g & 3, eb = item & 15;
    int tid = F.tid; asm volatile("" : "+v"(tid));
    const int lane = tid & 63, w = F.wave, fr = lane & 15, fq = lane >> 4;
    LAS unsigned char* L = F.lds;
    bf16_t* Z = WSP(bf16_t, WS_Z); const float* gates = WSP(float, WS_GATES);
    const int qcol = head * 256, kcol = 1024 + head * 256, vcol = 2048 + head * 256 + eb * 16, ocol = 3072 + head * 256 + eb * 16;
    const int outcol = ZC_PAIR + dir * 1024 + head * 256 + eb * 16;
    const int gi = dir * 4 + head;
    for (int i = tid; i < 64 * 16; i += 512) { const int r = i >> 4, cidx = 16 + (i & 15); *(LAS bf16_t*)(L + O_VS + r * VP + cidx * 2) = (cidx == 16) ? (bf16_t)0x3F80 : (bf16_t)0; }
    for (int i = tid; i < 2 * CS_BYTES / 4; i += 512) *(LAS unsigned*)(L + O_CS + 4 * i) = 0u;
    f32x4 Cacc[2][2];
#pragma unroll
    for (int a = 0; a < 2; ++a)
#pragma unroll
        for (int c = 0; c < 2; ++c) Cacc[a][c] = (f32x4){0.f, 0.f, 0.f, 0.f};
    float mrun = 0.f;
    u32x4 pq[4], pk[4], pv; float pig, pfg;
    const int scc = tid & 31, srow0 = tid >> 5;
    auto geom = [&](int st, int& rbase, int& tlo) { const bool ctx = st < 4; const int j = ctx ? st : st - 4, sl = ctx ? CTXL : SEQ;
        rbase = ctx ? M_LAT + b * CTXL : b * SEQ; tlo = dir == 0 ? 64 * j : sl - 64 * (j + 1); };
    auto prefetch = [&](int st) { int rbase, tlo; geom(st, rbase, tlo);
#pragma unroll
        for (int i = 0; i < 4; ++i) { const bf16_t* rp = Z + (size_t)(rbase + tlo + srow0 + 16 * i) * ZC; pq[i] = *(const u32x4*)(rp + qcol + 8 * scc); pk[i] = *(const u32x4*)(rp + kcol + 8 * scc); }
        if (tid < 128) pv = *(const u32x4*)(Z + (size_t)(rbase + tlo + (tid >> 1)) * ZC + vcol + 8 * (tid & 1));
        const int t = dir == 0 ? tlo + lane : tlo + 63 - lane;
        pig = gates[(size_t)(rbase + t) * 16 + gi]; pfg = gates[(size_t)(rbase + t) * 16 + 8 + gi]; };
    auto commit = [&]() {
#pragma unroll
        for (int i = 0; i < 4; ++i) { const int mr = srow0 + 16 * i, p = dir ? 63 - mr : mr; *(LAS u32x4*)(L + O_QS + p * QP + scc * 16) = pq[i]; *(LAS u32x4*)(L + O_KS + p * QP + scc * 16) = pk[i]; }
        if (tid < 128) { const int mr = tid >> 1, p = dir ? 63 - mr : mr; *(LAS u32x4*)(L + O_VS + p * VP + (tid & 1) * 16) = pv; } };
    prefetch(0);
    __syncthreads();
    commit();
    float igc = pig, fgc = pfg;
    __syncthreads();
    int cur = 0;
    for (int st = 0; st < 132; ++st) {
        const bool has_next = st + 1 < 132, is_ctx = st < 4;
        int rbase_c, tlo_c; geom(st, rbase_c, tlo_c);
        if (has_next) prefetch(st + 1);
        unsigned short ov[4] = {0, 0, 0, 0};
        if (!is_ctx && w < 4) {
#pragma unroll
            for (int i = 0; i < 4; ++i) { const int p = 16 * w + 4 * fq + i, t = dir == 0 ? tlo_c + p : tlo_c + 63 - p; ov[i] = Z[(size_t)(rbase_c + t) * ZC + ocol + fr]; }
        }
        const float fc = fminf(fgc, 0.f) - log1pf(__expf(-fabsf(fgc)));
        float bcum = fc;
#pragma unroll
        for (int o = 1; o < 64; o <<= 1) { const float t = __shfl_up(bcum, o); if (lane >= o) bcum += t; }
        const float aval = igc - bcum;
        float cmx = aval;
#pragma unroll
        for (int o = 1; o < 64; o <<= 1) { const float t = __shfl_up(cmx, o); if (lane >= o) cmx = fmaxf(cmx, t); }
        const float cm = fmaxf(mrun, cmx);
        const float csv = __expf(mrun - cm), emv = __expf(-(bcum + cm));
        const float cm63 = __shfl(cm, 63), b63 = __shfl(bcum, 63);
        const float wgt = __expf(aval - cm63), decay = __expf(mrun - cm63);
        const float mnext = b63 + cm63;
        {
            const int tb = w >> 1;
#pragma unroll
            for (int sbi = 0; sbi < 2; ++sbi) {
                const int sb = 2 * (w & 1) + sbi;
                u32x2 outp = {0u, 0u};
                if (sb <= tb) {
                    f32x4 acc = {0.f, 0.f, 0.f, 0.f};
#pragma unroll
                    for (int kk = 0; kk < 8; ++kk) {
                        const bf16x8 ka = *(const LAS bf16x8*)(L + O_KS + (16 * sb + fr) * QP + (32 * kk + 8 * fq) * 2);
                        const bf16x8 qb = *(const LAS bf16x8*)(L + O_QS + (16 * tb + fr) * QP + (32 * kk + 8 * fq) * 2);
                        acc = __builtin_amdgcn_mfma_f32_16x16x32_bf16(ka, qb, acc, 0, 0, 0);
                    }
                    const int t = 16 * tb + fr; const float cmt = __shfl(cm, t);
                    float pvv[4];
#pragma unroll
                    for (int i = 0; i < 4; ++i) { const int s = 16 * sb + 4 * fq + i; const float as = __shfl(aval, s); pvv[i] = s <= t ? acc[i] * __expf(as - cmt) : 0.f; }
                    outp.x = cvt_pk_bf16(pvv[0], pvv[1]); outp.y = cvt_pk_bf16(pvv[2], pvv[3]);
                }
                *(LAS u32x2*)(L + O_PS + (16 * tb + fr) * PP + (16 * sb + 4 * fq) * 2) = outp;
            }
            const int s = tid >> 3, e4 = (tid & 7) * 4; const float wg = __shfl(wgt, s & 63);
            const u32x2 vv = *(const LAS u32x2*)(L + O_VS + s * VP + e4 * 2);
            u32x2 vo; vo.x = cvt_pk_bf16(bflo(vv.x) * wg, bfhi(vv.x) * wg); vo.y = cvt_pk_bf16(bflo(vv.y) * wg, bfhi(vv.y) * wg);
            *(LAS u32x2*)(L + O_VW + s * VP + e4 * 2) = vo;
        }
        __syncthreads();
        f32x4 nacc = {0.f, 0.f, 0.f, 0.f};
        const int tt = w & 3, et = w >> 2;
        const int trg = lane >> 4, trq = (lane & 15) >> 2, trp = lane & 3;
        {
            const LAS unsigned char* CSc = L + O_CS + cur * CS_BYTES;
#pragma unroll
            for (int kk = 0; kk < 8; ++kk) {
                const bf16x8 qa = *(const LAS bf16x8*)(L + O_QS + (16 * tt + fr) * QP + (32 * kk + 8 * fq) * 2);
                const bf16x8 cb = *(const LAS bf16x8*)(CSc + (16 * et + fr) * QP + (32 * kk + 8 * fq) * 2);
                nacc = __builtin_amdgcn_mfma_f32_16x16x32_bf16(qa, cb, nacc, 0, 0, 0);
            }
#pragma unroll
            for (int i = 0; i < 4; ++i) nacc[i] *= __shfl(csv, 16 * tt + 4 * fq + i);
#pragma unroll
            for (int ks = 0; ks < 2; ++ks) {
                const bf16x8 pa = *(const LAS bf16x8*)(L + O_PS + (16 * tt + fr) * PP + (32 * ks + 8 * fq) * 2);
                const LAS unsigned char* vb = L + O_VS + (32 * ks + 8 * trg + trq) * VP + (16 * et + 4 * trp) * 2;
                const bf16x8 vf = tr_frag(vb, vb + 4 * VP);
                nacc = __builtin_amdgcn_mfma_f32_16x16x32_bf16(pa, vf, nacc, 0, 0, 0);
            }
            if (et == 1 && fr == 0) {
#pragma unroll
                for (int i = 0; i < 4; ++i) *(LAS float*)(L + O_DEN + (16 * tt + 4 * fq + i) * 4) = nacc[i];
            }
        }
        {
            LAS unsigned char* CSn = L + O_CS + (cur ^ 1) * CS_BYTES;
#pragma unroll
            for (int a = 0; a < 2; ++a)
#pragma unroll
                for (int c = 0; c < 2; ++c) Cacc[a][c] = Cacc[a][c] * decay;
#pragma unroll
            for (int ks = 0; ks < 2; ++ks) {
                bf16x8 ka[2], vb[2];
#pragma unroll
                for (int a = 0; a < 2; ++a) { const LAS unsigned char* p = L + O_KS + (32 * ks + 8 * trg + trq) * QP + (16 * (2 * w + a) + 4 * trp) * 2; ka[a] = tr_frag(p, p + 4 * QP); }
#pragma unroll
                for (int c = 0; c < 2; ++c) { const LAS unsigned char* p = L + O_VW + (32 * ks + 8 * trg + trq) * VP + (16 * c + 4 * trp) * 2; vb[c] = tr_frag(p, p + 4 * VP); }
#pragma unroll
                for (int a = 0; a < 2; ++a)
#pragma unroll
                    for (int c = 0; c < 2; ++c) Cacc[a][c] = __builtin_amdgcn_mfma_f32_16x16x32_bf16(ka[a], vb[c], Cacc[a][c], 0, 0, 0);
            }
#pragma unroll
            for (int a = 0; a < 2; ++a)
#pragma unroll
                for (int c = 0; c < 2; ++c) { u32x2 o; o.x = cvt_pk_bf16(Cacc[a][c][0], Cacc[a][c][1]); o.y = cvt_pk_bf16(Cacc[a][c][2], Cacc[a][c][3]);
                    *(LAS u32x2*)(CSn + (16 * c + fr) * QP + (16 * (2 * w + a) + 4 * fq) * 2) = o; }
        }
        __syncthreads();
        if (!is_ctx && w < 4) {
#pragma unroll
            for (int i = 0; i < 4; ++i) { const int p = 16 * w + 4 * fq + i, t = dir == 0 ? tlo_c + p : tlo_c + 63 - p;
                const float den = *(const LAS float*)(L + O_DEN + p * 4), em = __shfl(emv, p);
                const float h = nacc[i] / fmaxf(fabsf(den), em);
                Z[(size_t)(rbase_c + t) * ZC + outcol + fr] = (bf16_t)f2bf(sigmoidf_(bf2f(ov[i])) * h); }
        }
        if (has_next) { commit(); igc = pig; fgc = pfg; }
        mrun = mnext; cur ^= 1;
        __syncthreads();
    }
}

__device__ __forceinline__ void hyena_item(Frame& F, const Inputs& I, int c) {
    LAS f32x2* X = (LAS f32x2*)F.lds;
    int tid = F.tid; asm volatile("" : "+v"(tid));
    const bf16_t* s0 = WSP(bf16_t, WS_SCM) + (size_t)c * SEQ; const bf16_t* s1 = s0 + (size_t)1024 * SEQ;
    const f32x2* fs = WSP(f32x2, WS_FSPEC) + (size_t)c * FS_PITCH;
    bf16_t* y0 = WSP(bf16_t, WS_H) + (size_t)c * SEQ; bf16_t* y1 = y0 + (size_t)1024 * SEQ;
    {
        f32x2 v[32];
#pragma unroll
        for (int r = 0; r < 16; ++r) { const int t = tid + 512 * r; v[r] = (f32x2){bf2f(s0[t]), bf2f(s1[t])}; }
#pragma unroll
        for (int r = 16; r < 32; ++r) v[r] = (f32x2){0.f, 0.f};
        __syncthreads();
        fft_pass_a_store(v, X, tid);
    }
    __syncthreads();
    fft_pass_b(X, tid);
    __syncthreads();
    {
        f32x2 v[32]; fft_pass_c_compute(v, X, tid);
        asm volatile("" ::: "memory"); __builtin_amdgcn_sched_barrier(0);
#pragma unroll
        for (int u = 0; u < 2; ++u)
#pragma unroll
            for (int p = 0; p < 16; ++p) { const int idx = tid + 512 * u + 1024 * bitrev(p, 4);
                f32x2 f = idx <= 8192 ? fs[idx] : fs[FFT_N - idx]; if (idx > 8192) f.y = -f.y;
                const f32x2 y = cmul(v[16 * u + p], f); v[16 * u + p] = (f32x2){y.x, -y.y}; }
        __syncthreads();
#pragma unroll
        for (int u = 0; u < 2; ++u) { int jj = tid + 512 * u; asm volatile("" : "+v"(jj)); LAS f32x2* xb = X + jj + (jj >> 5);
#pragma unroll
            for (int p = 0; p < 16; ++p) xb[1056 * bitrev(p, 4)] = v[16 * u + p]; }
    }
    __syncthreads();
    {   f32x2 v[32]; fft_load32(v, X, tid); __syncthreads(); fft_pass_a_store(v, X, tid); }
    __syncthreads();
    fft_pass_b(X, tid);
    __syncthreads();
    {   f32x2 v[32]; fft_pass_c_compute(v, X, tid);
        asm volatile("" ::: "memory"); __builtin_amdgcn_sched_barrier(0);
        const float hb = I.h_bias[c];
#pragma unroll
        for (int u = 0; u < 2; ++u)
#pragma unroll
            for (int p = 0; p < 16; ++p) { const int q = bitrev(p, 4);
                if (q < 8) { const int idx = tid + 512 * u + 1024 * q;
                    const float o0 = v[16 * u + p].x + hb * bf2f(s0[idx]), o1 = -v[16 * u + p].y + hb * bf2f(s1[idx]);
                    y0[idx] = (bf16_t)f2bf(o0); y1[idx] = (bf16_t)f2bf(o1); } }
    }
    __syncthreads();
}
__device__ __forceinline__ void phase2b(Frame& F, const Inputs& I) {
    for (int it = F.vcu; it < 256; it += F.G) mlstm_item(F, I, it);
    __syncthreads();
    for (int c = F.vcu; c < 1024; c += F.G) hyena_item(F, I, c);
}

__device__ __forceinline__ void hy_item(Frame& F, const Inputs& I, int tb, int chb) {
    bf16_t* Z = WSP(bf16_t, WS_Z); const bf16_t* YCM = WSP(bf16_t, WS_H);
    constexpr int PITCH = 144;
    LAS unsigned char* X0T = F.lds; LAS unsigned char* YT = F.lds + 64 * PITCH;
    const int b = tb >> 7, t0 = (tb & 127) * 64;
    {   const int r = F.tid >> 3, cc = F.tid & 7;
        *(LAS u32x4*)(X0T + r * PITCH + cc * 16) = *(const u32x4*)(Z + (size_t)(tb * 64 + r) * ZC + ZC_X0 + chb * 64 + 8 * cc);
        *(LAS u32x4*)(YT + r * PITCH + cc * 16) = *(const u32x4*)(YCM + ((size_t)(b * 1024 + chb * 64 + r)) * SEQ + t0 + 8 * cc); }
    __syncthreads();
    {   const int r = F.tid >> 3, cc = F.tid & 7;
        const u32x4 z = {0u, 0u, 0u, 0u};
        const u32x4 c1 = *(const LAS u32x4*)(X0T + r * PITCH + cc * 16);
        const u32x4 c0 = r > 0 ? *(const LAS u32x4*)(X0T + (r - 1) * PITCH + cc * 16) : z;
        const u32x4 c2 = r < 63 ? *(const LAS u32x4*)(X0T + (r + 1) * PITCH + cc * 16) : z;
        float o[8];
#pragma unroll
        for (int e = 0; e < 8; ++e) { const int c = chb * 64 + 8 * cc + e; const int h = e >> 1;
            const float a0 = (e & 1) ? bfhi(c0[h]) : bflo(c0[h]), a1 = (e & 1) ? bfhi(c1[h]) : bflo(c1[h]), a2 = (e & 1) ? bfhi(c2[h]) : bflo(c2[h]);
            const float x0 = I.w_h_conv[c] * a0 + I.w_h_conv[3072 + c] * a1 + I.w_h_conv[6144 + c] * a2 + I.b_h_conv[c];
            o[e] = x0 * bf2f(*(const LAS bf16_t*)(YT + (8 * cc + e) * PITCH + r * 2)); }
        u32x4 ov; ov.x = pk2(o[0], o[1]); ov.y = pk2(o[2], o[3]); ov.z = pk2(o[4], o[5]); ov.w = pk2(o[6], o[7]);
        *(u32x4*)(Z + (size_t)(tb * 64 + r) * ZC + ZC_X0 + chb * 64 + 8 * cc) = ov; }
    __syncthreads();
}

__device__ __forceinline__ void expert_transposes(Frame& F, const Inputs& I, int part, int nparts) {
    LAS float* scr = (LAS float*)(F.lds + F.wave * 16384);
    const int gw = F.vcu * 8 + F.wave, NGW = F.G * 8;
    constexpr int PER_E = 3 * 256, NIT = NEXP * PER_E;
    const int lo = (int)((long)NIT * part / nparts), hi = (int)((long)NIT * (part + 1) / nparts);
    bf16_t* W13T = WSP(bf16_t, WS_W13T); bf16_t* W2T = WSP(bf16_t, WS_W2T);
    for (int it = lo + gw; it < hi; it += NGW) {
        const int e = it / PER_E, r = it % PER_E, m = r >> 8, rr = r & 255;
        if (m < 2) {
            const int kb = rr >> 4, nb = rr & 15, n0 = 32 * nb;
            const float* W = (m == 0 ? I.w1_e : I.w3_e) + (size_t)e * D * DEXP;
            transpose_item(W, DEXP, 64 * kb, [&](int i) { return n0 + i; }, W13T + (size_t)e * 1024 * 1024, D, (n0 >> 7) * 256 + m * 128 + (n0 & 127), 64 * kb, scr, F.lane);
        } else {
            const int kb = rr >> 5, nb = rr & 31;
            transpose_item(I.w2_e + (size_t)e * DEXP * D, D, 64 * kb, [&](int i) { return 32 * nb + i; }, W2T + (size_t)e * 1024 * DEXP, DEXP, 32 * nb, 64 * kb, scr, F.lane);
        }
    }
}

struct Route { int e0, e1; float w0, w1; };
__device__ __forceinline__ void route_item(Frame& F, const Inputs& I, const float* x1, int blk) {
    constexpr int XP = 65;
    LAS float* XT = (LAS float*)F.lds;
    LAS float* SSQ = (LAS float*)(F.lds + 256 * XP * 4);
    LAS float* LOG = SSQ + 64;
    const int tid = F.tid, lane = F.lane, w = F.wave;
    const int row0 = blk * 64, b = row0 / SEQ;
    const float* mods = WSP(float, WS_MODS) + b * 6144;
    const float* w72 = WSP(float, WS_WR72);
    float acc[9];
#pragma unroll
    for (int j = 0; j < 9; ++j) acc[j] = 0.f;
    const int sr = tid >> 3, seg = tid & 7;
    float ssq = 0.f;
    for (int kt = 0; kt < 4; ++kt) {
#pragma unroll
        for (int i = 0; i < 8; ++i) { const int kk = 32 * i + 4 * seg, k = kt * 256 + kk;
            const f32x4 xv = *(const f32x4*)(x1 + (size_t)(row0 + sr) * D + k);
            ssq += (xv.x * xv.x + xv.y * xv.y) + (xv.z * xv.z + xv.w * xv.w);
            const f32x4 g = *(const f32x4*)(I.g_norm2 + k), sc = *(const f32x4*)(mods + 4 * 1024 + k);
            const f32x4 hv = xv * g * (sc + 1.0f);
            XT[(kk + 0) * XP + sr] = hv.x; XT[(kk + 1) * XP + sr] = hv.y; XT[(kk + 2) * XP + sr] = hv.z; XT[(kk + 3) * XP + sr] = hv.w; }
        __syncthreads();
        const float* wp = w72 + (size_t)(kt * 256) * 72 + 9 * w;
#pragma unroll 4
        for (int kk = 0; kk < 256; ++kk) { const float xv = XT[kk * XP + lane];
#pragma unroll
            for (int j = 0; j < 9; ++j) acc[j] += xv * wp[kk * 72 + j]; }
        __syncthreads();
    }
    ssq += __shfl_xor(ssq, 1); ssq += __shfl_xor(ssq, 2); ssq += __shfl_xor(ssq, 4);
    if (seg == 0) SSQ[sr] = ssq;
    __syncthreads();
    const float rstd = 1.0f / sqrtf(SSQ[lane] * (1.0f / D) + EPS);
    const float* cst = WSP(float, WS_CST) + b * 72;
#pragma unroll
    for (int j = 0; j < 9; ++j) LOG[lane * 73 + 9 * w + j] = rstd * acc[j] + cst[9 * w + j];
    __syncthreads();
    if (w == 0) {
        const LAS float* lg = LOG + lane * 73;
        int gsel = 0; float gmax = lg[0];
#pragma unroll
        for (int j = 1; j < 8; ++j) if (lg[j] > gmax) { gmax = lg[j]; gsel = j; }
        float gs = 0.f;
#pragma unroll
        for (int j = 0; j < 8; ++j) gs += __expf(lg[j] - gmax);
        const float gwt = 1.0f / gs;
        const LAS float* el = lg + 8 + 8 * gsel;
        int i0 = 0; float v0 = el[0];
#pragma unroll
        for (int j = 1; j < 8; ++j) if (el[j] > v0) { v0 = el[j]; i0 = j; }
        int i1 = -1; float v1 = -3.0e38f;
#pragma unroll
        for (int j = 0; j < 8; ++j) if (j != i0 && el[j] > v1) { v1 = el[j]; i1 = j; }
        const float p1 = __expf(v1 - v0), inv = 1.0f / (1.0f + p1);
        Route r; r.e0 = gsel * 8 + i0; r.e1 = gsel * 8 + i1; r.w0 = gwt * inv; r.w1 = gwt * p1 * inv;
        WSP(Route, WS_ROUTE)[row0 + lane] = r;
        WSP(float, WS_RSTD2)[row0 + lane] = rstd;
        unsigned* cnt = WSP(unsigned, WS_CTL) + CW_CNT;
        atomicAdd(cnt + r.e0, 1u); atomicAdd(cnt + r.e1, 1u);
    }
    __syncthreads();
}
__device__ __forceinline__ int moe_tables(Frame& F, LAS int* seg_start, LAS int* tile_e) {
    const unsigned* cnt = WSP(unsigned, WS_CTL) + CW_CNT;
    if (F.tid < 64) { int s = 0; for (int e = 0; e < F.tid; ++e) s += ((int)__hip_atomic_load(cnt + e, RLX_AGENT) + 255) >> 8; seg_start[F.tid] = s * 256; }
    __syncthreads();
    if (F.tid < 64) { const int t0 = seg_start[F.tid] >> 8, nt = ((int)__hip_atomic_load(cnt + F.tid, RLX_AGENT) + 255) >> 8; for (int t = 0; t < nt; ++t) tile_e[t0 + t] = F.tid; if (F.tid == 63) seg_start[64] = (t0 + nt) * 256; }
    __syncthreads();
    return seg_start[64] >> 8;
}
__device__ __forceinline__ void phase4b(Frame& F, const Inputs& I, const float* x1) {
    LAS int* seg_start = (LAS int*)F.lds; LAS int* tile_e = seg_start + 80;
    (void)moe_tables(F, seg_start, tile_e);
    const int gw = F.vcu * 8 + F.wave, NGW = F.G * 8;
    unsigned* cur = WSP(unsigned, WS_CTL) + CW_CUR;
    bf16_t* XS = WSP(bf16_t, WS_XS);
    for (int row = gw; row < M_LAT; row += NGW) {
        const Route r = WSP(Route, WS_ROUTE)[row];
        int sl0 = 0, sl1 = 0;
        if (F.lane == 0) { sl0 = seg_start[r.e0] + (int)atomicAdd(cur + r.e0, 1u); sl1 = seg_start[r.e1] + (int)atomicAdd(cur + r.e1, 1u);
            WSP(int, WS_TOKSLOT)[2 * row] = sl0; WSP(int, WS_TOKSLOT)[2 * row + 1] = sl1; }
        sl0 = __shfl(sl0, 0); sl1 = __shfl(sl1, 0);
        const float rstd = WSP(float, WS_RSTD2)[row];
        const float* md = WSP(float, WS_MODS) + (row / SEQ) * 6144;
        const f32x4* xr = (const f32x4*)(x1 + (size_t)row * D) + F.lane;
        u32x2* o0 = (u32x2*)(XS + (size_t)sl0 * D) + F.lane; u32x2* o1 = (u32x2*)(XS + (size_t)sl1 * D) + F.lane;
#pragma unroll
        for (int j = 0; j < 4; ++j) { const int k = 4 * F.lane + 256 * j; const f32x4 xv = xr[64 * j];
            const f32x4 g = *(const f32x4*)(I.g_norm2 + k), sh = *(const f32x4*)(md + 3 * 1024 + k), sc = *(const f32x4*)(md + 4 * 1024 + k);
            const f32x4 h = xv * rstd * g * (sc + 1.0f) + sh;
            const u32x2 o = {pk2(h.x, h.y), pk2(h.z, h.w)}; o0[64 * j] = o; o1[64 * j] = o; }
    }
}
__device__ __forceinline__ void phase6(Frame& F, const Inputs& I, float* out) {
    const int gw = F.vcu * 8 + F.wave, NGW = F.G * 8;
    const bf16_t* Y = WSP(bf16_t, WS_XS);
    for (int row = gw; row < M_LAT; row += NGW) {
        const Route r = WSP(Route, WS_ROUTE)[row];
        const int sl0 = WSP(int, WS_TOKSLOT)[2 * row], sl1 = WSP(int, WS_TOKSLOT)[2 * row + 1];
        const float* md = WSP(float, WS_MODS) + (row / SEQ) * 6144 + 5 * 1024;
        f32x4* xr = (f32x4*)(out + (size_t)row * D) + F.lane;
        const u32x2* y0 = (const u32x2*)(Y + (size_t)sl0 * D) + F.lane; const u32x2* y1 = (const u32x2*)(Y + (size_t)sl1 * D) + F.lane;
        f32x4 v[4]; float s = 0.f;
#pragma unroll
        for (int j = 0; j < 4; ++j) { const int k = 4 * F.lane + 256 * j; const u32x2 a = y0[64 * j], bq = y1[64 * j];
            const f32x4 ya = {bflo(a.x), bfhi(a.x), bflo(a.y), bfhi(a.y)}, yb = {bflo(bq.x), bfhi(bq.x), bflo(bq.y), bfhi(bq.y)};
            const f32x4 moe = ya * r.w0 + yb * r.w1;
            v[j] = xr[64 * j] + *(const f32x4*)(md + k) * moe;
            s += (v[j].x * v[j].x + v[j].y * v[j].y) + (v[j].z * v[j].z + v[j].w * v[j].w); }
        const float rstd = 1.0f / sqrtf(wave_sum(s) * (1.0f / D) + EPS);
#pragma unroll
        for (int j = 0; j < 4; ++j) { const int k = 4 * F.lane + 256 * j; xr[64 * j] = v[j] * rstd * *(const f32x4*)(I.g_final + k); }
    }
}

#ifndef MK_PER_PHASE
#define DBG_SUB 0
#define MK_PER_PHASE 0
#endif
constexpr int N_PHASES = 13;
constexpr int TAB_OFF = 150 * 1024;

__global__ void __launch_bounds__(512, 2) fwd_kernel(Args args) {
    extern __shared__ __attribute__((aligned(16))) unsigned char lds_raw[];
    Frame F;
    F.lds = (LAS unsigned char*)lds_raw;
    F.tid = threadIdx.x; F.lane = F.tid & 63; F.wave = __builtin_amdgcn_readfirstlane(F.tid >> 6);
    F.G = gridDim.x; { const int bx = blockIdx.x; F.vcu = (F.G % 8 == 0) ? (bx % 8) * (F.G / 8) + bx / 8 : bx; }
    F.ws = args.ws;
    const Inputs& I = args.in;
    volatile LAS unsigned* MISC = (volatile LAS unsigned*)(F.lds + MISC_OFF);
    if (F.tid < 32) MISC[F.tid] = 0u;
    __syncthreads();
    XcdBarrier bar; bar.bar = WSP(unsigned, WS_CTL) + CW_BAR; bar.x = 0; bar.st = nullptr;
#if !MK_PER_PHASE
    bar = xcd_barrier_post(WSP(unsigned, WS_CTL) + CW_BAR, MISC + 8);
#define GRID_BAR() xcd_barrier(bar)
#else
#define GRID_BAR() do {} while (0)
#endif
    const int lo = args.ph_lo, hi = args.ph_hi;
#ifndef PH_MASK
#define PH_MASK 0x1fff
#endif
#define IN(k) (((PH_MASK >> (k)) & 1) && lo <= (k) && (k) < hi)
#define SEAM(k) do { if (IN(k) && IN((k) + 1)) GRID_BAR(); } while (0)
    bf16_t* Z = WSP(bf16_t, WS_Z);
    float* x1 = args.out;

    if (IN(0)) { phase0(F, I); } SEAM(0);
    if (IN(1)) { phase0b(F, I); } SEAM(1);
    if (IN(2)) {
        pg8::Gemm g{WSP(bf16_t, WS_H), WSP(bf16_t, WS_WIN_T), D, D, D};
        InOrder S; S.so.init(64, 37, F.G, (int)blockIdx.x, 256L * D * 2, 256L * D * 2); S.G = F.G; S.c = (int)blockIdx.x;
        EpiIn E{Z, WSP(float, WS_BIASP), WSP(float, WS_GATES)};
        pg8::gemm_phase<EpiIn, InOrder, true>(F.lds, g, S, E);
    } SEAM(2);
    if (IN(3)) { phase2a(F, I); } SEAM(3);
    if (IN(4)) { phase2b(F, I); } SEAM(4);
    if (IN(5)) {
        for (int it = F.vcu; it < 4096; it += F.G) hy_item(F, I, it >> 4, it & 15);
        __syncthreads();
        pg8::Gemm g{Z + ZC_PAIR, WSP(bf16_t, WS_WA2_T), ZC, 2 * D, 2 * D};
        pg8::StaticOrder S; S.init(64, 4, F.G, (int)blockIdx.x, 256L * ZC * 2, 256L * 2 * D * 2);
        EpiMerge<false> E{Z + ZC_GA, WSP(float, WS_FSPEC), nullptr};
        pg8::gemm_phase<EpiMerge<false>, pg8::StaticOrder, false>(F.lds, g, S, E);
    } SEAM(5);
    if (IN(6)) {
        pg8::Gemm g{Z + ZC_X0, WSP(bf16_t, WS_WB_T), ZC, D, D};
        pg8::StaticOrder S; S.init(64, 4, F.G, (int)blockIdx.x, 256L * ZC * 2, 256L * D * 2);
        EpiMerge<true> E{Z + ZC_GB, WSP(float, WS_FSPEC), WSP(bf16_t, WS_H)};
        pg8::gemm_phase<EpiMerge<true>, pg8::StaticOrder, false>(F.lds, g, S, E);
    } SEAM(6);
    if (IN(7)) {
        pg8::Gemm g{WSP(bf16_t, WS_H), WSP(bf16_t, WS_WOUT_T), D, D, D};
        pg8::StaticOrder S; S.init(64, 4, F.G, (int)blockIdx.x, 256L * D * 2, 256L * D * 2);
        EpiRes E{I.x, WSP(float, WS_MODS), x1};
        pg8::gemm_phase<EpiRes, pg8::StaticOrder, false>(F.lds, g, S, E);
        __syncthreads();
        expert_transposes(F, I, 0, 2);
    } SEAM(7);
    if (IN(8)) {
        for (int blk = F.vcu; blk < M_LAT / 64; blk += F.G) route_item(F, I, x1, blk);
        __syncthreads();
        expert_transposes(F, I, 1, 2);
    } SEAM(8);
    if (IN(9)) { phase4b(F, I, x1); } SEAM(9);
    if (IN(10)) {
        LAS int* seg_start = (LAS int*)(F.lds + TAB_OFF); LAS int* tile_e = seg_start + 80;
        const int ntiles = moe_tables(F, seg_start, tile_e);
        pg8::Gemm g{WSP(bf16_t, WS_XS), WSP(bf16_t, WS_W13T), D, D, D};
        MoeOrder S{tile_e, ntiles, F.G, F.vcu, 256L * D * 2, 256L * D * 2, 1024L * D * 2};
        EpiMoe1 E{WSP(bf16_t, WS_FSPEC)};
        pg8::gemm_phase<EpiMoe1, MoeOrder, true>(F.lds, g, S, E);
    } SEAM(10);
    if (IN(11)) {
        LAS int* seg_start = (LAS int*)(F.lds + TAB_OFF); LAS int* tile_e = seg_start + 80;
        const int ntiles = moe_tables(F, seg_start, tile_e);
        pg8::Gemm g{WSP(bf16_t, WS_FSPEC), WSP(bf16_t, WS_W2T), DEXP, DEXP, DEXP};
        MoeOrder S{tile_e, ntiles, F.G, F.vcu, 256L * DEXP * 2, 256L * DEXP * 2, 1024L * DEXP * 2};
        EpiBf E{WSP(bf16_t, WS_XS), D};
        pg8::gemm_phase<EpiBf, MoeOrder, true>(F.lds, g, S, E);
    } SEAM(11);
    if (IN(12)) { phase6(F, I, x1); }
#ifdef DBG_STOP
    if (lo == 13) {
        const int gw = F.vcu * 8 + F.wave, NGW = F.G * 8;
        for (int row = gw; row < M_LAT; row += NGW) {
            for (int c = F.lane; c < D; c += 64) { float s = 0.f;
                if (DBG_STOP <= 6 && !(DBG_STOP == 4 && DBG_SUB == 1)) { for (int j = 0; j < 9; ++j) s += bf2f(Z[(size_t)row * ZC + c + 1024 * j]); }
                if (DBG_STOP == 2) { if (c < 16) s += WSP(float, WS_GATES)[(size_t)row * 16 + c]; }
                if (DBG_STOP == 3) s += bf2f(WSP(bf16_t, WS_SCM)[((size_t)((row / SEQ) * 1024 + c)) * SEQ + (row % SEQ)]);
                if (DBG_STOP == 4 && DBG_SUB == 1) s += bf2f(WSP(bf16_t, WS_H)[((size_t)((row / SEQ) * 1024 + c)) * SEQ + (row % SEQ)]);
                if (DBG_STOP == 6) s += bf2f(WSP(bf16_t, WS_H)[(size_t)row * D + c]);
                if (DBG_STOP == 8) { s = x1[(size_t)row * D + c]; if (c < 4) { const Route r = WSP(Route, WS_ROUTE)[row]; s += c == 0 ? (float)r.e0 : c == 1 ? (float)r.e1 : c == 2 ? r.w0 : r.w1; } }
                if (DBG_STOP == 11) { const int sl0 = WSP(int, WS_TOKSLOT)[2 * row], sl1 = WSP(int, WS_TOKSLOT)[2 * row + 1]; s = bf2f(WSP(bf16_t, WS_XS)[(size_t)sl0 * D + c]) + bf2f(WSP(bf16_t, WS_XS)[(size_t)sl1 * D + c]); }
                args.out[(size_t)row * D + c] = s; }
        }
    }
#endif
#undef IN
#undef SEAM
}

extern "C" void kernel_launch(void* const* d_in, const int* in_sizes, int n_in, void* d_out, int out_size, void* d_ws, size_t ws_size, hipStream_t stream) {
    static int grid = 0;
    if (grid == 0) {
        if (n_in != 32 || in_sizes[0] != M_LAT * D || out_size != M_LAT * D || ws_size < WS_END) {
            fprintf(stderr, "kernel_launch: unexpected problem (n_in %d, in0 %d, out %d, ws %zu < %zu?)\n", n_in, n_in > 0 ? in_sizes[0] : -1, out_size, ws_size, (size_t)WS_END); grid = -1; return; }
        int dev = 0, cus = 0, per_cu = 0;
        if (hipGetDevice(&dev) != hipSuccess || hipDeviceGetAttribute(&cus, hipDeviceAttributeMultiprocessorCount, dev) != hipSuccess) { grid = -1; return; }
        if (hipFuncSetAttribute((const void*)fwd_kernel, hipFuncAttributeMaxDynamicSharedMemorySize, LDS_BYTES) != hipSuccess) { fprintf(stderr, "kernel_launch: hipFuncSetAttribute failed\n"); grid = -1; return; }
        if (hipOccupancyMaxActiveBlocksPerMultiprocessor(&per_cu, (const void*)fwd_kernel, 512, LDS_BYTES) != hipSuccess || per_cu < 1) { fprintf(stderr, "kernel_launch: occupancy query says %d\n", per_cu); per_cu = 1; }
        (void)hipGetLastError();
        grid = cus;
    }
    if (grid < 0) return;
    (void)hipMemsetAsync((char*)d_ws + WS_CTL, 0, CTL_ZERO_BYTES, stream);
    Args a{};
    const float** ip = (const float**)&a.in;
    for (int i = 0; i < 32; ++i) ip[i] = (const float*)d_in[i];
    a.out = (float*)d_out; a.ws = (unsigned char*)d_ws;
#if MK_PER_PHASE
#ifdef DBG_STOP
    for (int p = 0; p <= DBG_STOP; ++p) { a.ph_lo = p; a.ph_hi = p + 1; hipLaunchKernelGGL(fwd_kernel, dim3(grid), dim3(512), LDS_BYTES, stream, a); }
    a.ph_lo = 13; a.ph_hi = 14; hipLaunchKernelGGL(fwd_kernel, dim3(grid), dim3(512), LDS_BYTES, stream, a);
#else
    for (int p = 0; p < N_PHASES; ++p) { a.ph_lo = p; a.ph_hi = p + 1; hipLaunchKernelGGL(fwd_kernel, dim3(grid), dim3(512), LDS_BYTES, stream, a); }
#endif
#else
    a.ph_lo = 0; a.ph_hi = N_PHASES;
    hipLaunchKernelGGL(fwd_kernel, dim3(grid), dim3(512), LDS_BYTES, stream, a);
#endif
}
```

```cpp
#include <hip/hip_runtime.h>
#include <cstdio>
#include <cstdint>

#define LAS __attribute__((address_space(3)))
#define GAS __attribute__((address_space(1)))
typedef unsigned short bf16_t;
typedef short bf16x8 __attribute__((ext_vector_type(8)));
typedef short s16x4 __attribute__((ext_vector_type(4)));
typedef float f32x4 __attribute__((ext_vector_type(4)));
typedef float f32x2 __attribute__((ext_vector_type(2)));
typedef unsigned u32x4 __attribute__((ext_vector_type(4)));
typedef unsigned u32x2 __attribute__((ext_vector_type(2)));
typedef GAS unsigned gu32;

constexpr int D = 1024, BATCH = 2, SEQ = 8192, CTXL = 256;
constexpr int M_LAT = BATCH * SEQ, M_CTX = BATCH * CTXL, M_ALL = M_LAT + M_CTX;
constexpr int IN_COLS = 9232, IG0 = 4096, HY0 = 4112, GA0 = 7184, GB0 = 8208;
constexpr int ZC = 9216;
constexpr int ZC_X0 = 4096, ZC_PAIR = 5120, ZC_GA = 7168, ZC_GB = 8192;
constexpr int N_IN = 9472;
constexpr int NEXP = 64, DEXP = 512;
constexpr float EPS = 1e-6f;
constexpr int MAX_TILES = 192, MAX_SLOTS = MAX_TILES * 256;

constexpr size_t MiB = 1u << 20;
constexpr size_t WS_CTL = 0, CTL_ZERO_BYTES = 1 * MiB;
constexpr size_t WS_MODS = 1 * MiB;
constexpr size_t WS_BIASP = WS_MODS + 81920;
constexpr size_t WS_CST = WS_MODS + 122880;
constexpr size_t WS_RSTD2 = WS_MODS + 131072;
constexpr size_t WS_ROUTE = WS_MODS + 262144;
constexpr size_t WS_TOKSLOT = WS_MODS + 524288;
constexpr size_t WS_BLKCNT = WS_MODS + 196608;
constexpr size_t WS_W72S = WS_MODS + 720896;
constexpr size_t WS_GATES = 2 * MiB;
constexpr size_t WS_HID2 = 4 * MiB;
constexpr size_t WS_WIN_T = 8 * MiB;
constexpr size_t WS_WA2_T = 27 * MiB;
constexpr size_t WS_WB_T = 31 * MiB;
constexpr size_t WS_WOUT_T = 33 * MiB;
constexpr size_t WS_W3S = 35 * MiB;
constexpr size_t WS_H = 36 * MiB;
constexpr size_t WS_FSPEC = 70 * MiB;
constexpr int FS_PITCH = 8200;
constexpr size_t WS_SCM = 136 * MiB;
constexpr size_t WS_Z = 168 * MiB;
constexpr size_t WS_W13T = 168 * MiB;
constexpr size_t WS_W2T = 296 * MiB;
constexpr size_t WS_XS = 360 * MiB;
constexpr size_t WS_S0T = 466 * MiB;
constexpr size_t WS_QKC = 484 * MiB;
constexpr size_t WS_FILT = 486 * MiB;
constexpr size_t WS_END = 518 * MiB;
static_assert(WS_Z + (size_t)M_ALL * ZC * 2 <= WS_END && WS_XS + (size_t)MAX_SLOTS * 1024 * 2 <= WS_END, "ws map");
static_assert(WS_FSPEC + (size_t)1024 * FS_PITCH * 8 <= WS_SCM && WS_H + (size_t)M_ALL * D * 2 <= WS_FSPEC, "ws map");
constexpr int CW_BAR = 4096;
constexpr int CW_CNT = 16384, CW_CUR = 16384 + 64;
constexpr int CW_Q0 = 16384 + 256, CW_Q1 = 16384 + 320;
constexpr int CW_SUB = 20480;

constexpr int LDS_BYTES = 160 * 1024;
constexpr int MISC_OFF = 159 * 1024;

#define RLX_AGENT __ATOMIC_RELAXED, __HIP_MEMORY_SCOPE_AGENT
__device__ __forceinline__ unsigned f2bf(float f) { unsigned u = __builtin_bit_cast(unsigned, f); return (u + 0x7fffu + ((u >> 16) & 1u)) >> 16; }
__device__ __forceinline__ unsigned pk2(float lo, float hi) { return f2bf(lo) | (f2bf(hi) << 16); }
__device__ __forceinline__ float bf2f(unsigned short u) { return __builtin_bit_cast(float, (unsigned)u << 16); }
__device__ __forceinline__ float bflo(unsigned w) { return __builtin_bit_cast(float, w << 16); }
__device__ __forceinline__ float bfhi(unsigned w) { return __builtin_bit_cast(float, w & 0xffff0000u); }
__device__ __forceinline__ float sigmoidf_(float x) { return __builtin_amdgcn_rcpf(1.0f + __expf(-x)); }
__device__ __forceinline__ float siluf_(float x) { return x * __builtin_amdgcn_rcpf(1.0f + __expf(-x)); }
__device__ __forceinline__ float wave_sum(float v) {
#pragma unroll
    for (int o = 1; o < 64; o <<= 1) v += __shfl_xor(v, o);
    return v;
}

namespace pg8 {
#define PG8_LAS __attribute__((address_space(3)))
constexpr int BM = 256, BK = 64, HALF = 128, HTB = HALF * BK * 2, STAGE_BYTES = 8 * HTB, NXCD = 8, WGM = 8;
__host__ __device__ __forceinline__ int lds_byte(int r, int c) { const int st = (r >> 4) * 2 + (c >> 5), rr = r & 15, cc = c & 31, ob = rr * 64 + cc * 2; return st * 1024 + (ob ^ (((ob >> 9) & 1) << 5)); }
__host__ __device__ __forceinline__ void stage_rc(int b, int& R, int& C) { const int st = b / 1024, sb = b % 1024, swz = sb ^ (((sb >> 9) & 1) << 5); R = (st >> 1) * 16 + swz / 64; C = (st & 1) * 32 + (swz % 64) / 2; }
__host__ __device__ __forceinline__ int perm32(int rho) { const int n = rho >> 4, i = rho & 15; return 8 * (i >> 2) + 4 * n + (i & 3); }

struct Unit { long aoff, boff; int pm, pn, e, pad; };
struct Gemm { const bf16_t* A; const bf16_t* Bt; int lda, ldb, K; };

struct StaticOrder {
    int nM, nN, nwg, G, c; long astep, bstep;
    __device__ void init(int nM_, int nN_, int G_, int c_, long astep_, long bstep_) { nM = nM_; nN = nN_; nwg = nM * nN; G = G_; c = c_; astep = astep_; bstep = bstep_; }
    __device__ bool map(long L, Unit& u) const {
        if (L >= nwg) return false;
        int wgid = (int)L; { const int q = nwg / NXCD, r = nwg % NXCD, xcd = wgid % NXCD, off = wgid / NXCD; wgid = (xcd < r ? xcd * (q + 1) : r * (q + 1) + (xcd - r) * q) + off; }
        const int nig = WGM * nN, gid = wgid / nig, fm = gid * WGM, gsz = (nM - fm) < WGM ? (nM - fm) : WGM;
        u.pm = fm + ((wgid % nig) % gsz); u.pn = (wgid % nig) / gsz; u.e = 0; u.pad = 0; u.aoff = u.pm * astep; u.boff = u.pn * bstep; return true;
    }
    __device__ bool next(int i, Unit& u) const { return map((long)i * G + c, u); }
};

typedef __bf16 bf16v2_t __attribute__((ext_vector_type(2)));
__device__ __forceinline__ unsigned cvt_pk_bf16(float lo, float hi) { const bf16v2_t v = __builtin_convertvector((f32x2){lo, hi}, bf16v2_t); return __builtin_bit_cast(unsigned, v); }

template <class Epi, class Sched, bool ALIGN_EPI>
__device__ __forceinline__ void gemm_phase(PG8_LAS unsigned char* lds, const Gemm g, const Sched& S, const Epi& E) {
    const int tid = threadIdx.x, wid = __builtin_amdgcn_readfirstlane(tid >> 6), lane = tid & 63, wr = wid >> 2, wc = wid & 3, fr = lane & 15, fq = lane >> 4;
    const int K = g.K, nt = K / BK;
    unsigned voffA[2], voffB[2];
#pragma unroll
    for (int i = 0; i < 2; ++i) { int R, C; stage_rc(tid * 16 + i * 8192, R, C); const int Rb = Epi::PERM ? ((R & ~31) + perm32(R & 31)) : R;
        voffA[i] = (unsigned)(R * g.lda + C) * 2u; voffB[i] = (unsigned)(Rb * g.ldb + C) * 2u; }
    const size_t kstep = (size_t)(BK * 2);
    const size_t hstepA = (size_t)HALF * g.lda * 2, hstepB = (size_t)HALF * g.ldb * 2;
    const unsigned ldsw = (unsigned)wid * 1024u;
    const int aoff = lds_byte(wr * 64 + fr, fq * 8), boff = lds_byte(wc * 32 + fr, fq * 8);
#define PG8_SA(b, h) (((b) * 2 + (h)) * HTB)
#define PG8_SB(b, h) ((4 + (b) * 2 + (h)) * HTB)
#define PG8_STAGE(bufoff, gbase, voff) do { _Pragma("unroll") for (int _i = 0; _i < 2; ++_i) \
        __builtin_amdgcn_global_load_lds((const unsigned*)((const char*)(gbase) + (voff)[_i]), (PG8_LAS unsigned*)(lds + (bufoff) + ldsw + _i * 8192), 16, 0, 0); } while (0)
#define PG8_LDA(dst, b, h) do { _Pragma("unroll") for (int m = 0; m < 4; ++m) _Pragma("unroll") for (int k = 0; k < 2; ++k) dst[m][k] = *(const PG8_LAS bf16x8*)(lds + PG8_SA(b, h) + aoff + m * 2048 + k * 1024); } while (0)
#define PG8_LDB(dst, b, h) do { _Pragma("unroll") for (int n = 0; n < 2; ++n) _Pragma("unroll") for (int k = 0; k < 2; ++k) dst[n][k] = *(const PG8_LAS bf16x8*)(lds + PG8_SB(b, h) + boff + n * 2048 + k * 1024); } while (0)
#define PG8_MMA(ai, bj, At, Bt) do { __builtin_amdgcn_s_setprio(1); _Pragma("unroll") for (int m = 0; m < 4; ++m) _Pragma("unroll") for (int n = 0; n < 2; ++n) _Pragma("unroll") for (int k = 0; k < 2; ++k) \
        acc[ai][bj][m][n] = __builtin_amdgcn_mfma_f32_16x16x32_bf16(Bt[n][k], At[m][k], acc[ai][bj][m][n], 0, 0, 0); __builtin_amdgcn_s_setprio(0); } while (0)
#define PG8_WAIT_V(n) asm volatile("s_waitcnt vmcnt(" #n ")" ::: "memory")
#define PG8_WAIT_L(n) asm volatile("s_waitcnt lgkmcnt(" #n ")" ::: "memory")
#define PG8_BAR __builtin_amdgcn_s_barrier()
#define PG8_SCHED __builtin_amdgcn_sched_barrier(0)
    Unit cur, nxt; int ui = 0;
    if (!S.next(0, cur)) return;
    f32x4 acc[2][2][4][2];
#pragma unroll
    for (int a = 0; a < 2; ++a)
#pragma unroll
        for (int b = 0; b < 2; ++b)
#pragma unroll
            for (int m = 0; m < 4; ++m)
#pragma unroll
                for (int n = 0; n < 2; ++n) acc[a][b][m][n] = (f32x4){0.f, 0.f, 0.f, 0.f};
    bf16x8 At[4][2], B0[2][2], B1[2][2];
    const char* cA = (const char*)g.A + cur.aoff; const char* cB = (const char*)g.Bt + cur.boff;
    PG8_STAGE(PG8_SB(0, 0), cB, voffB); PG8_STAGE(PG8_SB(0, 1), cB + hstepB, voffB); PG8_STAGE(PG8_SA(0, 0), cA, voffA); PG8_STAGE(PG8_SA(0, 1), cA + hstepA, voffA);
    if (wr == 1) PG8_BAR;
    PG8_WAIT_V(2); PG8_BAR;
    PG8_STAGE(PG8_SB(1, 0), cB + kstep, voffB); PG8_STAGE(PG8_SA(1, 0), cA + kstep, voffA); PG8_STAGE(PG8_SB(1, 1), cB + hstepB + kstep, voffB);
    PG8_WAIT_V(6); PG8_BAR;
    for (;;) {
        const bool has_next = S.next(ui + 1, nxt);
        const char* nA = has_next ? (const char*)g.A + nxt.aoff : cA; const char* nB = has_next ? (const char*)g.Bt + nxt.boff : cB;
        for (int t = 0; t < nt; t += 2) {
            const bool last = (t == nt - 2);
            const char* a1 = cA + (size_t)(t + 1) * kstep;
            const char* a2 = last ? nA : cA + (size_t)(t + 2) * kstep; const char* b2 = last ? nB : cB + (size_t)(t + 2) * kstep;
            const char* a3 = a2 + kstep; const char* b3 = b2 + kstep;
            PG8_LDB(B0, 0, 0); PG8_LDB(B1, 0, 1); PG8_SCHED; PG8_LDA(At, 0, 0); PG8_STAGE(PG8_SA(1, 1), a1 + hstepA, voffA);
            PG8_WAIT_V(8); PG8_WAIT_L(0); PG8_BAR; PG8_MMA(0, 0, At, B0); PG8_MMA(0, 1, At, B1); PG8_BAR; PG8_SCHED;
            PG8_LDA(At, 0, 1); PG8_STAGE(PG8_SB(0, 0), b2, voffB); PG8_STAGE(PG8_SB(0, 1), b2 + hstepB, voffB); PG8_STAGE(PG8_SA(0, 0), a2, voffA);
            PG8_WAIT_V(8); PG8_WAIT_L(0); PG8_BAR; PG8_MMA(1, 0, At, B0); PG8_MMA(1, 1, At, B1); PG8_BAR; PG8_SCHED;
            PG8_LDB(B0, 1, 0); PG8_LDB(B1, 1, 1); PG8_SCHED; PG8_LDA(At, 1, 0); PG8_STAGE(PG8_SA(0, 1), a2 + hstepA, voffA);
            PG8_WAIT_V(8); PG8_WAIT_L(0); PG8_BAR; PG8_MMA(0, 0, At, B0); PG8_MMA(0, 1, At, B1); PG8_BAR; PG8_SCHED;
            PG8_LDA(At, 1, 1); PG8_STAGE(PG8_SB(1, 0), b3, voffB); PG8_STAGE(PG8_SB(1, 1), b3 + hstepB, voffB); PG8_STAGE(PG8_SA(1, 0), a3, voffA);
            PG8_WAIT_V(8); PG8_WAIT_L(0); PG8_BAR; PG8_MMA(1, 0, At, B0); PG8_MMA(1, 1, At, B1); PG8_BAR; PG8_SCHED;
        }
        if constexpr (ALIGN_EPI) { if (wr == 0) PG8_BAR; }
        E(acc, cur, wr, wc, fr, fq);
        if (!has_next) break;
#pragma unroll
        for (int a = 0; a < 2; ++a)
#pragma unroll
            for (int b = 0; b < 2; ++b)
#pragma unroll
                for (int m = 0; m < 4; ++m)
#pragma unroll
                    for (int n = 0; n < 2; ++n) acc[a][b][m][n] = (f32x4){0.f, 0.f, 0.f, 0.f};
        cur = nxt; cA = nA; cB = nB; ++ui;
        if constexpr (ALIGN_EPI) { if (wr == 1) PG8_BAR; }
    }
    PG8_WAIT_V(0);
    if constexpr (!ALIGN_EPI) { if (wr == 0) PG8_BAR; }
    PG8_BAR;
#undef PG8_SA
#undef PG8_SB
#undef PG8_STAGE
#undef PG8_LDA
#undef PG8_LDB
#undef PG8_MMA
#undef PG8_WAIT_V
#undef PG8_WAIT_L
#undef PG8_BAR
#undef PG8_SCHED
}
}

#define XB_TMO      128
#define XB_XCNT(j)  (256  + 64 * (j))
#define XB_XSUB(j)  (1280 + 64 * (j))
#define XB_XGEN(j)  (2304 + 64 * (j))
#define XB_TOP      3328
#define XB_TOPGEN   3392
#define XCD_BAR_WORDS 3456
#define XB_SPIN_CAP (1u << 18)
__device__ __forceinline__ unsigned xb_ld(unsigned* p)              { return __hip_atomic_load(p, __ATOMIC_RELAXED, __HIP_MEMORY_SCOPE_AGENT); }
__device__ __forceinline__ unsigned xb_add(unsigned* p, unsigned v) { return __hip_atomic_fetch_add(p, v, __ATOMIC_RELAXED, __HIP_MEMORY_SCOPE_AGENT); }
__device__ __forceinline__ unsigned xb_xcc_id() { return (unsigned)__builtin_amdgcn_s_getreg((3 << 11) | 20) & 0xFu; }
#define XB_SPIN(cond, bar) do { unsigned _sp = 0; while (cond) { __builtin_amdgcn_s_sleep(1); \
    if ((++_sp & 255u) == 0u) { if (xb_ld(&(bar)[XB_TMO])) break; if (_sp > XB_SPIN_CAP) { atomicAdd(&(bar)[XB_TMO], 1u); break; } } } } while (0)
struct XcdBarrier { unsigned* bar; unsigned x; volatile LAS unsigned* st; };
__device__ __forceinline__ XcdBarrier xcd_barrier_post(unsigned* bar, volatile LAS unsigned* st) {
    XcdBarrier b; b.bar = bar; b.x = xb_xcc_id(); b.st = st;
    if (threadIdx.x == 0) (void)xb_add(&bar[XB_XCNT(b.x)], 1u);
    return b;
}
__device__ __forceinline__ void xcd_barrier_complete(unsigned* bar, unsigned x, unsigned& nloc, unsigned& nx) {
    const unsigned G = gridDim.x * gridDim.y * gridDim.z;
    unsigned sum, cnt, mine, sp = 0u;
    for (;;) {
        sum = 0u; cnt = 0u; mine = 0u;
#pragma unroll
        for (unsigned j = 0; j < 16; ++j) { const unsigned c = xb_ld(&bar[XB_XCNT(j)]); sum += c; cnt += (c > 0u) ? 1u : 0u; mine = (j == x) ? c : mine; }
        if (sum == G) break;
        __builtin_amdgcn_s_sleep(1);
        if ((++sp & 255u) == 0u) { if (xb_ld(&bar[XB_TMO])) break; if (sp > XB_SPIN_CAP) { atomicAdd(&bar[XB_TMO], 1u); break; } }
    }
    nloc = mine > 0u ? mine : 1u; nx = cnt > 0u ? cnt : 1u;
}
__device__ __forceinline__ void xcd_barrier(const XcdBarrier& b) {
    asm volatile("s_waitcnt vmcnt(0)" ::: "memory");
    __syncthreads();
    if (threadIdx.x == 0) {
        unsigned* bar = b.bar;
        __builtin_amdgcn_s_waitcnt(0);
        unsigned nloc = b.st[0], nx = b.st[1];
        if (nloc == 0u) { xcd_barrier_complete(bar, b.x, nloc, nx); b.st[0] = nloc; b.st[1] = nx; }
        const unsigned old = xb_add(&bar[XB_XSUB(b.x)], 1u);
        const unsigned gen = old / nloc;
        if (old + 1u == (gen + 1u) * nloc) {
            __builtin_amdgcn_fence(__ATOMIC_RELEASE, "agent");
            asm volatile("s_waitcnt vmcnt(0)" ::: "memory");
            const unsigned og = xb_add(&bar[XB_TOP], 1u);
            const unsigned tg = og / nx;
            if (og + 1u == (tg + 1u) * nx) xb_add(&bar[XB_TOPGEN], 1u);
            else XB_SPIN(xb_ld(&bar[XB_TOPGEN]) == tg, bar);
            __builtin_amdgcn_fence(__ATOMIC_ACQUIRE, "agent");
            xb_add(&bar[XB_XGEN(b.x)], 1u);
            asm volatile("s_waitcnt vmcnt(0)" ::: "memory");
        } else {
            XB_SPIN(xb_ld(&bar[XB_XGEN(b.x)]) == gen, bar);
            __builtin_amdgcn_fence(__ATOMIC_ACQUIRE, "agent");
            asm volatile("s_waitcnt vmcnt(0)" ::: "memory");
        }
    }
    __syncthreads();
}

__device__ __forceinline__ void subgrid_barrier(unsigned* cnt, unsigned n, unsigned round) {
    asm volatile("s_waitcnt vmcnt(0)" ::: "memory");
    __syncthreads();
    if (threadIdx.x == 0) {
        __builtin_amdgcn_fence(__ATOMIC_RELEASE, "agent");
        asm volatile("s_waitcnt vmcnt(0)" ::: "memory");
        xb_add(cnt, 1u);
        unsigned sp = 0;
        while (xb_ld(cnt) < n * round) { __builtin_amdgcn_s_sleep(2); if (++sp > (1u << 22)) break; }
        __builtin_amdgcn_fence(__ATOMIC_ACQUIRE, "agent");
        asm volatile("s_waitcnt vmcnt(0)" ::: "memory");
    }
    __syncthreads();
}

struct Inputs {
    const float *x, *c, *ctx, *c_ctx, *w_mod, *b_mod, *g_norm1, *g_norm2, *w_in, *b_in, *w_qk_conv, *b_qk_conv, *w_h_conv, *b_h_conv,
        *hf_w1, *hf_b1, *hf_w2, *hf_b2, *hf_w3, *hf_freq, *h_bias, *w_a, *w_b, *w_out, *w_group, *b_group, *w_router, *b_router, *w1_e, *w3_e, *w2_e, *g_final;
};
struct Args { Inputs in; float* out; unsigned char* ws; int ph_lo, ph_hi; };
struct Frame {
    LAS unsigned char* lds;
    int tid, lane, wave, vcu, G;
    unsigned char* ws;
};
#define WSP(T, off) ((T*)(F.ws + (off)))

__device__ __forceinline__ int win_src(int rho) {
    if (rho < 4096) return rho;
    if (rho < ZC_PAIR) return HY0 + (rho - ZC_X0);
    if (rho < ZC_GA) { const int t = rho - ZC_PAIR, p = t >> 8, bj = (t >> 7) & 1, j = t & 127; return HY0 + 1024 + bj * 1024 + 128 * p + j; }
    if (rho < ZC_GB) return GA0 + (rho - ZC_GA);
    if (rho < ZC) return GB0 + (rho - ZC_GB);
    if (rho < ZC + 16) return IG0 + (rho - ZC);
    return -1;
}
template <class SrcCol>
__device__ __forceinline__ void transpose_item(const float* W, int N, int k0, SrcCol scol, bf16_t* WT, int ldt, int drow0, int kdst, LAS float* scr, int lane) {
    const int sc = scol(lane & 31);
#pragma unroll 16
    for (int i = 0; i < 32; ++i) { const int kk = 2 * i + (lane >> 5); scr[kk * 33 + (lane & 31)] = sc >= 0 ? W[(size_t)(k0 + kk) * N + sc] : 0.f; }
    asm volatile("s_waitcnt lgkmcnt(0)" ::: "memory");
    const int c = lane & 7;
#pragma unroll
    for (int j = 0; j < 4; ++j) { const int n = (lane >> 3) + 8 * j; const LAS float* s = scr + (8 * c) * 33 + n;
        u32x4 o; o.x = pk2(s[0 * 33], s[1 * 33]); o.y = pk2(s[2 * 33], s[3 * 33]); o.z = pk2(s[4 * 33], s[5 * 33]); o.w = pk2(s[6 * 33], s[7 * 33]);
        *(u32x4*)(WT + (size_t)(drow0 + n) * ldt + kdst + 8 * c) = o; }
    asm volatile("s_waitcnt lgkmcnt(0)" ::: "memory");
}


__device__ __forceinline__ void weight_transposes(Frame& F, const Inputs& I, int which, int wg, int nwg) {
    LAS float* scr = (LAS float*)(F.lds + F.wave * 16384);
    const int gw = wg * 8 + F.wave, NGW = nwg * 8;
    {
        constexpr int I_IN = (D / 64) * (N_IN / 32), I_SQ = (D / 64) * (D / 32);
        const int lo = which == 0 ? 0 : I_IN, hi = which == 0 ? I_IN : I_IN + 3 * I_SQ;
        for (int it = lo + gw; it < hi; it += NGW) {
            int r = it;
            if (r < I_IN) { const int nblk = N_IN / 32, kb = r / nblk, nb = r % nblk;
                transpose_item(I.w_in, IN_COLS, 64 * kb, [&](int i) { return win_src(32 * nb + i); }, WSP(bf16_t, WS_WIN_T), D, 32 * nb, 64 * kb, scr, F.lane); continue; }
            r -= I_IN;
            const int m = r / I_SQ, rr = r % I_SQ, kb = rr / 32, nb = rr % 32;
            if (m == 0) { transpose_item(I.w_a, D, 64 * kb, [&](int i) { return 32 * nb + i; }, WSP(bf16_t, WS_WA2_T), 2 * D, 32 * nb, 64 * kb, scr, F.lane);
                          transpose_item(I.w_a, D, 64 * kb, [&](int i) { return 32 * nb + i; }, WSP(bf16_t, WS_WA2_T), 2 * D, 32 * nb, D + 64 * kb, scr, F.lane); }
            else if (m == 1) transpose_item(I.w_b, D, 64 * kb, [&](int i) { return 32 * nb + i; }, WSP(bf16_t, WS_WB_T), D, 32 * nb, 64 * kb, scr, F.lane);
            else transpose_item(I.w_out, D, 64 * kb, [&](int i) { return 32 * nb + i; }, WSP(bf16_t, WS_WOUT_T), D, 32 * nb, 64 * kb, scr, F.lane);
        }
    }
    __syncthreads();
}
__device__ __forceinline__ void phase0(Frame& F, const Inputs& I) {
    LAS float* scr = (LAS float*)(F.lds + F.wave * 16384);
    const int gw = F.vcu * 8 + F.wave, NGW = F.G * 8;
    {
        LAS float* red = (LAS float*)F.lds;
        LAS float* sl = red + 8 * 3 * 32;
        float* mods = WSP(float, WS_MODS);
        for (int i = F.tid; i < 3 * 1024; i += 512) { const int v = i >> 10, k = i & 1023; sl[i] = siluf_(v == 0 ? I.c[k] : v == 1 ? I.c[D + k] : I.c_ctx[k]); }
        __syncthreads();
        for (int it = F.vcu; it < 256; it += F.G) {
            const int col = F.lane & 31, kr = F.lane >> 5, n = it * 24 + col; const bool act = col < 24;
            float a0 = 0.f, a1 = 0.f, a2 = 0.f;
#pragma unroll 16
            for (int i = 0; i < 64; ++i) { const int k = F.wave * 128 + 2 * i + kr; const float w = act ? I.w_mod[(size_t)k * 6144 + n] : 0.f;
                a0 += sl[k] * w; a1 += sl[1024 + k] * w; a2 += sl[2048 + k] * w; }
            a0 += __shfl_xor(a0, 32); a1 += __shfl_xor(a1, 32); a2 += __shfl_xor(a2, 32);
            if (F.lane < 32) { red[(F.wave * 3 + 0) * 32 + col] = a0; red[(F.wave * 3 + 1) * 32 + col] = a1; red[(F.wave * 3 + 2) * 32 + col] = a2; }
            __syncthreads();
            if (F.tid < 96) { const int v = F.tid >> 5, l = F.tid & 31; float s = 0.f;
#pragma unroll
                for (int w = 0; w < 8; ++w) s += red[(w * 3 + v) * 32 + l];
                if (l < 24) mods[v * 6144 + it * 24 + l] = s + I.b_mod[it * 24 + l]; }
            __syncthreads();
        }
    }
    __syncthreads();
    for (int i = F.vcu * 512 + F.tid; i < N_IN; i += F.G * 512) { const int s = win_src(i); WSP(float, WS_BIASP)[i] = s >= 0 ? I.b_in[s] : 0.f; }
    for (int i = F.vcu * 512 + F.tid; i < 80 * 2048; i += F.G * 512) { const int col = i >> 11, which = (i >> 10) & 1, k = i & 1023;
        const float v = col < 8 ? I.w_group[k * 8 + col] : col < 72 ? I.w_router[k * 64 + (col - 8)] : 0.f;
        const unsigned hi = f2bf(v); WSP(bf16_t, WS_W72S)[i] = (bf16_t)(which ? f2bf(v - bf2f((unsigned short)hi)) : hi); }
    {
        bf16_t* hids = WSP(bf16_t, WS_HID2);
        const int j = F.lane;
        const float fr = I.hf_freq[j], b1 = I.hf_b1[j], b2 = I.hf_b2[j];
        for (int pos = gw; pos < SEQ; pos += NGW) {
            const float t = (float)pos / (float)(SEQ - 1);
            float a = b1 + t * I.hf_w1[0 * 64 + j];
#pragma unroll 4
            for (int i = 0; i < 16; ++i) { const float band = 1e-4f + (float)i * ((15.0f - 1e-4f) / 15.0f);
                const float rev = ((float)pos * (1.0f / (float)SEQ)) * band;
                const float sn = __builtin_amdgcn_sinf(rev), cs = __builtin_amdgcn_cosf(rev);
                a += cs * I.hf_w1[(1 + i) * 64 + j] - sn * I.hf_w1[(17 + i) * 64 + j]; }
            const float h1 = __builtin_amdgcn_sinf(fr * a * 0.15915494309189535f);
            float a2 = b2;
#pragma unroll 8
            for (int i = 0; i < 64; ++i) a2 += __shfl(h1, i) * I.hf_w2[i * 64 + j];
            const float h2 = __builtin_amdgcn_sinf(fr * a2 * 0.15915494309189535f);
            const unsigned hi = f2bf(h2), lo = f2bf(h2 - bf2f((unsigned short)hi));
            bf16_t* hp = hids + (size_t)pos * 256;
            hp[j] = (bf16_t)hi; hp[64 + j] = (bf16_t)hi; hp[128 + j] = (bf16_t)lo; hp[192 + j] = 0;
        }
        bf16_t* w3s = WSP(bf16_t, WS_W3S);
        for (int i = F.vcu * 512 + F.tid; i < 2048 * 64; i += F.G * 512) { const int h = i >> 11, col = i & 2047;
            const float wv = I.hf_w3[i]; const unsigned hi = f2bf(wv), lo = f2bf(wv - bf2f((unsigned short)hi));
            bf16_t* wp = w3s + (size_t)col * 256;
            wp[h] = (bf16_t)hi; wp[64 + h] = (bf16_t)lo; wp[128 + h] = (bf16_t)hi; wp[192 + h] = 0; }
    }
}

constexpr int FFT_N = 16384;
__device__ __forceinline__ int PADI(int i) { return i + (i >> 5); }
__device__ __forceinline__ constexpr int bitrev(int x, int bits) { int r = 0; for (int i = 0; i < bits; ++i) r = (r << 1) | ((x >> i) & 1); return r; }
template <int R, int LOG2R>
__device__ __forceinline__ void dft_dif(f32x2 (&v)[R]) {
    constexpr float C32[16] = {1.000000000e+00f, 9.807852804e-01f, 9.238795325e-01f, 8.314696123e-01f, 7.071067812e-01f, 5.555702330e-01f, 3.826834324e-01f, 1.950903220e-01f,
                               0.0f, -1.950903220e-01f, -3.826834324e-01f, -5.555702330e-01f, -7.071067812e-01f, -8.314696123e-01f, -9.238795325e-01f, -9.807852804e-01f};
    constexpr float S32[16] = {0.0f, 1.950903220e-01f, 3.826834324e-01f, 5.555702330e-01f, 7.071067812e-01f, 8.314696123e-01f, 9.238795325e-01f, 9.807852804e-01f,
                               1.0f, 9.807852804e-01f, 9.238795325e-01f, 8.314696123e-01f, 7.071067812e-01f, 5.555702330e-01f, 3.826834324e-01f, 1.950903220e-01f};
#pragma unroll
    for (int st = 0; st < LOG2R; ++st) {
        const int half = R >> (st + 1);
#pragma unroll
        for (int blk = 0; blk < R; blk += 2 * half)
#pragma unroll
            for (int i = 0; i < half; ++i) {
                const f32x2 a = v[blk + i], b = v[blk + i + half];
                v[blk + i] = a + b;
                const f32x2 t = a - b;
                const int ti = i * (16 / half);
                if (ti == 0) v[blk + i + half] = t;
                else if (ti == 8) v[blk + i + half] = (f32x2){t.y, -t.x};
                else { const float c = C32[ti], s = S32[ti]; v[blk + i + half] = (f32x2){t.x * c + t.y * s, t.y * c - t.x * s}; }
            }
    }
}
__device__ __forceinline__ f32x2 cmul(f32x2 a, f32x2 b) { return (f32x2){a.x * b.x - a.y * b.y, a.x * b.y + a.y * b.x}; }
__device__ __forceinline__ f32x2 twid(float frac) { return (f32x2){__builtin_amdgcn_cosf(frac), -__builtin_amdgcn_sinf(frac)}; }
__device__ __forceinline__ void fft_pass_a_store(f32x2 (&v)[32], LAS f32x2* X, int j) {
    dft_dif<32, 5>(v);
    int jq = j; asm volatile("" : "+v"(jq));
    LAS f32x2* xb = X + 33 * jq;
#pragma unroll
    for (int p = 0; p < 32; ++p) xb[bitrev(p, 5)] = v[p];
}
__device__ __forceinline__ void fft_load32(f32x2 (&v)[32], const LAS f32x2* X, int j) {
    int jq = j; asm volatile("" : "+v"(jq));
    const LAS f32x2* xb = X + jq + (jq >> 5);
#pragma unroll
    for (int r = 0; r < 32; ++r) v[r] = xb[528 * r];
}
__device__ __forceinline__ void fft_pass_b(LAS f32x2* X, int j) {
    f32x2 v[32]; fft_load32(v, X, j);
    int jo = j; asm volatile("" : "+v"(jo));
    const int k = jo & 31; const float f1 = (float)k * (1.0f / 1024.0f);
    j = jo;
#pragma unroll
    for (int r = 1; r < 32; ++r) v[r] = cmul(v[r], twid((float)r * f1));
    dft_dif<32, 5>(v);
    __syncthreads();
    LAS f32x2* xb = X + (j >> 5) * 1056 + k;
#pragma unroll
    for (int p = 0; p < 32; ++p) xb[33 * bitrev(p, 5)] = v[p];
}
__device__ __forceinline__ void fft_pass_c_compute(f32x2 (&v)[32], const LAS f32x2* X, int tid) {
#pragma unroll
    for (int u = 0; u < 2; ++u) {
        int jj = tid + 512 * u; asm volatile("" : "+v"(jj)); f32x2 w[16];
#pragma unroll
        for (int r = 0; r < 16; ++r) w[r] = X[jj + (jj >> 5) + 1056 * r];
        const float f1 = (float)jj * (1.0f / 16384.0f);
#pragma unroll
        for (int r = 1; r < 16; ++r) w[r] = cmul(w[r], twid((float)r * f1));
        dft_dif<16, 4>(w);
#pragma unroll
        for (int p = 0; p < 16; ++p) v[16 * u + p] = w[p];
    }
}

__device__ __forceinline__ void filter_spec_item(Frame& F, const Inputs& I, int pair) {
    const int c = 2 * pair, tid = F.tid;
    LAS f32x2* X = (LAS f32x2*)F.lds;
    LAS float* red = (LAS float*)(F.lds + 140 * 1024);
    const _Float16* filt = WSP(_Float16, WS_FILT);
    float ss0 = 0.f, ss1 = 0.f;
    for (int i = 0; i < 16; ++i) {
        const int lag = tid + 512 * i;
        const float f0 = (float)filt[(size_t)c * SEQ + lag], f1 = (float)filt[(size_t)(c + 1) * SEQ + lag], g0 = (float)filt[(size_t)(1024 + c) * SEQ + lag], g1 = (float)filt[(size_t)(1025 + c) * SEQ + lag];
        X[PADI(lag)] = (f32x2){f0, f1}; ss0 += f0 * f0; ss1 += f1 * f1;
        if (lag >= 1) { X[PADI(FFT_N - lag)] = (f32x2){g0, g1}; ss0 += g0 * g0; ss1 += g1 * g1; }
    }
    if (tid == 0) X[PADI(8192)] = (f32x2){0.f, 0.f};
    ss0 = wave_sum(ss0); ss1 = wave_sum(ss1);
    if (F.lane == 0) { red[F.wave * 2] = ss0; red[F.wave * 2 + 1] = ss1; }
    __syncthreads();
    float t0 = 0.f, t1 = 0.f;
#pragma unroll
    for (int w = 0; w < 8; ++w) { t0 += red[2 * w]; t1 += red[2 * w + 1]; }
    const float sc0 = (1.0f / sqrtf(t0 + EPS)) * (1.0f / 16384.0f), sc1 = (1.0f / sqrtf(t1 + EPS)) * (1.0f / 16384.0f);
    {   f32x2 v[32]; fft_load32(v, X, tid); __syncthreads(); fft_pass_a_store(v, X, tid); }
    __syncthreads();
    fft_pass_b(X, tid);
    __syncthreads();
    {   f32x2 v[32]; fft_pass_c_compute(v, X, tid); __syncthreads();
#pragma unroll
        for (int u = 0; u < 2; ++u) { int jj = tid + 512 * u; asm volatile("" : "+v"(jj)); LAS f32x2* xb = X + jj + (jj >> 5);
#pragma unroll
            for (int p = 0; p < 16; ++p) xb[1056 * bitrev(p, 4)] = v[16 * u + p]; } }
    __syncthreads();
    f32x2* fs = WSP(f32x2, WS_FSPEC);
    for (int k = tid; k <= 8192; k += 512) {
        const f32x2 zk = X[PADI(k)], zn = X[PADI((FFT_N - k) & (FFT_N - 1))];
        fs[(size_t)c * FS_PITCH + k] = (f32x2){0.5f * (zk.x + zn.x) * sc0, 0.5f * (zk.y - zn.y) * sc0};
        fs[(size_t)(c + 1) * FS_PITCH + k] = (f32x2){0.5f * (zk.y + zn.y) * sc1, -0.5f * (zk.x - zn.x) * sc1};
    }
    __syncthreads();
}
__device__ __forceinline__ void phase0b(Frame& F, const Inputs& I) {
    const int gw = F.vcu * 8 + F.wave, NGW = F.G * 8;
    const float* mods = WSP(float, WS_MODS);
    {
        bf16_t* H = WSP(bf16_t, WS_H);
        for (int row = gw; row < M_ALL; row += NGW) {
            const float* src = row < M_LAT ? I.x + (size_t)row * D : I.ctx + (size_t)(row - M_LAT) * D;
            const float* md = mods + (row < M_LAT ? row / SEQ : 2) * 6144;
            const f32x4* xr = (const f32x4*)src + F.lane;
            f32x4 v[4]; float s = 0.f;
#pragma unroll
            for (int j = 0; j < 4; ++j) { v[j] = xr[64 * j]; s += (v[j].x * v[j].x + v[j].y * v[j].y) + (v[j].z * v[j].z + v[j].w * v[j].w); }
            const float rstd = 1.0f / sqrtf(wave_sum(s) * (1.0f / D) + EPS);
            u32x2* o8 = (u32x2*)(H + (size_t)row * D) + F.lane;
#pragma unroll
            for (int j = 0; j < 4; ++j) { const int k = 4 * F.lane + 256 * j;
                const f32x4 g = *(const f32x4*)(I.g_norm1 + k), sh = *(const f32x4*)(md + k), sc = *(const f32x4*)(md + 1024 + k);
                const f32x4 h = v[j] * rstd * g * (sc + 1.0f) + sh;
                o8[64 * j] = (u32x2){pk2(h.x, h.y), pk2(h.z, h.w)}; }
        }
    }
    for (int it = gw; it < 144; it += NGW) { const int b = it / 72, j = it % 72; const float* sh2 = mods + b * 6144 + 3 * 1024;
        float s = 0.f;
        for (int k = F.lane; k < 1024; k += 64) s += sh2[k] * (j < 8 ? I.w_group[k * 8 + j] : I.w_router[k * 64 + (j - 8)]);
        s = wave_sum(s);
        if (F.lane == 0) WSP(float, WS_CST)[it] = s + (j < 8 ? I.b_group[j] : I.b_router[j - 8]); }
}

using pg8::Unit; using pg8::cvt_pk_bf16;
struct EpiIn {
    static constexpr bool PERM = true;
    bf16_t* Z; const float* bias; float* gates;
    __device__ __forceinline__ void operator()(const f32x4 (&acc)[2][2][4][2], const Unit& u, int wr, int wc, int fr, int fq) const {
        const int row0 = u.pm * 256 + wr * 64 + fr;
        if (u.pn == 36) {
            if (wc == 0 && fq < 2) {
                const f32x4 b0 = *(const f32x4*)(bias + ZC + 8 * fq), b1 = *(const f32x4*)(bias + ZC + 8 * fq + 4);
#pragma unroll
                for (int ai = 0; ai < 2; ++ai)
#pragma unroll
                    for (int m = 0; m < 4; ++m) { float* gp = gates + (size_t)(row0 + ai * 128 + m * 16) * 16 + 8 * fq;
                        *(f32x4*)gp = acc[ai][0][m][0] + b0; *(f32x4*)(gp + 4) = acc[ai][0][m][1] + b1; }
            }
            return;
        }
        const int col0 = u.pn * 256 + wc * 32 + 8 * fq;
        f32x4 bv[2][2];
#pragma unroll
        for (int bj = 0; bj < 2; ++bj)
#pragma unroll
            for (int n = 0; n < 2; ++n) bv[bj][n] = *(const f32x4*)(bias + col0 + bj * 128 + 4 * n);
#pragma unroll
        for (int ai = 0; ai < 2; ++ai)
#pragma unroll
            for (int m = 0; m < 4; ++m) { bf16_t* rowp = Z + (size_t)(row0 + ai * 128 + m * 16) * ZC + col0;
#pragma unroll
                for (int bj = 0; bj < 2; ++bj) { const f32x4 v0 = acc[ai][bj][m][0] + bv[bj][0], v1 = acc[ai][bj][m][1] + bv[bj][1];
                    u32x4 w; w.x = cvt_pk_bf16(v0[0], v0[1]); w.y = cvt_pk_bf16(v0[2], v0[3]); w.z = cvt_pk_bf16(v1[0], v1[1]); w.w = cvt_pk_bf16(v1[2], v1[3]);
                    *(u32x4*)(rowp + bj * 128) = w; } }
    }
};
template <bool STEP_B> struct EpiMerge {
    static constexpr bool PERM = true;
    const bf16_t* Zg; float* T1; bf16_t* G;
    __device__ __forceinline__ void operator()(const f32x4 (&acc)[2][2][4][2], const Unit& u, int wr, int wc, int fr, int fq) const {
        const int row0 = u.pm * 256 + wr * 64 + fr, col0 = u.pn * 256 + wc * 32 + 8 * fq;
#pragma unroll
        for (int ai = 0; ai < 2; ++ai)
#pragma unroll
            for (int m = 0; m < 4; ++m) { const size_t row = (size_t)(row0 + ai * 128 + m * 16);
#pragma unroll
                for (int bj = 0; bj < 2; ++bj) {
                    const int col = col0 + bj * 128;
                    const u32x4 gw = *(const u32x4*)(Zg + row * ZC + col);
                    f32x4 g0 = {sigmoidf_(bflo(gw.x)), sigmoidf_(bfhi(gw.x)), sigmoidf_(bflo(gw.y)), sigmoidf_(bfhi(gw.y))};
                    f32x4 g1 = {sigmoidf_(bflo(gw.z)), sigmoidf_(bfhi(gw.z)), sigmoidf_(bflo(gw.w)), sigmoidf_(bfhi(gw.w))};
                    f32x4 v0 = g0 * acc[ai][bj][m][0], v1 = g1 * acc[ai][bj][m][1];
                    float* tp = T1 + row * D + col;
                    if constexpr (!STEP_B) { *(f32x4*)tp = v0; *(f32x4*)(tp + 4) = v1; }
                    else { v0 += *(const f32x4*)tp; v1 += *(const f32x4*)(tp + 4);
                        u32x4 w; w.x = cvt_pk_bf16(v0[0], v0[1]); w.y = cvt_pk_bf16(v0[2], v0[3]); w.z = cvt_pk_bf16(v1[0], v1[1]); w.w = cvt_pk_bf16(v1[2], v1[3]);
                        *(u32x4*)(G + row * D + col) = w; }
                } }
    }
};
struct EpiRes {
    static constexpr bool PERM = false;
    const float* x; const float* mods; float* out;
    __device__ __forceinline__ void operator()(const f32x4 (&acc)[2][2][4][2], const Unit& u, int wr, int wc, int fr, int fq) const {
        const int row0 = u.pm * 256 + wr * 64 + fr, col0 = u.pn * 256 + wc * 32 + 4 * fq;
        const float* gate = mods + (u.pm * 256 / SEQ) * 6144 + 2 * 1024;
        f32x4 gv[2][2];
#pragma unroll
        for (int bj = 0; bj < 2; ++bj)
#pragma unroll
            for (int n = 0; n < 2; ++n) gv[bj][n] = *(const f32x4*)(gate + col0 + bj * 128 + n * 16);
#pragma unroll
        for (int ai = 0; ai < 2; ++ai)
#pragma unroll
            for (int m = 0; m < 4; ++m) { const size_t off = (size_t)(row0 + ai * 128 + m * 16) * D + col0;
#pragma unroll
                for (int bj = 0; bj < 2; ++bj)
#pragma unroll
                    for (int n = 0; n < 2; ++n) *(f32x4*)(out + off + bj * 128 + n * 16) = *(const f32x4*)(x + off + bj * 128 + n * 16) + gv[bj][n] * acc[ai][bj][m][n]; }
    }
};
struct EpiMoe1 {
    static constexpr bool PERM = true;
    bf16_t* H2;
    __device__ __forceinline__ void operator()(const f32x4 (&acc)[2][2][4][2], const Unit& u, int wr, int wc, int fr, int fq) const {
        const int row0 = u.pm * 256 + wr * 64 + fr, col0 = u.pn * 128 + wc * 32 + 8 * fq;
#pragma unroll
        for (int ai = 0; ai < 2; ++ai)
#pragma unroll
            for (int m = 0; m < 4; ++m) { const size_t row = (size_t)(row0 + ai * 128 + m * 16);
                f32x4 v0, v1;
#pragma unroll
                for (int i = 0; i < 4; ++i) { v0[i] = siluf_(acc[ai][0][m][0][i]) * acc[ai][1][m][0][i]; v1[i] = siluf_(acc[ai][0][m][1][i]) * acc[ai][1][m][1][i]; }
                u32x4 w; w.x = cvt_pk_bf16(v0[0], v0[1]); w.y = cvt_pk_bf16(v0[2], v0[3]); w.z = cvt_pk_bf16(v1[0], v1[1]); w.w = cvt_pk_bf16(v1[2], v1[3]);
                *(u32x4*)(H2 + row * DEXP + col0) = w; }
    }
};
struct EpiBf {
    static constexpr bool PERM = true;
    bf16_t* O; int ldo;
    __device__ __forceinline__ void operator()(const f32x4 (&acc)[2][2][4][2], const Unit& u, int wr, int wc, int fr, int fq) const {
        const int row0 = u.pm * 256 + wr * 64 + fr, col0 = u.pn * 256 + wc * 32 + 8 * fq;
#pragma unroll
        for (int ai = 0; ai < 2; ++ai)
#pragma unroll
            for (int m = 0; m < 4; ++m) { bf16_t* rowp = O + (size_t)(row0 + ai * 128 + m * 16) * ldo + col0;
#pragma unroll
                for (int bj = 0; bj < 2; ++bj) { const f32x4 v0 = acc[ai][bj][m][0], v1 = acc[ai][bj][m][1];
                    u32x4 w; w.x = cvt_pk_bf16(v0[0], v0[1]); w.y = cvt_pk_bf16(v0[2], v0[3]); w.z = cvt_pk_bf16(v1[0], v1[1]); w.w = cvt_pk_bf16(v1[2], v1[3]);
                    *(u32x4*)(rowp + bj * 128) = w; } }
    }
};
struct EpiFilt {
    static constexpr bool PERM = false;
    _Float16* FILT;
    __device__ __forceinline__ void operator()(const f32x4 (&acc)[2][2][4][2], const Unit& u, int wr, int wc, int fr, int fq) const {
        typedef _Float16 h16x4 __attribute__((ext_vector_type(4)));
        const int row0 = u.pm * 256 + wr * 64 + fr, col0 = u.pn * 256 + wc * 32 + 4 * fq;
        const float dmin = -4.605170186f / 1.5f, dmax = -4.605170186f / 0.3f;
#pragma unroll
        for (int ai = 0; ai < 2; ++ai)
#pragma unroll
            for (int m = 0; m < 4; ++m) { const int r = row0 + ai * 128 + m * 16;
                const float dc = fabsf(dmin + (float)(r & 1023) * ((dmax - dmin) / 1023.0f)) * (1.0f / (float)(SEQ - 1));
#pragma unroll
                for (int bj = 0; bj < 2; ++bj)
#pragma unroll
                    for (int n = 0; n < 2; ++n) { const int lag = col0 + bj * 128 + n * 16; h16x4 o;
#pragma unroll
                        for (int i = 0; i < 4; ++i) o[i] = (_Float16)(acc[ai][bj][m][n][i] * __expf(-(float)(lag + i) * dc));
                        *(h16x4*)(FILT + (size_t)r * SEQ + lag) = o; } }
    }
};
struct InOrder {
    pg8::StaticOrder so; int G, c;
    __device__ bool next(int i, Unit& u) const {
        long L = (long)i * G + c;
        if (L < 64 * 37) return so.map(L, u);
        L -= 64 * 37; if (L >= 26) return false;
        const int j = (int)(L % 13); u.pm = 64 + (int)(L / 13); u.pn = j < 12 ? j : 36; u.e = 0; u.pad = 0; u.aoff = u.pm * so.astep; u.boff = u.pn * so.bstep; return true;
    }
};
struct MoeOrder {
    const LAS int* tile_e; int ntiles, G, c; long astep, bstep, estep;
    __device__ bool next(int i, Unit& u) const {
        const long L = (long)i * G + c; if (L >= (long)ntiles * 4) return false;
        u.pm = (int)(L >> 2); u.pn = (int)(L & 3); u.e = tile_e[u.pm]; u.pad = 0; u.aoff = u.pm * astep; u.boff = u.e * estep + u.pn * bstep; return true;
    }
};

__device__ __forceinline__ void qk_item(Frame& F, const Inputs& I, int b, int head, int ci) {
    constexpr int RPITCH = 1040, QP = 528, O_RAW = 0, O_QS = 69632, O_KS = 103424;
    bf16_t* Z = WSP(bf16_t, WS_Z); bf16_t* QKC = WSP(bf16_t, WS_QKC);
    LAS unsigned char* L = F.lds;
    const int tid = F.tid, lane = F.lane, w = F.wave, fr = lane & 15, fq = lane >> 4;
    const bool is_ctx = ci < 4; const int j = is_ctx ? ci : ci - 4;
    const int rbase = is_ctx ? M_LAT + b * CTXL : b * SEQ, t0 = 64 * j;
    const int seg_lo = is_ctx ? 0 : t0, seg_hi = is_ctx ? CTXL : t0 + 64;
    for (int id = tid; id < 66 * 64; id += 512) { const int r = id >> 6, c = id & 63, t = t0 - 1 + r;
        u32x4 v = {0u, 0u, 0u, 0u};
        if (t >= seg_lo && t < seg_hi) v = *(const u32x4*)(Z + (size_t)(rbase + t) * ZC + (c >> 5) * 1024 + head * 256 + 8 * (c & 31));
        *(LAS u32x4*)(L + O_RAW + r * RPITCH + c * 16) = v; }
    const int cc = tid & 63, colabs = (cc >> 5) * 1024 + head * 256 + 8 * (cc & 31);
    float wt[3][8], bs[8];
#pragma unroll
    for (int e = 0; e < 8; ++e) { wt[0][e] = I.w_qk_conv[colabs + e]; wt[1][e] = I.w_qk_conv[2048 + colabs + e]; wt[2][e] = I.w_qk_conv[4096 + colabs + e]; bs[e] = I.b_qk_conv[colabs + e]; }
    const float osc = cc >= 32 ? 0.0625f : 1.0f;
    __syncthreads();
#pragma unroll 2
    for (int i = 0; i < 8; ++i) { const int r = (tid >> 6) + 8 * i;
        const u32x4 c0 = *(const LAS u32x4*)(L + O_RAW + r * RPITCH + cc * 16), c1 = *(const LAS u32x4*)(L + O_RAW + (r + 1) * RPITCH + cc * 16), c2 = *(const LAS u32x4*)(L + O_RAW + (r + 2) * RPITCH + cc * 16);
        float o[8];
#pragma unroll
        for (int h = 0; h < 4; ++h) {
            const float v0 = wt[0][2 * h] * bflo(c0[h]) + wt[1][2 * h] * bflo(c1[h]) + wt[2][2 * h] * bflo(c2[h]) + bs[2 * h];
            const float v1 = wt[0][2 * h + 1] * bfhi(c0[h]) + wt[1][2 * h + 1] * bfhi(c1[h]) + wt[2][2 * h + 1] * bfhi(c2[h]) + bs[2 * h + 1];
            o[2 * h] = siluf_(v0) * osc; o[2 * h + 1] = siluf_(v1) * osc; }
        u32x4 ov; ov.x = pk2(o[0], o[1]); ov.y = pk2(o[2], o[3]); ov.z = pk2(o[4], o[5]); ov.w = pk2(o[6], o[7]);
        *(LAS u32x4*)(L + (cc >= 32 ? O_KS : O_QS) + r * QP + (cc & 31) * 16) = ov;
        if (is_ctx) *(u32x4*)(QKC + (size_t)(b * CTXL + t0 + r) * 2048 + colabs) = ov;
        else *(u32x4*)(Z + (size_t)(rbase + t0 + r) * ZC + colabs) = ov; }
    __syncthreads();
    {
        bf16_t* S0T = WSP(bf16_t, WS_S0T) + ((size_t)((b * 4 + head) * 132 + ci)) * 8192;
        const int tb = w >> 1;
#pragma unroll
        for (int sbi = 0; sbi < 2; ++sbi) { const int sb = 2 * (w & 1) + sbi;
            f32x4 acc = {0.f, 0.f, 0.f, 0.f};
#pragma unroll
            for (int kk = 0; kk < 8; ++kk) {
                const bf16x8 ka = *(const LAS bf16x8*)(L + O_KS + (16 * sb + fr) * QP + (32 * kk + 8 * fq) * 2);
                const bf16x8 qb = *(const LAS bf16x8*)(L + O_QS + (16 * tb + fr) * QP + (32 * kk + 8 * fq) * 2);
                acc = __builtin_amdgcn_mfma_f32_16x16x32_bf16(ka, qb, acc, 0, 0, 0); }
            const int t = 16 * tb + fr, s0 = 16 * sb + 4 * fq;
            u32x2 o; o.x = cvt_pk_bf16(s0 <= t ? acc[0] : 0.f, s0 + 1 <= t ? acc[1] : 0.f); o.y = cvt_pk_bf16(s0 + 2 <= t ? acc[2] : 0.f, s0 + 3 <= t ? acc[3] : 0.f);
            *(u32x2*)(S0T + t * 64 + s0) = o;
            o.x = cvt_pk_bf16(s0 + 3 >= t ? acc[3] : 0.f, s0 + 2 >= t ? acc[2] : 0.f); o.y = cvt_pk_bf16(s0 + 1 >= t ? acc[1] : 0.f, s0 >= t ? acc[0] : 0.f);
            *(u32x2*)(S0T + 4096 + (63 - t) * 64 + (60 - s0)) = o; }
    }
    __syncthreads();
}
__device__ __forceinline__ void hyprep_item(Frame& F, const Inputs& I, int tb, int chb) {
    const bf16_t* Z = WSP(bf16_t, WS_Z); bf16_t* SCM = WSP(bf16_t, WS_SCM);
    constexpr int PITCH = 144;
    LAS unsigned char* X1T = F.lds; LAS unsigned char* VT = F.lds + 64 * PITCH;
    const int p = chb >> 1, j0 = (chb & 1) * 64;
    {   const int r = F.tid >> 3, cc = F.tid & 7; const bf16_t* src = Z + (size_t)(tb * 64 + r) * ZC + ZC_PAIR + 256 * p + j0 + 8 * cc;
        *(LAS u32x4*)(X1T + r * PITCH + cc * 16) = *(const u32x4*)src;
        *(LAS u32x4*)(VT + r * PITCH + cc * 16) = *(const u32x4*)(src + 128); }
    __syncthreads();
    {   const int ch = F.tid >> 3, t8 = (F.tid & 7) * 8, c = chb * 64 + ch;
        float wx[3], wv[3];
#pragma unroll
        for (int k = 0; k < 3; ++k) { wx[k] = I.w_h_conv[k * 3072 + 1024 + c]; wv[k] = I.w_h_conv[k * 3072 + 2048 + c]; }
        const float bx = I.b_h_conv[1024 + c], bv = I.b_h_conv[2048 + c];
        float xs[10], vs[10];
#pragma unroll
        for (int i = 0; i < 10; ++i) { const int r = t8 - 1 + i; const bool ok = r >= 0 && r < 64;
            xs[i] = ok ? bf2f(*(const LAS bf16_t*)(X1T + r * PITCH + ch * 2)) : 0.f; vs[i] = ok ? bf2f(*(const LAS bf16_t*)(VT + r * PITCH + ch * 2)) : 0.f; }
        float s[8];
#pragma unroll
        for (int i = 0; i < 8; ++i) s[i] = (wx[0] * xs[i] + wx[1] * xs[i + 1] + wx[2] * xs[i + 2] + bx) * (wv[0] * vs[i] + wv[1] * vs[i + 1] + wv[2] * vs[i + 2] + bv);
        u32x4 o; o.x = pk2(s[0], s[1]); o.y = pk2(s[2], s[3]); o.z = pk2(s[4], s[5]); o.w = pk2(s[6], s[7]);
        const int b = tb >> 7, t0 = (tb & 127) * 64;
        *(u32x4*)(SCM + ((size_t)(b * 1024 + c)) * SEQ + t0 + t8) = o; }
    __syncthreads();
}
__device__ __forceinline__ void phase2a(Frame& F, const Inputs& I) {
    unsigned* q1 = WSP(unsigned, WS_CTL) + CW_Q1;
    volatile LAS int* itp = (volatile LAS int*)(F.lds + MISC_OFF + 64);
    for (;;) {
        if (F.tid == 0) *itp = (int)atomicAdd(q1, 1u);
        __syncthreads();
        const int it = *itp;
        __syncthreads();
        if (it >= 1056 + 4096) break;
        if (it < 1056) qk_item(F, I, it / 528, (it / 132) & 3, it % 132);
        else { const int j = it - 1056; hyprep_item(F, I, j >> 4, j & 15); }
    }
}

__device__ __forceinline__ bf16x8 tr_frag(const LAS unsigned char* p0, const LAS unsigned char* p1) {
    const s16x4 a = __builtin_amdgcn_ds_read_tr16_b64_v4i16((LAS s16x4*)p0);
    const s16x4 b = __builtin_amdgcn_ds_read_tr16_b64_v4i16((LAS s16x4*)p1);
    return (bf16x8){a[0], a[1], a[2], a[3], b[0], b[1], b[2], b[3]};
}
template <int CTRL, int RM, bool BC> __device__ __forceinline__ float dppf(float old, float x) {
    return __builtin_bit_cast(float, __builtin_amdgcn_update_dpp(__builtin_bit_cast(int, old), __builtin_bit_cast(int, x), CTRL, RM, 0xf, BC)); }
__device__ __forceinline__ float wave_scan_sum(float x) {
    x += dppf<0x111, 0xf, true>(0.f, x); x += dppf<0x112, 0xf, true>(0.f, x); x += dppf<0x114, 0xf, true>(0.f, x); x += dppf<0x118, 0xf, true>(0.f, x);
    x += dppf<0x142, 0xa, false>(0.f, x); x += dppf<0x143, 0xc, false>(0.f, x); return x; }
__device__ __forceinline__ float wave_scan_max(float x) {
    const float ninf = -__builtin_inff();
    x = fmaxf(x, dppf<0x111, 0xf, false>(ninf, x)); x = fmaxf(x, dppf<0x112, 0xf, false>(ninf, x)); x = fmaxf(x, dppf<0x114, 0xf, false>(ninf, x)); x = fmaxf(x, dppf<0x118, 0xf, false>(ninf, x));
    x = fmaxf(x, dppf<0x142, 0xa, false>(ninf, x)); x = fmaxf(x, dppf<0x143, 0xc, false>(ninf, x)); return x; }
__device__ __forceinline__ float lane63(float x) { return __builtin_bit_cast(float, __builtin_amdgcn_readlane(__builtin_bit_cast(int, x), 63)); }
__device__ __forceinline__ void mlstm_item(Frame& F, const Inputs& I, int item) {
    constexpr int QP = 528, VP = 112, PP = 144;
    constexpr int O_QS = 0, O_KS = 33792, O_VW = 67584, O_PS = 74752, O_CS = 83968, CS_BYTES = 25344, O_DEN = 134656, O_SC = 135168, SC_BYTES = 6 * 64 * 4;
    const int b = item >> 6, g = (item >> 3) & 7, dir = g >> 2, head = g & 3, eb = item & 7;
    int tid = F.tid; asm volatile("" : "+v"(tid));
    const int lane = tid & 63, w = F.wave, fr = lane & 15, fq = lane >> 4;
    LAS unsigned char* L = F.lds;
    bf16_t* Z = WSP(bf16_t, WS_Z); const float* gates = WSP(float, WS_GATES);
    const unsigned char* wsb = F.ws;
    const int qcol = head * 256, vcol = 2048 + head * 256 + eb * 32, ocol = 3072 + head * 256 + eb * 32;
    const int outcol = ZC_PAIR + dir * 1024 + head * 256 + eb * 32;
    const int gi = dir * 4 + head;
    for (int i = tid; i < 64 * 16; i += 512) { const int r = i >> 4, cidx = 32 + (i & 15);
        *(LAS bf16_t*)(L + O_VW + r * VP + cidx * 2) = (bf16_t)0; }
    for (int i = tid; i < 2 * CS_BYTES / 4; i += 512) *(LAS unsigned*)(L + O_CS + 4 * i) = 0u;
    f32x4 Cacc[2][3];
#pragma unroll
    for (int a = 0; a < 2; ++a)
#pragma unroll
        for (int c = 0; c < 3; ++c) Cacc[a][c] = (f32x4){0.f, 0.f, 0.f, 0.f};
    struct Stage { u32x4 q[4], k[4], v, s; float ig, fg; };
    Stage R0, R1;
    const int scc = tid & 31, srow0 = tid >> 5;
    const int ppos = tid >> 3, ps8 = (tid & 7) * 8;
    auto geom = [&](int st, int& rbase, int& tlo, int& ci) { const bool ctx = st < 4; const int j = ctx ? st : st - 4, sl = ctx ? CTXL : SEQ;
        rbase = ctx ? M_LAT + b * CTXL : b * SEQ; tlo = dir == 0 ? 64 * j : sl - 64 * (j + 1); ci = (ctx ? 0 : 4) + (tlo >> 6); };
    auto prefetch = [&](int st, Stage& R) { int rbase, tlo, ci; geom(st, rbase, tlo, ci);
        const int t = dir == 0 ? tlo + lane : tlo + 63 - lane;
        const unsigned goff = (unsigned)(rbase + t) * 64u + (unsigned)gi * 4u;
        R.ig = *(const float*)(wsb + (unsigned)WS_GATES + goff); R.fg = *(const float*)(wsb + (unsigned)WS_GATES + goff + 32u);
        const unsigned qoff = st < 4 ? (unsigned)WS_QKC + (unsigned)(b * CTXL + tlo + srow0) * 4096u + (unsigned)head * 512u + (unsigned)scc * 16u
                                     : (unsigned)WS_Z + (unsigned)(rbase + tlo + srow0) * (unsigned)(ZC * 2) + (unsigned)qcol * 2u + (unsigned)scc * 16u;
        const unsigned qpitch = st < 4 ? 16u * 4096u : 16u * (unsigned)(ZC * 2);
#pragma unroll
        for (int i = 0; i < 4; ++i) { R.q[i] = *(const u32x4*)(wsb + (qoff + i * qpitch)); R.k[i] = *(const u32x4*)(wsb + (qoff + i * qpitch + 2048u)); }
        R.v = *(const u32x4*)(wsb + ((unsigned)WS_Z + (unsigned)(rbase + tlo + ((tid & 255) >> 2)) * (unsigned)(ZC * 2) + (unsigned)vcol * 2u + (unsigned)(tid & 3) * 16u));
        const unsigned soff = (unsigned)WS_S0T + (unsigned)(((b * 4 + head) * 132 + ci) * 2 + dir) * 8192u + (unsigned)(ppos * 64 + ps8) * 2u;
        R.s = *(const u32x4*)(wsb + soff); };
    auto commit = [&](int buf, const Stage& R) {
        const LAS float* SCn = (const LAS float*)(L + O_SC + buf * SC_BYTES);
#pragma unroll
        for (int i = 0; i < 4; ++i) { const int mr = srow0 + 16 * i, p = dir ? 63 - mr : mr; *(LAS u32x4*)(L + O_QS + p * QP + scc * 16) = R.q[i]; *(LAS u32x4*)(L + O_KS + p * QP + scc * 16) = R.k[i]; }
        if (tid < 256) { const int mr = tid >> 2, p = dir ? 63 - mr : mr; const u32x4 pv = R.v;
            const float wg = SCn[256 + p]; u32x4 vo;
            vo.x = cvt_pk_bf16(bflo(pv.x) * wg, bfhi(pv.x) * wg); vo.y = cvt_pk_bf16(bflo(pv.y) * wg, bfhi(pv.y) * wg); vo.z = cvt_pk_bf16(bflo(pv.z) * wg, bfhi(pv.z) * wg); vo.w = cvt_pk_bf16(bflo(pv.w) * wg, bfhi(pv.w) * wg);
            *(LAS u32x4*)(L + O_VW + p * VP + (tid & 3) * 16) = vo; }
        else if (tid < 320) { const int p = tid - 256; *(LAS bf16_t*)(L + O_VW + p * VP + 64) = (bf16_t)f2bf(SCn[256 + p]); }
        *(LAS u32x4*)(L + O_PS + ppos * PP + ps8 * 2) = R.s; };
#define LDS_BAR() do { asm volatile("s_waitcnt lgkmcnt(0)" ::: "memory"); __builtin_amdgcn_s_barrier(); asm volatile("" ::: "memory"); } while (0)
    float mnext = 0.f;
    auto scalars = [&](float ig, float fg, int buf) {
        if (w == 7) {
            const float mprev = mnext;
            const float fc = fminf(fg, 0.f) - __logf(1.0f + __expf(-fabsf(fg)));
            const float bcum = wave_scan_sum(fc);
            const float aval = ig - bcum;
            const float cm = fmaxf(mprev, wave_scan_max(aval));
            const float cm63 = lane63(cm), b63 = lane63(bcum);
            mnext = b63 + cm63;
            LAS float* sc = (LAS float*)(L + O_SC + buf * SC_BYTES) + lane;
            sc[0] = __expf(fminf(cm63 - cm, 80.f)); sc[128] = __expf(mprev - cm); sc[192] = __expf(-(bcum + cm)); sc[256] = __expf(aval - cm63);
            if (lane == 0) sc[320] = __expf(mprev - cm63);
        } };
    prefetch(0, R0);
    scalars(R0.ig, R0.fg, 0);
    __syncthreads();
    commit(0, R0);
    prefetch(1, R1);
    __syncthreads();
    int cur = 0;
    auto step = [&](int st, Stage& RA, Stage& RB) {
        const bool has_next = st + 1 < 132, is_ctx = st < 4;
        int rbase_c, tlo_c, ci_c; geom(st, rbase_c, tlo_c, ci_c);
        unsigned short ov[4];
#pragma unroll
        for (int i = 0; i < 4; ++i) { const int p = 16 * (w & 3) + 4 * fq + i, t = dir == 0 ? tlo_c + p : tlo_c + 63 - p;
            ov[i] = *(const bf16_t*)(wsb + ((unsigned)WS_Z + (unsigned)(rbase_c + t) * (unsigned)(ZC * 2) + (unsigned)(ocol + 16 * (w >> 2) + fr) * 2u)); }
        prefetch(st + 2 < 132 ? st + 2 : 131, RA);
        const LAS float* SC = (const LAS float*)(L + O_SC + cur * SC_BYTES);
        const float c_decay = SC[320];
        const int tt = w & 3, et = w >> 2;
        const int trg = lane >> 4, trq = (lane & 15) >> 2, trp = lane & 3;
        f32x4 nacc;
        {
            const LAS unsigned char* CSc = L + O_CS + cur * CS_BYTES;
            const f32x4 cs4 = *(const LAS f32x4*)(SC + 128 + 16 * tt + 4 * fq), rs4 = *(const LAS f32x4*)(SC + 16 * tt + 4 * fq);
            f32x4 a = {0.f, 0.f, 0.f, 0.f}, ia = {0.f, 0.f, 0.f, 0.f}, da = {0.f, 0.f, 0.f, 0.f}, dia = {0.f, 0.f, 0.f, 0.f};
#pragma unroll
            for (int kk = 0; kk < 8; ++kk) {
                const bf16x8 qa = *(const LAS bf16x8*)(L + O_QS + (16 * tt + fr) * QP + (32 * kk + 8 * fq) * 2);
                const bf16x8 cb = *(const LAS bf16x8*)(CSc + (16 * et + fr) * QP + (32 * kk + 8 * fq) * 2);
                a = __builtin_amdgcn_mfma_f32_16x16x32_bf16(qa, cb, a, 0, 0, 0);
                if ((kk >> 2) == et) { const bf16x8 cd = *(const LAS bf16x8*)(CSc + (32 + fr) * QP + (32 * kk + 8 * fq) * 2);
                    da = __builtin_amdgcn_mfma_f32_16x16x32_bf16(qa, cd, da, 0, 0, 0); } }
#pragma unroll
            for (int ks = 0; ks < 2; ++ks) {
                const bf16x8 pa = *(const LAS bf16x8*)(L + O_PS + (16 * tt + fr) * PP + (32 * ks + 8 * fq) * 2);
                const LAS unsigned char* vb = L + O_VW + (32 * ks + 8 * trg + trq) * VP + (16 * et + 4 * trp) * 2;
                ia = __builtin_amdgcn_mfma_f32_16x16x32_bf16(pa, tr_frag(vb, vb + 4 * VP), ia, 0, 0, 0);
                if (ks == et) { const LAS unsigned char* vd = L + O_VW + (32 * ks + 8 * trg + trq) * VP + (32 + 4 * trp) * 2;
                    dia = __builtin_amdgcn_mfma_f32_16x16x32_bf16(pa, tr_frag(vd, vd + 4 * VP), dia, 0, 0, 0); } }
            nacc = a * cs4 + ia * rs4;
            const f32x4 dacc = da * cs4 + dia * rs4;
            if (fr == 0) *(LAS f32x4*)(L + O_DEN + et * 256 + (16 * tt + 4 * fq) * 4) = dacc;
        }
        {
            LAS unsigned char* CSn = L + O_CS + (cur ^ 1) * CS_BYTES;
#pragma unroll
            for (int a = 0; a < 2; ++a)
#pragma unroll
                for (int c = 0; c < 3; ++c) Cacc[a][c] = Cacc[a][c] * c_decay;
#pragma unroll
            for (int ks = 0; ks < 2; ++ks) {
                bf16x8 ka[2], vb[3];
#pragma unroll
                for (int a = 0; a < 2; ++a) { const LAS unsigned char* p = L + O_KS + (32 * ks + 8 * trg + trq) * QP + (16 * (2 * w + a) + 4 * trp) * 2; ka[a] = tr_frag(p, p + 4 * QP); }
#pragma unroll
                for (int c = 0; c < 3; ++c) { const LAS unsigned char* p = L + O_VW + (32 * ks + 8 * trg + trq) * VP + (16 * c + 4 * trp) * 2; vb[c] = tr_frag(p, p + 4 * VP); }
#pragma unroll
                for (int a = 0; a < 2; ++a)
#pragma unroll
                    for (int c = 0; c < 3; ++c) Cacc[a][c] = __builtin_amdgcn_mfma_f32_16x16x32_bf16(ka[a], vb[c], Cacc[a][c], 0, 0, 0);
            }
#pragma unroll
            for (int a = 0; a < 2; ++a)
#pragma unroll
                for (int c = 0; c < 3; ++c) { u32x2 o; o.x = cvt_pk_bf16(Cacc[a][c][0], Cacc[a][c][1]); o.y = cvt_pk_bf16(Cacc[a][c][2], Cacc[a][c][3]);
                    *(LAS u32x2*)(CSn + (16 * c + fr) * QP + (16 * (2 * w + a) + 4 * fq) * 2) = o; }
        }
        if (has_next) scalars(RB.ig, RB.fg, cur ^ 1);
        LDS_BAR();
        if (!is_ctx) {
            const f32x4 den4 = *(const LAS f32x4*)(L + O_DEN + (16 * tt + 4 * fq) * 4) + *(const LAS f32x4*)(L + O_DEN + 256 + (16 * tt + 4 * fq) * 4), em4 = *(const LAS f32x4*)(SC + 192 + 16 * tt + 4 * fq);
#pragma unroll
            for (int i = 0; i < 4; ++i) { const int p = 16 * tt + 4 * fq + i, t = dir == 0 ? tlo_c + p : tlo_c + 63 - p;
                const float h = nacc[i] * __builtin_amdgcn_rcpf(fmaxf(fabsf(den4[i]), em4[i]));
                *(bf16_t*)(F.ws + ((unsigned)WS_Z + (unsigned)(rbase_c + t) * (unsigned)(ZC * 2) + (unsigned)(outcol + 16 * et + fr) * 2u)) = (bf16_t)f2bf(sigmoidf_(bf2f(ov[i])) * h); }
        }
        if (has_next) commit(cur ^ 1, RB);
        cur ^= 1;
        LDS_BAR();
    };
    for (int st = 0; st < 132; st += 2) { step(st, R0, R1); step(st + 1, R1, R0); }
    __syncthreads();
#undef LDS_BAR
}

__device__ __forceinline__ void hyena_item(Frame& F, const Inputs& I, int c) {
    LAS f32x2* X = (LAS f32x2*)F.lds;
    int tid = F.tid; asm volatile("" : "+v"(tid));
    const bf16_t* s0 = WSP(bf16_t, WS_SCM) + (size_t)c * SEQ; const bf16_t* s1 = s0 + (size_t)1024 * SEQ;
    const f32x2* fs = WSP(f32x2, WS_FSPEC) + (size_t)c * FS_PITCH;
    bf16_t* y0 = WSP(bf16_t, WS_H) + (size_t)c * SEQ; bf16_t* y1 = y0 + (size_t)1024 * SEQ;
    {
        f32x2 v[32];
#pragma unroll
        for (int r = 0; r < 16; ++r) { const int t = tid + 512 * r; v[r] = (f32x2){bf2f(s0[t]), bf2f(s1[t])}; }
#pragma unroll
        for (int r = 16; r < 32; ++r) v[r] = (f32x2){0.f, 0.f};
        __syncthreads();
        fft_pass_a_store(v, X, tid);
    }
    __syncthreads();
    fft_pass_b(X, tid);
    __syncthreads();
    {
        f32x2 v[32]; fft_pass_c_compute(v, X, tid);
        asm volatile("" ::: "memory"); __builtin_amdgcn_sched_barrier(0);
#pragma unroll
        for (int u = 0; u < 2; ++u)
#pragma unroll
            for (int p = 0; p < 16; ++p) { const int idx = tid + 512 * u + 1024 * bitrev(p, 4);
                f32x2 f = idx <= 8192 ? fs[idx] : fs[FFT_N - idx]; if (idx > 8192) f.y = -f.y;
                const f32x2 y = cmul(v[16 * u + p], f); v[16 * u + p] = (f32x2){y.x, -y.y}; }
        __syncthreads();
#pragma unroll
        for (int u = 0; u < 2; ++u) { int jj = tid + 512 * u; asm volatile("" : "+v"(jj)); LAS f32x2* xb = X + jj + (jj >> 5);
#pragma unroll
            for (int p = 0; p < 16; ++p) xb[1056 * bitrev(p, 4)] = v[16 * u + p]; }
    }
    __syncthreads();
    {   f32x2 v[32]; fft_load32(v, X, tid); __syncthreads(); fft_pass_a_store(v, X, tid); }
    __syncthreads();
    fft_pass_b(X, tid);
    __syncthreads();
    {   f32x2 v[32]; fft_pass_c_compute(v, X, tid);
        asm volatile("" ::: "memory"); __builtin_amdgcn_sched_barrier(0);
        const float hb = I.h_bias[c];
#pragma unroll
        for (int u = 0; u < 2; ++u)
#pragma unroll
            for (int p = 0; p < 16; ++p) { const int q = bitrev(p, 4);
                if (q < 8) { const int idx = tid + 512 * u + 1024 * q;
                    const float o0 = v[16 * u + p].x + hb * bf2f(s0[idx]), o1 = -v[16 * u + p].y + hb * bf2f(s1[idx]);
                    y0[idx] = (bf16_t)f2bf(o0); y1[idx] = (bf16_t)f2bf(o1); } }
    }
    __syncthreads();
}
__device__ __forceinline__ void hy_item(Frame& F, const Inputs& I, int tb, int chb) {
    bf16_t* Z = WSP(bf16_t, WS_Z); const bf16_t* YCM = WSP(bf16_t, WS_H);
    constexpr int PITCH = 144;
    LAS unsigned char* X0T = F.lds; LAS unsigned char* YT = F.lds + 64 * PITCH;
    const int b = tb >> 7, t0 = (tb & 127) * 64;
    {   const int r = F.tid >> 3, cc = F.tid & 7;
        *(LAS u32x4*)(X0T + r * PITCH + cc * 16) = *(const u32x4*)(Z + (size_t)(tb * 64 + r) * ZC + ZC_X0 + chb * 64 + 8 * cc);
        *(LAS u32x4*)(YT + r * PITCH + cc * 16) = *(const u32x4*)(YCM + ((size_t)(b * 1024 + chb * 64 + r)) * SEQ + t0 + 8 * cc); }
    __syncthreads();
    {   const int r = F.tid >> 3, cc = F.tid & 7;
        const u32x4 z = {0u, 0u, 0u, 0u};
        const u32x4 c1 = *(const LAS u32x4*)(X0T + r * PITCH + cc * 16);
        const u32x4 c0 = r > 0 ? *(const LAS u32x4*)(X0T + (r - 1) * PITCH + cc * 16) : z;
        const u32x4 c2 = r < 63 ? *(const LAS u32x4*)(X0T + (r + 1) * PITCH + cc * 16) : z;
        float o[8];
        const int cb8 = chb * 64 + 8 * cc;
        const f32x4 w0a = *(const f32x4*)(I.w_h_conv + cb8), w0b = *(const f32x4*)(I.w_h_conv + cb8 + 4), w1a = *(const f32x4*)(I.w_h_conv + 3072 + cb8), w1b = *(const f32x4*)(I.w_h_conv + 3072 + cb8 + 4);
        const f32x4 w2a = *(const f32x4*)(I.w_h_conv + 6144 + cb8), w2b = *(const f32x4*)(I.w_h_conv + 6144 + cb8 + 4), bba = *(const f32x4*)(I.b_h_conv + cb8), bbb = *(const f32x4*)(I.b_h_conv + cb8 + 4);
#pragma unroll
        for (int e = 0; e < 8; ++e) { const int h = e >> 1;
            const float a0 = (e & 1) ? bfhi(c0[h]) : bflo(c0[h]), a1 = (e & 1) ? bfhi(c1[h]) : bflo(c1[h]), a2 = (e & 1) ? bfhi(c2[h]) : bflo(c2[h]);
            const float k0 = e < 4 ? w0a[e & 3] : w0b[e & 3], k1 = e < 4 ? w1a[e & 3] : w1b[e & 3], k2 = e < 4 ? w2a[e & 3] : w2b[e & 3], kb = e < 4 ? bba[e & 3] : bbb[e & 3];
            const float x0 = k0 * a0 + k1 * a1 + k2 * a2 + kb;
            o[e] = x0 * bf2f(*(const LAS bf16_t*)(YT + (8 * cc + e) * PITCH + r * 2)); }
        u32x4 ov; ov.x = pk2(o[0], o[1]); ov.y = pk2(o[2], o[3]); ov.z = pk2(o[4], o[5]); ov.w = pk2(o[6], o[7]);
        *(u32x4*)(Z + (size_t)(tb * 64 + r) * ZC + ZC_X0 + chb * 64 + 8 * cc) = ov; }
    __syncthreads();
}

__device__ __forceinline__ void phase2b(Frame& F, const Inputs& I) {
    const int GA = F.G >= 2 ? F.G / 2 : 1, GB = F.G - GA;
    if (F.vcu < GA) { for (int it = F.vcu; it < 128; it += GA) mlstm_item(F, I, it); __syncthreads(); }
    if (GB == 0 || F.vcu >= GA) {
        const int c0 = GB ? F.vcu - GA : 0, cs = GB ? GB : 1;
        unsigned* sub = WSP(unsigned, WS_CTL) + CW_SUB;
        const int cpw = (1024 / 2 + cs - 1) / cs * 2, cb = c0 * cpw, ce = cb + cpw < 1024 ? cb + cpw : 1024;
        for (int c = cb; c < ce; c += 2) filter_spec_item(F, I, c >> 1);
        for (int c = cb; c < ce; ++c) hyena_item(F, I, c);
        subgrid_barrier(sub, (unsigned)cs, 1u);
        for (int it = c0; it < 4096; it += cs) hy_item(F, I, it >> 4, it & 15);
        subgrid_barrier(sub, (unsigned)cs, 2u);
        {
            bf16_t* Z = WSP(bf16_t, WS_Z);
            pg8::Gemm g{Z + ZC_X0, WSP(bf16_t, WS_WB_T), ZC, D, D};
            pg8::StaticOrder S; S.init(64, 4, cs, c0, 256L * ZC * 2, 256L * D * 2);
            EpiMerge<false> E{Z + ZC_GB, WSP(float, WS_FSPEC), nullptr};
            pg8::gemm_phase<EpiMerge<false>, pg8::StaticOrder, true>(F.lds, g, S, E);
        }
    }
}

struct XtItem { const float* W; int N, k0, n0; bf16_t* WT; int ldt, drow0; };
__device__ __forceinline__ XtItem xt_decode(const Inputs& I, bf16_t* W13T, bf16_t* W2T, int it) {
    constexpr int PER_E = 3 * 256;
    const int e = it / PER_E, r = it % PER_E, m = r >> 8, rr = r & 255; XtItem x;
    if (m < 2) { const int kb = rr >> 4, nb = rr & 15, n0 = 32 * nb;
        x.W = (m == 0 ? I.w1_e : I.w3_e) + (size_t)e * D * DEXP; x.N = DEXP; x.k0 = 64 * kb; x.n0 = n0; x.WT = W13T + (size_t)e * 1024 * 1024; x.ldt = D; x.drow0 = (n0 >> 7) * 256 + m * 128 + (n0 & 127); }
    else { const int kb = rr >> 5, nb = rr & 31;
        x.W = I.w2_e + (size_t)e * DEXP * D; x.N = D; x.k0 = 64 * kb; x.n0 = 32 * nb; x.WT = W2T + (size_t)e * 1024 * DEXP; x.ldt = DEXP; x.drow0 = 32 * nb; }
    return x;
}
__device__ __forceinline__ void xt_load(const XtItem& x, float (&v)[32], int lane) {
    const float* p = x.W + (size_t)(x.k0 + (lane >> 5)) * x.N + x.n0 + (lane & 31);
#pragma unroll
    for (int i = 0; i < 32; ++i) v[i] = p[(size_t)(2 * i) * x.N];
}
__device__ __forceinline__ void xt_finish(const XtItem& x, const float (&v)[32], LAS float* scr, int lane) {
#pragma unroll
    for (int i = 0; i < 32; ++i) scr[(2 * i + (lane >> 5)) * 33 + (lane & 31)] = v[i];
    asm volatile("s_waitcnt lgkmcnt(0)" ::: "memory");
    const int c = lane & 7;
#pragma unroll
    for (int j = 0; j < 4; ++j) { const int n = (lane >> 3) + 8 * j; const LAS float* s = scr + (8 * c) * 33 + n;
        u32x4 o; o.x = pk2(s[0 * 33], s[1 * 33]); o.y = pk2(s[2 * 33], s[3 * 33]); o.z = pk2(s[4 * 33], s[5 * 33]); o.w = pk2(s[6 * 33], s[7 * 33]);
        *(u32x4*)(x.WT + (size_t)(x.drow0 + n) * x.ldt + x.k0 + 8 * c) = o; }
    asm volatile("s_waitcnt lgkmcnt(0)" ::: "memory");
}
__device__ __forceinline__ void expert_transposes(Frame& F, const Inputs& I, int part, int nparts, int wg, int nwg) {
    LAS float* scr = (LAS float*)(F.lds + F.wave * 16384);
    const int gw = wg * 8 + F.wave, NGW = nwg * 8;
    constexpr int NIT = NEXP * 3 * 256;
    const int lo = (int)((long)NIT * part / nparts), hi = (int)((long)NIT * (part + 1) / nparts);
    bf16_t* W13T = WSP(bf16_t, WS_W13T); bf16_t* W2T = WSP(bf16_t, WS_W2T);
    int it = lo + gw; if (it >= hi) return;
    float va[32], vb[32];
    XtItem xa = xt_decode(I, W13T, W2T, it), xb = xa;
    xt_load(xa, va, F.lane);
    for (;;) {
        const bool nb = it + NGW < hi;
        if (nb) { xb = xt_decode(I, W13T, W2T, it + NGW); xt_load(xb, vb, F.lane); }
        xt_finish(xa, va, scr, F.lane);
        if (!nb) break;
        it += NGW;
        const bool na = it + NGW < hi;
        if (na) { xa = xt_decode(I, W13T, W2T, it + NGW); xt_load(xa, va, F.lane); }
        xt_finish(xb, vb, scr, F.lane);
        if (!na) break;
        it += NGW;
    }
}

struct Route { int e0, e1; float w0, w1; };
__device__ __forceinline__ void route_item(Frame& F, const Inputs& I, const float* x1, int blk) {
    constexpr int RP = 528;
    constexpr int O_AH = 0, O_AL = 33792, O_BH = 67584, O_BL = 109824, O_SSQ = 152064, O_LC = 152320;
    LAS unsigned char* L = F.lds;
    const int tid = F.tid, lane = F.lane, w = F.wave, fr = lane & 15, fq = lane >> 4;
    const int row0 = blk * 64, b = row0 / SEQ;
    const float* mods = WSP(float, WS_MODS) + b * 6144;
    const bf16_t* w72s = WSP(bf16_t, WS_W72S);
    f32x4 acc[3];
#pragma unroll
    for (int t = 0; t < 3; ++t) acc[t] = (f32x4){0.f, 0.f, 0.f, 0.f};
    const int sr = tid >> 3, seg = tid & 7;
    float ssq = 0.f;
    if (tid < 64) *(LAS int*)(L + O_LC + 4 * tid) = 0;
    for (int kt = 0; kt < 4; ++kt) {
#pragma unroll
        for (int i = 0; i < 8; ++i) { const int kk = 32 * i + 4 * seg, k = kt * 256 + kk;
            const f32x4 xv = *(const f32x4*)(x1 + (size_t)(row0 + sr) * D + k);
            ssq += (xv.x * xv.x + xv.y * xv.y) + (xv.z * xv.z + xv.w * xv.w);
            const f32x4 g = *(const f32x4*)(I.g_norm2 + k), sc = *(const f32x4*)(mods + 4 * 1024 + k);
            const f32x4 hv = xv * g * (sc + 1.0f);
            const unsigned h0 = f2bf(hv.x), h1 = f2bf(hv.y), h2 = f2bf(hv.z), h3 = f2bf(hv.w);
            const u32x2 hi = {h0 | (h1 << 16), h2 | (h3 << 16)};
            const u32x2 lo = {pk2(hv.x - bf2f((unsigned short)h0), hv.y - bf2f((unsigned short)h1)), pk2(hv.z - bf2f((unsigned short)h2), hv.w - bf2f((unsigned short)h3))};
            *(LAS u32x2*)(L + O_AH + sr * RP + kk * 2) = hi; *(LAS u32x2*)(L + O_AL + sr * RP + kk * 2) = lo; }
#pragma unroll
        for (int j = 0; j < 10; ++j) { const int id = tid + 512 * j, which = id / 2560, rem = id % 2560, col = rem >> 5, c16 = rem & 31;
            *(LAS u32x4*)(L + (which ? O_BL : O_BH) + col * RP + c16 * 16) = *(const u32x4*)(w72s + (size_t)(col * 2 + which) * 1024 + kt * 256 + c16 * 8); }
        __syncthreads();
#pragma unroll
        for (int ti = 0; ti < 3; ++ti) { const int T = w + 8 * ti;
            if (T < 20) { const int rt = T & 3, ct = T >> 2;
#pragma unroll
                for (int k8 = 0; k8 < 8; ++k8) {
                    const bf16x8 ah = *(const LAS bf16x8*)(L + O_AH + (16 * rt + fr) * RP + (32 * k8 + 8 * fq) * 2), al = *(const LAS bf16x8*)(L + O_AL + (16 * rt + fr) * RP + (32 * k8 + 8 * fq) * 2);
                    const bf16x8 bh = *(const LAS bf16x8*)(L + O_BH + (16 * ct + fr) * RP + (32 * k8 + 8 * fq) * 2), bl = *(const LAS bf16x8*)(L + O_BL + (16 * ct + fr) * RP + (32 * k8 + 8 * fq) * 2);
                    acc[ti] = __builtin_amdgcn_mfma_f32_16x16x32_bf16(ah, bh, acc[ti], 0, 0, 0);
                    acc[ti] = __builtin_amdgcn_mfma_f32_16x16x32_bf16(al, bh, acc[ti], 0, 0, 0);
                    acc[ti] = __builtin_amdgcn_mfma_f32_16x16x32_bf16(ah, bl, acc[ti], 0, 0, 0);
                } } }
        __syncthreads();
    }
    ssq += __shfl_xor(ssq, 1); ssq += __shfl_xor(ssq, 2); ssq += __shfl_xor(ssq, 4);
    if (seg == 0) *(LAS float*)(L + O_SSQ + 4 * sr) = ssq;
    LAS float* LOG = (LAS float*)L;
#pragma unroll
    for (int ti = 0; ti < 3; ++ti) { const int T = w + 8 * ti;
        if (T < 20) { const int rt = T & 3, ct = T >> 2;
#pragma unroll
            for (int i = 0; i < 4; ++i) LOG[(16 * rt + 4 * fq + i) * 81 + 16 * ct + fr] = acc[ti][i]; } }
    __syncthreads();
    if (w == 0) {
        const float rstd = 1.0f / sqrtf(*(const LAS float*)(L + O_SSQ + 4 * lane) * (1.0f / D) + EPS);
        const float* cst = WSP(float, WS_CST) + b * 72;
        float lg[72];
#pragma unroll
        for (int j = 0; j < 72; ++j) lg[j] = rstd * LOG[lane * 81 + j] + cst[j];
        int gsel = 0; float gmax = lg[0];
#pragma unroll
        for (int j = 1; j < 8; ++j) if (lg[j] > gmax) { gmax = lg[j]; gsel = j; }
        float gs = 0.f;
#pragma unroll
        for (int j = 0; j < 8; ++j) gs += __expf(lg[j] - gmax);
        const float gwt = 1.0f / gs;
        float el[8];
#pragma unroll
        for (int j = 0; j < 8; ++j) { float v = lg[8 + j];
#pragma unroll
            for (int gI = 1; gI < 8; ++gI) v = gsel == gI ? lg[8 + 8 * gI + j] : v;
            el[j] = v; }
        int i0 = 0; float v0 = el[0];
#pragma unroll
        for (int j = 1; j < 8; ++j) if (el[j] > v0) { v0 = el[j]; i0 = j; }
        int i1 = -1; float v1 = -3.0e38f;
#pragma unroll
        for (int j = 0; j < 8; ++j) if (j != i0 && el[j] > v1) { v1 = el[j]; i1 = j; }
        const float p1 = __expf(v1 - v0), inv = 1.0f / (1.0f + p1);
        const int e0 = gsel * 8 + i0, e1 = gsel * 8 + i1;
        const int r0 = __hip_atomic_fetch_add((LAS int*)(L + O_LC) + e0, 1, __ATOMIC_RELAXED, __HIP_MEMORY_SCOPE_WORKGROUP);
        const int r1 = __hip_atomic_fetch_add((LAS int*)(L + O_LC) + e1, 1, __ATOMIC_RELAXED, __HIP_MEMORY_SCOPE_WORKGROUP);
        Route r; r.e0 = e0 | (r0 << 8); r.e1 = e1 | (r1 << 8); r.w0 = gwt * inv; r.w1 = gwt * p1 * inv;
        WSP(Route, WS_ROUTE)[row0 + lane] = r;
        WSP(float, WS_RSTD2)[row0 + lane] = rstd;
    }
    __syncthreads();
    if (tid < 64) WSP(int, WS_BLKCNT)[blk * 64 + tid] = *(const LAS int*)(L + O_LC + 4 * tid);
    __syncthreads();
}
__device__ __forceinline__ int moe_tables(Frame& F, LAS int* seg_start, LAS int* tile_e) {
    const unsigned* cnt = WSP(unsigned, WS_CTL) + CW_CNT;
    if (F.tid < 64) seg_start[96 + F.tid] = (int)__hip_atomic_load(cnt + F.tid, RLX_AGENT);
    __syncthreads();
    if (F.tid < 64) { int s = 0; for (int e = 0; e < F.tid; ++e) s += (seg_start[96 + e] + 255) >> 8; seg_start[F.tid] = s * 256; }
    __syncthreads();
    if (F.tid < 64) { const int t0 = seg_start[F.tid] >> 8, nt = (seg_start[96 + F.tid] + 255) >> 8; for (int t = 0; t < nt; ++t) tile_e[t0 + t] = F.tid; if (F.tid == 63) seg_start[64] = (t0 + nt) * 256; }
    __syncthreads();
    return seg_start[64] >> 8;
}
__device__ __forceinline__ void phase4b(Frame& F, const Inputs& I, const float* x1) {
    LAS int* PART = (LAS int*)F.lds;
    LAS int* TOT = PART + 1024;
    LAS int* BEF = TOT + 64;
    LAS int* SEG = BEF + 64;
    const int* blkcnt = WSP(int, WS_BLKCNT);
    bf16_t* XS = WSP(bf16_t, WS_XS);
    for (int blk = F.vcu; blk < M_LAT / 64; blk += F.G) {
        {   const int e = F.tid & 63, part = F.tid >> 6; int sa = 0, sb = 0;
#pragma unroll 8
            for (int i = 0; i < 32; ++i) { const int bb = 32 * part + i; const int c = blkcnt[bb * 64 + e]; sa += c; sb += bb < blk ? c : 0; }
            PART[(part * 64 + e) * 2] = sa; PART[(part * 64 + e) * 2 + 1] = sb; }
        __syncthreads();
        if (F.tid < 64) { int ta = 0, tb = 0;
#pragma unroll
            for (int p = 0; p < 8; ++p) { ta += PART[(p * 64 + F.tid) * 2]; tb += PART[(p * 64 + F.tid) * 2 + 1]; }
            TOT[F.tid] = ta; BEF[F.tid] = tb;
            if (blk == 0) WSP(unsigned, WS_CTL)[CW_CNT + F.tid] = (unsigned)ta; }
        __syncthreads();
        if (F.tid == 0) { int run = 0; for (int e = 0; e < 64; ++e) { SEG[e] = run * 256; run += (TOT[e] + 255) >> 8; } SEG[64] = run * 256; }
        __syncthreads();
#pragma unroll 1
        for (int i = 0; i < 8; ++i) {
            const int row = blk * 64 + F.wave * 8 + i;
            const Route r = WSP(Route, WS_ROUTE)[row];
            const int e0 = r.e0 & 255, e1 = r.e1 & 255;
            const int sl0 = SEG[e0] + BEF[e0] + (r.e0 >> 8), sl1 = SEG[e1] + BEF[e1] + (r.e1 >> 8);
            if (F.lane == 0) { WSP(int, WS_TOKSLOT)[2 * row] = sl0; WSP(int, WS_TOKSLOT)[2 * row + 1] = sl1; }
            const float rstd = WSP(float, WS_RSTD2)[row];
            const float* md = WSP(float, WS_MODS) + (row / SEQ) * 6144;
            const f32x4* xr = (const f32x4*)(x1 + (size_t)row * D) + F.lane;
            u32x2* o0 = (u32x2*)(XS + (size_t)sl0 * D) + F.lane; u32x2* o1 = (u32x2*)(XS + (size_t)sl1 * D) + F.lane;
#pragma unroll
            for (int j = 0; j < 4; ++j) { const int k = 4 * F.lane + 256 * j; const f32x4 xv = xr[64 * j];
                const f32x4 g = *(const f32x4*)(I.g_norm2 + k), sh = *(const f32x4*)(md + 3 * 1024 + k), sc = *(const f32x4*)(md + 4 * 1024 + k);
                const f32x4 h = xv * rstd * g * (sc + 1.0f) + sh;
                const u32x2 o = {pk2(h.x, h.y), pk2(h.z, h.w)}; o0[64 * j] = o; o1[64 * j] = o; }
        }
        __syncthreads();
    }
}
__device__ __forceinline__ void phase6(Frame& F, const Inputs& I, float* out) {
    const int gw = F.vcu * 8 + F.wave, NGW = F.G * 8;
    const bf16_t* Y = WSP(bf16_t, WS_XS);
    for (int row = gw; row < M_LAT; row += NGW) {
        const Route r = WSP(Route, WS_ROUTE)[row];
        const int sl0 = WSP(int, WS_TOKSLOT)[2 * row], sl1 = WSP(int, WS_TOKSLOT)[2 * row + 1];
        const float* md = WSP(float, WS_MODS) + (row / SEQ) * 6144 + 5 * 1024;
        f32x4* xr = (f32x4*)(out + (size_t)row * D) + F.lane;
        const u32x2* y0 = (const u32x2*)(Y + (size_t)sl0 * D) + F.lane; const u32x2* y1 = (const u32x2*)(Y + (size_t)sl1 * D) + F.lane;
        f32x4 v[4]; float s = 0.f;
#pragma unroll
        for (int j = 0; j < 4; ++j) { const int k = 4 * F.lane + 256 * j; const u32x2 a = y0[64 * j], bq = y1[64 * j];
            const f32x4 ya = {bflo(a.x), bfhi(a.x), bflo(a.y), bfhi(a.y)}, yb = {bflo(bq.x), bfhi(bq.x), bflo(bq.y), bfhi(bq.y)};
            const f32x4 moe = ya * r.w0 + yb * r.w1;
            v[j] = xr[64 * j] + *(const f32x4*)(md + k) * moe;
            s += (v[j].x * v[j].x + v[j].y * v[j].y) + (v[j].z * v[j].z + v[j].w * v[j].w); }
        const float rstd = 1.0f / sqrtf(wave_sum(s) * (1.0f / D) + EPS);
#pragma unroll
        for (int j = 0; j < 4; ++j) { const int k = 4 * F.lane + 256 * j; xr[64 * j] = v[j] * rstd * *(const f32x4*)(I.g_final + k); }
    }
}

#ifndef MK_PER_PHASE
#define MK_PER_PHASE 0
#endif
constexpr int N_PHASES = 12;
constexpr int TAB_OFF = 150 * 1024;

__global__ void __launch_bounds__(512, 2) fwd_kernel(Args args) {
    extern __shared__ __attribute__((aligned(16))) unsigned char lds_raw[];
    Frame F;
    F.lds = (LAS unsigned char*)lds_raw;
    F.tid = threadIdx.x; F.lane = F.tid & 63; F.wave = __builtin_amdgcn_readfirstlane(F.tid >> 6);
    F.G = gridDim.x; { const int bx = blockIdx.x; F.vcu = (F.G % 8 == 0) ? (bx % 8) * (F.G / 8) + bx / 8 : bx; }
    F.ws = args.ws;
    const Inputs& I = args.in;
    volatile LAS unsigned* MISC = (volatile LAS unsigned*)(F.lds + MISC_OFF);
    if (F.tid < 32) MISC[F.tid] = 0u;
    __syncthreads();
    XcdBarrier bar; bar.bar = WSP(unsigned, WS_CTL) + CW_BAR; bar.x = 0; bar.st = nullptr;
#if !MK_PER_PHASE
    bar = xcd_barrier_post(WSP(unsigned, WS_CTL) + CW_BAR, MISC + 8);
#define GRID_BAR() xcd_barrier(bar)
#else
#define GRID_BAR() do {} while (0)
#endif
    const int lo = args.ph_lo, hi = args.ph_hi;
#ifndef PH_MASK
#define PH_MASK 0xffff
#endif
#define IN(k) (((PH_MASK >> (k)) & 1) && lo <= (k) && (k) < hi)
#define SEAM(k) do { if (IN(k) && IN((k) + 1)) GRID_BAR(); } while (0)
    bf16_t* Z = WSP(bf16_t, WS_Z);
    float* x1 = args.out;

    if (IN(0)) { phase0(F, I); } SEAM(0);
    if (IN(1)) {
        phase0b(F, I);
        __syncthreads();
        pg8::Gemm g{WSP(bf16_t, WS_W3S), WSP(bf16_t, WS_HID2), 256, 256, 256};
        pg8::StaticOrder S; S.init(8, 32, F.G, (int)blockIdx.x, 256L * 256 * 2, 256L * 256 * 2);
        EpiFilt E{WSP(_Float16, WS_FILT)};
        pg8::gemm_phase<EpiFilt, pg8::StaticOrder, false>(F.lds, g, S, E);
        __syncthreads();
        weight_transposes(F, I, 0, F.vcu, F.G);
    } SEAM(1);
    if (IN(2)) {
        pg8::Gemm g{WSP(bf16_t, WS_H), WSP(bf16_t, WS_WIN_T), D, D, D};
        InOrder S; S.so.init(64, 37, F.G, (int)blockIdx.x, 256L * D * 2, 256L * D * 2); S.G = F.G; S.c = (int)blockIdx.x;
        EpiIn E{Z, WSP(float, WS_BIASP), WSP(float, WS_GATES)};
        pg8::gemm_phase<EpiIn, InOrder, true>(F.lds, g, S, E);
        const int nfull = (64 * 37 + 26) % F.G, nlight = F.G - nfull;
        __syncthreads();
        if (nfull == 0) weight_transposes(F, I, 1, (int)blockIdx.x, F.G);
        else if ((int)blockIdx.x >= nfull) weight_transposes(F, I, 1, (int)blockIdx.x - nfull, nlight);
    } SEAM(2);
    if (IN(3)) { phase2a(F, I); } SEAM(3);
    if (IN(4)) { phase2b(F, I); } SEAM(4);
    if (IN(5)) {
        pg8::Gemm g{Z + ZC_PAIR, WSP(bf16_t, WS_WA2_T), ZC, 2 * D, 2 * D};
        pg8::StaticOrder S; S.init(64, 4, F.G, (int)blockIdx.x, 256L * ZC * 2, 256L * 2 * D * 2);
        EpiMerge<true> E{Z + ZC_GA, WSP(float, WS_FSPEC), WSP(bf16_t, WS_H)};
        pg8::gemm_phase<EpiMerge<true>, pg8::StaticOrder, false>(F.lds, g, S, E);
    } SEAM(5);
    if (IN(6)) {
        pg8::Gemm g{WSP(bf16_t, WS_H), WSP(bf16_t, WS_WOUT_T), D, D, D};
        pg8::StaticOrder S; S.init(64, 4, F.G, (int)blockIdx.x, 256L * D * 2, 256L * D * 2);
        EpiRes E{I.x, WSP(float, WS_MODS), x1};
        pg8::gemm_phase<EpiRes, pg8::StaticOrder, false>(F.lds, g, S, E);
        __syncthreads();
        expert_transposes(F, I, 0, 2, F.vcu, F.G);
    } SEAM(6);
    if (IN(7)) {
        for (int blk = F.vcu; blk < M_LAT / 64; blk += F.G) route_item(F, I, x1, blk);
        __syncthreads();
        expert_transposes(F, I, 1, 2, F.vcu, F.G);
    } SEAM(7);
    if (IN(8)) { phase4b(F, I, x1); } SEAM(8);
    if (IN(9)) {
        LAS int* seg_start = (LAS int*)(F.lds + TAB_OFF); LAS int* tile_e = seg_start + 192;
        const int ntiles = moe_tables(F, seg_start, tile_e);
        pg8::Gemm g{WSP(bf16_t, WS_XS), WSP(bf16_t, WS_W13T), D, D, D};
        MoeOrder S{tile_e, ntiles, F.G, F.vcu, 256L * D * 2, 256L * D * 2, 1024L * D * 2};
        EpiMoe1 E{WSP(bf16_t, WS_FSPEC)};
        pg8::gemm_phase<EpiMoe1, MoeOrder, true>(F.lds, g, S, E);
    } SEAM(9);
    if (IN(10)) {
        LAS int* seg_start = (LAS int*)(F.lds + TAB_OFF); LAS int* tile_e = seg_start + 192;
        const int ntiles = moe_tables(F, seg_start, tile_e);
        pg8::Gemm g{WSP(bf16_t, WS_FSPEC), WSP(bf16_t, WS_W2T), DEXP, DEXP, DEXP};
        MoeOrder S{tile_e, ntiles, F.G, F.vcu, 256L * DEXP * 2, 256L * DEXP * 2, 1024L * DEXP * 2};
        EpiBf E{WSP(bf16_t, WS_XS), D};
        pg8::gemm_phase<EpiBf, MoeOrder, true>(F.lds, g, S, E);
    } SEAM(10);
    if (IN(11)) { phase6(F, I, x1); }
#undef IN
#undef SEAM
}

extern "C" void kernel_launch(void* const* d_in, const int* in_sizes, int n_in, void* d_out, int out_size, void* d_ws, size_t ws_size, hipStream_t stream) {
    static int grid = 0;
    if (grid == 0) {
        if (n_in != 32 || in_sizes[0] != M_LAT * D || out_size != M_LAT * D || ws_size < WS_END) {
            fprintf(stderr, "kernel_launch: unexpected problem (n_in %d, in0 %d, out %d, ws %zu < %zu?)\n", n_in, n_in > 0 ? in_sizes[0] : -1, out_size, ws_size, (size_t)WS_END); grid = -1; return; }
        int dev = 0, cus = 0, per_cu = 0;
        if (hipGetDevice(&dev) != hipSuccess || hipDeviceGetAttribute(&cus, hipDeviceAttributeMultiprocessorCount, dev) != hipSuccess) { grid = -1; return; }
        if (hipFuncSetAttribute((const void*)fwd_kernel, hipFuncAttributeMaxDynamicSharedMemorySize, LDS_BYTES) != hipSuccess) { fprintf(stderr, "kernel_launch: hipFuncSetAttribute failed\n"); grid = -1; return; }
        if (hipOccupancyMaxActiveBlocksPerMultiprocessor(&per_cu, (const void*)fwd_kernel, 512, LDS_BYTES) != hipSuccess || per_cu < 1) { fprintf(stderr, "kernel_launch: occupancy query says %d\n", per_cu); per_cu = 1; }
        (void)hipGetLastError();
        grid = cus;
    }
    if (grid < 0) return;
    (void)hipMemsetAsync((char*)d_ws + WS_CTL, 0, CTL_ZERO_BYTES, stream);
    Args a{};
    const float** ip = (const float**)&a.in;
    for (int i = 0; i < 32; ++i) ip[i] = (const float*)d_in[i];
    a.out = (float*)d_out; a.ws = (unsigned char*)d_ws;
#if MK_PER_PHASE
    for (int p = 0; p < N_PHASES; ++p) { a.ph_lo = p; a.ph_hi = p + 1; hipLaunchKernelGGL(fwd_kernel, dim3(grid), dim3(512), LDS_BYTES, stream, a); }
#else
    a.ph_lo = 0; a.ph_hi = N_PHASES;
    hipLaunchKernelGGL(fwd_kernel, dim3(grid), dim3(512), LDS_BYTES, stream, a);
#endif
}
```

```cpp
#include <hip/hip_runtime.h>
#include <cstdio>
#include <cstdint>

#define LAS __attribute__((address_space(3)))
#define GAS __attribute__((address_space(1)))
typedef unsigned short bf16_t;
typedef short bf16x8 __attribute__((ext_vector_type(8)));
typedef short s16x4 __attribute__((ext_vector_type(4)));
typedef float f32x4 __attribute__((ext_vector_type(4)));
typedef float f32x2 __attribute__((ext_vector_type(2)));
typedef unsigned u32x4 __attribute__((ext_vector_type(4)));
typedef unsigned u32x2 __attribute__((ext_vector_type(2)));
typedef GAS unsigned gu32;

constexpr int D = 1024, BATCH = 2, SEQ = 8192, CTXL = 256;
constexpr int M_LAT = BATCH * SEQ, M_CTX = BATCH * CTXL, M_ALL = M_LAT + M_CTX;
constexpr int IN_COLS = 9232, IG0 = 4096, HY0 = 4112, GA0 = 7184, GB0 = 8208;
constexpr int ZC = 9216;
constexpr int ZC_X0 = 4096, ZC_PAIR = 5120, ZC_GA = 7168, ZC_GB = 8192;
constexpr int N_IN = 9472;
constexpr int NEXP = 64, DEXP = 512;
constexpr float EPS = 1e-6f;
constexpr int MAX_TILES = 192, MAX_SLOTS = MAX_TILES * 256;

constexpr size_t MiB = 1u << 20;
constexpr size_t WS_CTL = 0, CTL_ZERO_BYTES = 1 * MiB;
constexpr size_t WS_MODS = 1 * MiB;
constexpr size_t WS_BIASP = WS_MODS + 81920;
constexpr size_t WS_CST = WS_MODS + 122880;
constexpr size_t WS_RSTD2 = WS_MODS + 131072;
constexpr size_t WS_ROUTE = WS_MODS + 262144;
constexpr size_t WS_TOKSLOT = WS_MODS + 524288;
constexpr size_t WS_BLKCNT = WS_MODS + 196608;
constexpr size_t WS_W72S = WS_MODS + 720896;
constexpr size_t WS_GATES = 2 * MiB;
constexpr size_t WS_HID2 = 4 * MiB;
constexpr size_t WS_WIN_T = 8 * MiB;
constexpr size_t WS_WA2_T = 27 * MiB;
constexpr size_t WS_WB_T = 31 * MiB;
constexpr size_t WS_WOUT_T = 33 * MiB;
constexpr size_t WS_W3S = 35 * MiB;
constexpr size_t WS_H = 36 * MiB;
constexpr size_t WS_FSPEC = 70 * MiB;
constexpr int FS_PITCH = 8200;
constexpr size_t WS_SCM = 136 * MiB;
constexpr size_t WS_Z = 168 * MiB;
constexpr size_t WS_W13T = 168 * MiB;
constexpr size_t WS_W2T = 296 * MiB;
constexpr size_t WS_XS = 360 * MiB;
constexpr size_t WS_S0T = 466 * MiB;
constexpr size_t WS_QKC = 484 * MiB;
constexpr size_t WS_FILT = 486 * MiB;
constexpr size_t WS_END = 518 * MiB;
static_assert(WS_Z + (size_t)M_ALL * ZC * 2 <= WS_END && WS_XS + (size_t)MAX_SLOTS * 1024 * 2 <= WS_END, "ws map");
static_assert(WS_FSPEC + (size_t)1024 * FS_PITCH * 8 <= WS_SCM && WS_H + (size_t)M_ALL * D * 2 <= WS_FSPEC, "ws map");
constexpr int CW_BAR = 4096;
constexpr int CW_CNT = 16384, CW_CUR = 16384 + 64;
constexpr int CW_Q0 = 16384 + 256, CW_Q1 = 16384 + 320;
constexpr int CW_SUB = 20480;

constexpr int LDS_BYTES = 160 * 1024;
constexpr int MISC_OFF = 159 * 1024;

#define RLX_AGENT __ATOMIC_RELAXED, __HIP_MEMORY_SCOPE_AGENT
__device__ __forceinline__ unsigned f2bf(float f) { unsigned u = __builtin_bit_cast(unsigned, f); return (u + 0x7fffu + ((u >> 16) & 1u)) >> 16; }
__device__ __forceinline__ unsigned pk2(float lo, float hi) { return f2bf(lo) | (f2bf(hi) << 16); }
__device__ __forceinline__ float bf2f(unsigned short u) { return __builtin_bit_cast(float, (unsigned)u << 16); }
__device__ __forceinline__ float bflo(unsigned w) { return __builtin_bit_cast(float, w << 16); }
__device__ __forceinline__ float bfhi(unsigned w) { return __builtin_bit_cast(float, w & 0xffff0000u); }
__device__ __forceinline__ float sigmoidf_(float x) { return __builtin_amdgcn_rcpf(1.0f + __expf(-x)); }
__device__ __forceinline__ float siluf_(float x) { return x * __builtin_amdgcn_rcpf(1.0f + __expf(-x)); }
__device__ __forceinline__ float wave_sum(float v) {
#pragma unroll
    for (int o = 1; o < 64; o <<= 1) v += __shfl_xor(v, o);
    return v;
}

namespace pg8 {
#define PG8_LAS __attribute__((address_space(3)))
constexpr int BM = 256, BK = 64, HALF = 128, HTB = HALF * BK * 2, STAGE_BYTES = 8 * HTB, NXCD = 8, WGM = 8;
__host__ __device__ __forceinline__ int lds_byte(int r, int c) { const int st = (r >> 4) * 2 + (c >> 5), rr = r & 15, cc = c & 31, ob = rr * 64 + cc * 2; return st * 1024 + (ob ^ (((ob >> 9) & 1) << 5)); }
__host__ __device__ __forceinline__ void stage_rc(int b, int& R, int& C) { const int st = b / 1024, sb = b % 1024, swz = sb ^ (((sb >> 9) & 1) << 5); R = (st >> 1) * 16 + swz / 64; C = (st & 1) * 32 + (swz % 64) / 2; }
__host__ __device__ __forceinline__ int perm32(int rho) { const int n = rho >> 4, i = rho & 15; return 8 * (i >> 2) + 4 * n + (i & 3); }

struct Unit { long aoff, boff; int pm, pn, e, pad; };
struct Gemm { const bf16_t* A; const bf16_t* Bt; int lda, ldb, K; };

struct StaticOrder {
    int nM, nN, nwg, G, c; long astep, bstep;
    __device__ void init(int nM_, int nN_, int G_, int c_, long astep_, long bstep_) { nM = nM_; nN = nN_; nwg = nM * nN; G = G_; c = c_; astep = astep_; bstep = bstep_; }
    __device__ bool map(long L, Unit& u) const {
        if (L >= nwg) return false;
        int wgid = (int)L; { const int q = nwg / NXCD, r = nwg % NXCD, xcd = wgid % NXCD, off = wgid / NXCD; wgid = (xcd < r ? xcd * (q + 1) : r * (q + 1) + (xcd - r) * q) + off; }
        const int nig = WGM * nN, gid = wgid / nig, fm = gid * WGM, gsz = (nM - fm) < WGM ? (nM - fm) : WGM;
        u.pm = fm + ((wgid % nig) % gsz); u.pn = (wgid % nig) / gsz; u.e = 0; u.pad = 0; u.aoff = u.pm * astep; u.boff = u.pn * bstep; return true;
    }
    __device__ bool next(int i, Unit& u) const { return map((long)i * G + c, u); }
};

typedef __bf16 bf16v2_t __attribute__((ext_vector_type(2)));
__device__ __forceinline__ unsigned cvt_pk_bf16(float lo, float hi) { const bf16v2_t v = __builtin_convertvector((f32x2){lo, hi}, bf16v2_t); return __builtin_bit_cast(unsigned, v); }

template <class Epi, class Sched, bool ALIGN_EPI>
__device__ __forceinline__ void gemm_phase(PG8_LAS unsigned char* lds, const Gemm g, const Sched& S, const Epi& E) {
    const int tid = threadIdx.x, wid = __builtin_amdgcn_readfirstlane(tid >> 6), lane = tid & 63, wr = wid >> 2, wc = wid & 3, fr = lane & 15, fq = lane >> 4;
    const int K = g.K, nt = K / BK;
    unsigned voffA[2], voffB[2];
#pragma unroll
    for (int i = 0; i < 2; ++i) { int R, C; stage_rc(tid * 16 + i * 8192, R, C); const int Rb = Epi::PERM ? ((R & ~31) + perm32(R & 31)) : R;
        voffA[i] = (unsigned)(R * g.lda + C) * 2u; voffB[i] = (unsigned)(Rb * g.ldb + C) * 2u; }
    const size_t kstep = (size_t)(BK * 2);
    const size_t hstepA = (size_t)HALF * g.lda * 2, hstepB = (size_t)HALF * g.ldb * 2;
    const unsigned ldsw = (unsigned)wid * 1024u;
    const int aoff = lds_byte(wr * 64 + fr, fq * 8), boff = lds_byte(wc * 32 + fr, fq * 8);
#define PG8_SA(b, h) (((b) * 2 + (h)) * HTB)
#define PG8_SB(b, h) ((4 + (b) * 2 + (h)) * HTB)
#define PG8_STAGE(bufoff, gbase, voff) do { _Pragma("unroll") for (int _i = 0; _i < 2; ++_i) \
        __builtin_amdgcn_global_load_lds((const unsigned*)((const char*)(gbase) + (voff)[_i]), (PG8_LAS unsigned*)(lds + (bufoff) + ldsw + _i * 8192), 16, 0, 0); } while (0)
#define PG8_LDA(dst, b, h) do { _Pragma("unroll") for (int m = 0; m < 4; ++m) _Pragma("unroll") for (int k = 0; k < 2; ++k) dst[m][k] = *(const PG8_LAS bf16x8*)(lds + PG8_SA(b, h) + aoff + m * 2048 + k * 1024); } while (0)
#define PG8_LDB(dst, b, h) do { _Pragma("unroll") for (int n = 0; n < 2; ++n) _Pragma("unroll") for (int k = 0; k < 2; ++k) dst[n][k] = *(const PG8_LAS bf16x8*)(lds + PG8_SB(b, h) + boff + n * 2048 + k * 1024); } while (0)
#define PG8_MMA(ai, bj, At, Bt) do { __builtin_amdgcn_s_setprio(1); _Pragma("unroll") for (int m = 0; m < 4; ++m) _Pragma("unroll") for (int n = 0; n < 2; ++n) _Pragma("unroll") for (int k = 0; k < 2; ++k) \
        acc[ai][bj][m][n] = __builtin_amdgcn_mfma_f32_16x16x32_bf16(Bt[n][k], At[m][k], acc[ai][bj][m][n], 0, 0, 0); __builtin_amdgcn_s_setprio(0); } while (0)
#define PG8_WAIT_V(n) asm volatile("s_waitcnt vmcnt(" #n ")" ::: "memory")
#define PG8_WAIT_L(n) asm volatile("s_waitcnt lgkmcnt(" #n ")" ::: "memory")
#define PG8_BAR __builtin_amdgcn_s_barrier()
#define PG8_SCHED __builtin_amdgcn_sched_barrier(0)
    Unit cur, nxt; int ui = 0;
    if (!S.next(0, cur)) return;
    f32x4 acc[2][2][4][2];
#pragma unroll
    for (int a = 0; a < 2; ++a)
#pragma unroll
        for (int b = 0; b < 2; ++b)
#pragma unroll
            for (int m = 0; m < 4; ++m)
#pragma unroll
                for (int n = 0; n < 2; ++n) acc[a][b][m][n] = (f32x4){0.f, 0.f, 0.f, 0.f};
    bf16x8 At[4][2], B0[2][2], B1[2][2];
    const char* cA = (const char*)g.A + cur.aoff; const char* cB = (const char*)g.Bt + cur.boff;
    PG8_STAGE(PG8_SB(0, 0), cB, voffB); PG8_STAGE(PG8_SB(0, 1), cB + hstepB, voffB); PG8_STAGE(PG8_SA(0, 0), cA, voffA); PG8_STAGE(PG8_SA(0, 1), cA + hstepA, voffA);
    if (wr == 1) PG8_BAR;
    PG8_WAIT_V(2); PG8_BAR;
    PG8_STAGE(PG8_SB(1, 0), cB + kstep, voffB); PG8_STAGE(PG8_SA(1, 0), cA + kstep, voffA); PG8_STAGE(PG8_SB(1, 1), cB + hstepB + kstep, voffB);
    PG8_WAIT_V(6); PG8_BAR;
    for (;;) {
        const bool has_next = S.next(ui + 1, nxt);
        const char* nA = has_next ? (const char*)g.A + nxt.aoff : cA; const char* nB = has_next ? (const char*)g.Bt + nxt.boff : cB;
        for (int t = 0; t < nt; t += 2) {
            const bool last = (t == nt - 2);
            const char* a1 = cA + (size_t)(t + 1) * kstep;
            const char* a2 = last ? nA : cA + (size_t)(t + 2) * kstep; const char* b2 = last ? nB : cB + (size_t)(t + 2) * kstep;
            const char* a3 = a2 + kstep; const char* b3 = b2 + kstep;
            PG8_LDB(B0, 0, 0); PG8_LDB(B1, 0, 1); PG8_SCHED; PG8_LDA(At, 0, 0); PG8_STAGE(PG8_SA(1, 1), a1 + hstepA, voffA);
            PG8_WAIT_V(8); PG8_WAIT_L(0); PG8_BAR; PG8_MMA(0, 0, At, B0); PG8_MMA(0, 1, At, B1); PG8_BAR; PG8_SCHED;
            PG8_LDA(At, 0, 1); PG8_STAGE(PG8_SB(0, 0), b2, voffB); PG8_STAGE(PG8_SB(0, 1), b2 + hstepB, voffB); PG8_STAGE(PG8_SA(0, 0), a2, voffA);
            PG8_WAIT_V(8); PG8_WAIT_L(0); PG8_BAR; PG8_MMA(1, 0, At, B0); PG8_MMA(1, 1, At, B1); PG8_BAR; PG8_SCHED;
            PG8_LDB(B0, 1, 0); PG8_LDB(B1, 1, 1); PG8_SCHED; PG8_LDA(At, 1, 0); PG8_STAGE(PG8_SA(0, 1), a2 + hstepA, voffA);
            PG8_WAIT_V(8); PG8_WAIT_L(0); PG8_BAR; PG8_MMA(0, 0, At, B0); PG8_MMA(0, 1, At, B1); PG8_BAR; PG8_SCHED;
            PG8_LDA(At, 1, 1); PG8_STAGE(PG8_SB(1, 0), b3, voffB); PG8_STAGE(PG8_SB(1, 1), b3 + hstepB, voffB); PG8_STAGE(PG8_SA(1, 0), a3, voffA);
            PG8_WAIT_V(8); PG8_WAIT_L(0); PG8_BAR; PG8_MMA(1, 0, At, B0); PG8_MMA(1, 1, At, B1); PG8_BAR; PG8_SCHED;
        }
        if constexpr (ALIGN_EPI) { if (wr == 0) PG8_BAR; }
        E(acc, cur, wr, wc, fr, fq);
        if (!has_next) break;
#pragma unroll
        for (int a = 0; a < 2; ++a)
#pragma unroll
            for (int b = 0; b < 2; ++b)
#pragma unroll
                for (int m = 0; m < 4; ++m)
#pragma unroll
                    for (int n = 0; n < 2; ++n) acc[a][b][m][n] = (f32x4){0.f, 0.f, 0.f, 0.f};
        cur = nxt; cA = nA; cB = nB; ++ui;
        if constexpr (ALIGN_EPI) { if (wr == 1) PG8_BAR; }
    }
    PG8_WAIT_V(0);
    if constexpr (!ALIGN_EPI) { if (wr == 0) PG8_BAR; }
    PG8_BAR;
#undef PG8_SA
#undef PG8_SB
#undef PG8_STAGE
#undef PG8_LDA
#undef PG8_LDB
#undef PG8_MMA
#undef PG8_WAIT_V
#undef PG8_WAIT_L
#undef PG8_BAR
#undef PG8_SCHED
}
}

#define XB_TMO      128
#define XB_XCNT(j)  (256  + 64 * (j))
#define XB_XSUB(j)  (1280 + 64 * (j))
#define XB_XGEN(j)  (2304 + 64 * (j))
#define XB_TOP      3328
#define XB_TOPGEN   3392
#define XCD_BAR_WORDS 3456
#define XB_SPIN_CAP (1u << 18)
__device__ __forceinline__ unsigned xb_ld(unsigned* p)              { return __hip_atomic_load(p, __ATOMIC_RELAXED, __HIP_MEMORY_SCOPE_AGENT); }
__device__ __forceinline__ unsigned xb_add(unsigned* p, unsigned v) { return __hip_atomic_fetch_add(p, v, __ATOMIC_RELAXED, __HIP_MEMORY_SCOPE_AGENT); }
__device__ __forceinline__ unsigned xb_xcc_id() { return (unsigned)__builtin_amdgcn_s_getreg((3 << 11) | 20) & 0xFu; }
#define XB_SPIN(cond, bar) do { unsigned _sp = 0; while (cond) { __builtin_amdgcn_s_sleep(1); \
    if ((++_sp & 255u) == 0u) { if (xb_ld(&(bar)[XB_TMO])) break; if (_sp > XB_SPIN_CAP) { atomicAdd(&(bar)[XB_TMO], 1u); break; } } } } while (0)
struct XcdBarrier { unsigned* bar; unsigned x; volatile LAS unsigned* st; };
__device__ __forceinline__ XcdBarrier xcd_barrier_post(unsigned* bar, volatile LAS unsigned* st) {
    XcdBarrier b; b.bar = bar; b.x = xb_xcc_id(); b.st = st;
    if (threadIdx.x == 0) (void)xb_add(&bar[XB_XCNT(b.x)], 1u);
    return b;
}
__device__ __forceinline__ void xcd_barrier_complete(unsigned* bar, unsigned x, unsigned& nloc, unsigned& nx) {
    const unsigned G = gridDim.x * gridDim.y * gridDim.z;
    unsigned sum, cnt, mine, sp = 0u;
    for (;;) {
        sum = 0u; cnt = 0u; mine = 0u;
#pragma unroll
        for (unsigned j = 0; j < 16; ++j) { const unsigned c = xb_ld(&bar[XB_XCNT(j)]); sum += c; cnt += (c > 0u) ? 1u : 0u; mine = (j == x) ? c : mine; }
        if (sum == G) break;
        __builtin_amdgcn_s_sleep(1);
        if ((++sp & 255u) == 0u) { if (xb_ld(&bar[XB_TMO])) break; if (sp > XB_SPIN_CAP) { atomicAdd(&bar[XB_TMO], 1u); break; } }
    }
    nloc = mine > 0u ? mine : 1u; nx = cnt > 0u ? cnt : 1u;
}
__device__ __forceinline__ void xcd_barrier(const XcdBarrier& b) {
    asm volatile("s_waitcnt vmcnt(0)" ::: "memory");
    __syncthreads();
    if (threadIdx.x == 0) {
        unsigned* bar = b.bar;
        __builtin_amdgcn_s_waitcnt(0);
        unsigned nloc = b.st[0], nx = b.st[1];
        if (nloc == 0u) { xcd_barrier_complete(bar, b.x, nloc, nx); b.st[0] = nloc; b.st[1] = nx; }
        const unsigned old = xb_add(&bar[XB_XSUB(b.x)], 1u);
        const unsigned gen = old / nloc;
        if (old + 1u == (gen + 1u) * nloc) {
            __builtin_amdgcn_fence(__ATOMIC_RELEASE, "agent");
            asm volatile("s_waitcnt vmcnt(0)" ::: "memory");
            const unsigned og = xb_add(&bar[XB_TOP], 1u);
            const unsigned tg = og / nx;
            if (og + 1u == (tg + 1u) * nx) xb_add(&bar[XB_TOPGEN], 1u);
            else XB_SPIN(xb_ld(&bar[XB_TOPGEN]) == tg, bar);
            __builtin_amdgcn_fence(__ATOMIC_ACQUIRE, "agent");
            xb_add(&bar[XB_XGEN(b.x)], 1u);
            asm volatile("s_waitcnt vmcnt(0)" ::: "memory");
        } else {
            XB_SPIN(xb_ld(&bar[XB_XGEN(b.x)]) == gen, bar);
            __builtin_amdgcn_fence(__ATOMIC_ACQUIRE, "agent");
            asm volatile("s_waitcnt vmcnt(0)" ::: "memory");
        }
    }
    __syncthreads();
}

__device__ __forceinline__ void subgrid_barrier(unsigned* cnt, unsigned n, unsigned round) {
    asm volatile("s_waitcnt vmcnt(0)" ::: "memory");
    __syncthreads();
    if (threadIdx.x == 0) {
        __builtin_amdgcn_fence(__ATOMIC_RELEASE, "agent");
        asm volatile("s_waitcnt vmcnt(0)" ::: "memory");
        xb_add(cnt, 1u);
        unsigned sp = 0;
        while (xb_ld(cnt) < n * round) { __builtin_amdgcn_s_sleep(2); if (++sp > (1u << 22)) break; }
        __builtin_amdgcn_fence(__ATOMIC_ACQUIRE, "agent");
        asm volatile("s_waitcnt vmcnt(0)" ::: "memory");
    }
    __syncthreads();
}

struct Inputs {
    const float *x, *c, *ctx, *c_ctx, *w_mod, *b_mod, *g_norm1, *g_norm2, *w_in, *b_in, *w_qk_conv, *b_qk_conv, *w_h_conv, *b_h_conv,
        *hf_w1, *hf_b1, *hf_w2, *hf_b2, *hf_w3, *hf_freq, *h_bias, *w_a, *w_b, *w_out, *w_group, *b_group, *w_router, *b_router, *w1_e, *w3_e, *w2_e, *g_final;
};
struct Args { Inputs in; float* out; unsigned char* ws; int ph_lo, ph_hi; };
struct Frame {
    LAS unsigned char* lds;
    int tid, lane, wave, vcu, G;
    unsigned char* ws;
};
#define WSP(T, off) ((T*)(F.ws + (off)))

__device__ __forceinline__ int win_src(int rho) {
    if (rho < 4096) return rho;
    if (rho < ZC_PAIR) return HY0 + (rho - ZC_X0);
    if (rho < ZC_GA) { const int t = rho - ZC_PAIR, p = t >> 8, bj = (t >> 7) & 1, j = t & 127; return HY0 + 1024 + bj * 1024 + 128 * p + j; }
    if (rho < ZC_GB) return GA0 + (rho - ZC_GA);
    if (rho < ZC) return GB0 + (rho - ZC_GB);
    if (rho < ZC + 16) return IG0 + (rho - ZC);
    return -1;
}
template <class SrcCol>
__device__ __forceinline__ void transpose_item(const float* W, int N, int k0, SrcCol scol, bf16_t* WT, int ldt, int drow0, int kdst, LAS float* scr, int lane) {
    const int sc = scol(lane & 31);
#pragma unroll 16
    for (int i = 0; i < 32; ++i) { const int kk = 2 * i + (lane >> 5); scr[kk * 33 + (lane & 31)] = sc >= 0 ? W[(size_t)(k0 + kk) * N + sc] : 0.f; }
    asm volatile("s_waitcnt lgkmcnt(0)" ::: "memory");
    const int c = lane & 7;
#pragma unroll
    for (int j = 0; j < 4; ++j) { const int n = (lane >> 3) + 8 * j; const LAS float* s = scr + (8 * c) * 33 + n;
        u32x4 o; o.x = pk2(s[0 * 33], s[1 * 33]); o.y = pk2(s[2 * 33], s[3 * 33]); o.z = pk2(s[4 * 33], s[5 * 33]); o.w = pk2(s[6 * 33], s[7 * 33]);
        *(u32x4*)(WT + (size_t)(drow0 + n) * ldt + kdst + 8 * c) = o; }
    asm volatile("s_waitcnt lgkmcnt(0)" ::: "memory");
}


__device__ __forceinline__ void weight_transposes(Frame& F, const Inputs& I, int which, int wg, int nwg) {
    LAS float* scr = (LAS float*)(F.lds + F.wave * 16384);
    const int gw = wg * 8 + F.wave, NGW = nwg * 8;
    {
        constexpr int I_IN = (D / 64) * (N_IN / 32), I_SQ = (D / 64) * (D / 32);
        const int lo = which == 0 ? 0 : I_IN, hi = which == 0 ? I_IN : I_IN + 3 * I_SQ;
        for (int it = lo + gw; it < hi; it += NGW) {
            int r = it;
            if (r < I_IN) { const int nblk = N_IN / 32, kb = r / nblk, nb = r % nblk;
                transpose_item(I.w_in, IN_COLS, 64 * kb, [&](int i) { return win_src(32 * nb + i); }, WSP(bf16_t, WS_WIN_T), D, 32 * nb, 64 * kb, scr, F.lane); continue; }
            r -= I_IN;
            const int m = r / I_SQ, rr = r % I_SQ, kb = rr / 32, nb = rr % 32;
            if (m == 0) { transpose_item(I.w_a, D, 64 * kb, [&](int i) { return 32 * nb + i; }, WSP(bf16_t, WS_WA2_T), 2 * D, 32 * nb, 64 * kb, scr, F.lane);
                          transpose_item(I.w_a, D, 64 * kb, [&](int i) { return 32 * nb + i; }, WSP(bf16_t, WS_WA2_T), 2 * D, 32 * nb, D + 64 * kb, scr, F.lane); }
            else if (m == 1) transpose_item(I.w_b, D, 64 * kb, [&](int i) { return 32 * nb + i; }, WSP(bf16_t, WS_WB_T), D, 32 * nb, 64 * kb, scr, F.lane);
            else transpose_item(I.w_out, D, 64 * kb, [&](int i) { return 32 * nb + i; }, WSP(bf16_t, WS_WOUT_T), D, 32 * nb, 64 * kb, scr, F.lane);
        }
    }
    __syncthreads();
}
__device__ __forceinline__ void phase0(Frame& F, const Inputs& I) {
    LAS float* scr = (LAS float*)(F.lds + F.wave * 16384);
    const int gw = F.vcu * 8 + F.wave, NGW = F.G * 8;
    {
        LAS float* red = (LAS float*)F.lds;
        LAS float* sl = red + 8 * 3 * 32;
        float* mods = WSP(float, WS_MODS);
        for (int i = F.tid; i < 3 * 1024; i += 512) { const int v = i >> 10, k = i & 1023; sl[i] = siluf_(v == 0 ? I.c[k] : v == 1 ? I.c[D + k] : I.c_ctx[k]); }
        __syncthreads();
        for (int it = F.vcu; it < 256; it += F.G) {
            const int col = F.lane & 31, kr = F.lane >> 5, n = it * 24 + col; const bool act = col < 24;
            float a0 = 0.f, a1 = 0.f, a2 = 0.f;
#pragma unroll 16
            for (int i = 0; i < 64; ++i) { const int k = F.wave * 128 + 2 * i + kr; const float w = act ? I.w_mod[(size_t)k * 6144 + n] : 0.f;
                a0 += sl[k] * w; a1 += sl[1024 + k] * w; a2 += sl[2048 + k] * w; }
            a0 += __shfl_xor(a0, 32); a1 += __shfl_xor(a1, 32); a2 += __shfl_xor(a2, 32);
            if (F.lane < 32) { red[(F.wave * 3 + 0) * 32 + col] = a0; red[(F.wave * 3 + 1) * 32 + col] = a1; red[(F.wave * 3 + 2) * 32 + col] = a2; }
            __syncthreads();
            if (F.tid < 96) { const int v = F.tid >> 5, l = F.tid & 31; float s = 0.f;
#pragma unroll
                for (int w = 0; w < 8; ++w) s += red[(w * 3 + v) * 32 + l];
                if (l < 24) mods[v * 6144 + it * 24 + l] = s + I.b_mod[it * 24 + l]; }
            __syncthreads();
        }
    }
    __syncthreads();
    for (int i = F.vcu * 512 + F.tid; i < N_IN; i += F.G * 512) { const int s = win_src(i); WSP(float, WS_BIASP)[i] = s >= 0 ? I.b_in[s] : 0.f; }
    for (int i = F.vcu * 512 + F.tid; i < 80 * 2048; i += F.G * 512) { const int col = i >> 11, which = (i >> 10) & 1, k = i & 1023;
        const float v = col < 8 ? I.w_group[k * 8 + col] : col < 72 ? I.w_router[k * 64 + (col - 8)] : 0.f;
        const unsigned hi = f2bf(v); WSP(bf16_t, WS_W72S)[i] = (bf16_t)(which ? f2bf(v - bf2f((unsigned short)hi)) : hi); }
    {
        bf16_t* hids = WSP(bf16_t, WS_HID2);
        const int j = F.lane;
        const float fr = I.hf_freq[j], b1 = I.hf_b1[j], b2 = I.hf_b2[j];
        for (int pos = gw; pos < SEQ; pos += NGW) {
            const float t = (float)pos / (float)(SEQ - 1);
            float a = b1 + t * I.hf_w1[0 * 64 + j];
#pragma unroll 4
            for (int i = 0; i < 16; ++i) { const float band = 1e-4f + (float)i * ((15.0f - 1e-4f) / 15.0f);
                const float rev = ((float)pos * (1.0f / (float)SEQ)) * band;
                const float sn = __builtin_amdgcn_sinf(rev), cs = __builtin_amdgcn_cosf(rev);
                a += cs * I.hf_w1[(1 + i) * 64 + j] - sn * I.hf_w1[(17 + i) * 64 + j]; }
            const float h1 = __builtin_amdgcn_sinf(fr * a * 0.15915494309189535f);
            float a2 = b2;
#pragma unroll 8
            for (int i = 0; i < 64; ++i) a2 += __shfl(h1, i) * I.hf_w2[i * 64 + j];
            const float h2 = __builtin_amdgcn_sinf(fr * a2 * 0.15915494309189535f);
            const unsigned hi = f2bf(h2), lo = f2bf(h2 - bf2f((unsigned short)hi));
            bf16_t* hp = hids + (size_t)pos * 256;
            hp[j] = (bf16_t)hi; hp[64 + j] = (bf16_t)hi; hp[128 + j] = (bf16_t)lo; hp[192 + j] = 0;
        }
        bf16_t* w3s = WSP(bf16_t, WS_W3S);
        for (int i = F.vcu * 512 + F.tid; i < 2048 * 64; i += F.G * 512) { const int h = i >> 11, col = i & 2047;
            const float wv = I.hf_w3[i]; const unsigned hi = f2bf(wv), lo = f2bf(wv - bf2f((unsigned short)hi));
            bf16_t* wp = w3s + (size_t)col * 256;
            wp[h] = (bf16_t)hi; wp[64 + h] = (bf16_t)lo; wp[128 + h] = (bf16_t)hi; wp[192 + h] = 0; }
    }
}

constexpr int FFT_N = 16384;
__device__ __forceinline__ int PADI(int i) { return i + (i >> 5); }
__device__ __forceinline__ constexpr int bitrev(int x, int bits) { int r = 0; for (int i = 0; i < bits; ++i) r = (r << 1) | ((x >> i) & 1); return r; }
template <int R, int LOG2R>
__device__ __forceinline__ void dft_dif(f32x2 (&v)[R]) {
    constexpr float C32[16] = {1.000000000e+00f, 9.807852804e-01f, 9.238795325e-01f, 8.314696123e-01f, 7.071067812e-01f, 5.555702330e-01f, 3.826834324e-01f, 1.950903220e-01f,
                               0.0f, -1.950903220e-01f, -3.826834324e-01f, -5.555702330e-01f, -7.071067812e-01f, -8.314696123e-01f, -9.238795325e-01f, -9.807852804e-01f};
    constexpr float S32[16] = {0.0f, 1.950903220e-01f, 3.826834324e-01f, 5.555702330e-01f, 7.071067812e-01f, 8.314696123e-01f, 9.238795325e-01f, 9.807852804e-01f,
                               1.0f, 9.807852804e-01f, 9.238795325e-01f, 8.314696123e-01f, 7.071067812e-01f, 5.555702330e-01f, 3.826834324e-01f, 1.950903220e-01f};
#pragma unroll
    for (int st = 0; st < LOG2R; ++st) {
        const int half = R >> (st + 1);
#pragma unroll
        for (int blk = 0; blk < R; blk += 2 * half)
#pragma unroll
            for (int i = 0; i < half; ++i) {
                const f32x2 a = v[blk + i], b = v[blk + i + half];
                v[blk + i] = a + b;
                const f32x2 t = a - b;
                const int ti = i * (16 / half);
                if (ti == 0) v[blk + i + half] = t;
                else if (ti == 8) v[blk + i + half] = (f32x2){t.y, -t.x};
                else { const float c = C32[ti], s = S32[ti]; v[blk + i + half] = (f32x2){t.x * c + t.y * s, t.y * c - t.x * s}; }
            }
    }
}
__device__ __forceinline__ f32x2 cmul(f32x2 a, f32x2 b) { return (f32x2){a.x * b.x - a.y * b.y, a.x * b.y + a.y * b.x}; }
__device__ __forceinline__ f32x2 twid(float frac) { return (f32x2){__builtin_amdgcn_cosf(frac), -__builtin_amdgcn_sinf(frac)}; }
__device__ __forceinline__ void fft_pass_a_store(f32x2 (&v)[32], LAS f32x2* X, int j) {
    dft_dif<32, 5>(v);
    int jq = j; asm volatile("" : "+v"(jq));
    LAS f32x2* xb = X + 33 * jq;
#pragma unroll
    for (int p = 0; p < 32; ++p) xb[bitrev(p, 5)] = v[p];
}
__device__ __forceinline__ void fft_load32(f32x2 (&v)[32], const LAS f32x2* X, int j) {
    int jq = j; asm volatile("" : "+v"(jq));
    const LAS f32x2* xb = X + jq + (jq >> 5);
#pragma unroll
    for (int r = 0; r < 32; ++r) v[r] = xb[528 * r];
}
constexpr int TW_OFF = 144 * 1024;
__device__ __forceinline__ void fft_twiddle_init(LAS unsigned char* lds, int tid) {
    LAS f32x2* T = (LAS f32x2*)(lds + TW_OFF);
    for (int m = tid; m < 1024; m += 512) T[m] = twid((float)m * (1.0f / 1024.0f));
}
__device__ __forceinline__ void fft_pass_b(LAS f32x2* X, int j) {
    f32x2 v[32]; fft_load32(v, X, j);
    int jo = j; asm volatile("" : "+v"(jo));
    const int k = jo & 31;
    j = jo;
    const LAS f32x2* T = (const LAS f32x2*)((const LAS unsigned char*)X + TW_OFF) + k;
#pragma unroll
    for (int r = 1; r < 32; ++r) v[r] = cmul(v[r], T[(r - 1) * k]);
    dft_dif<32, 5>(v);
    __syncthreads();
    LAS f32x2* xb = X + (j >> 5) * 1056 + k;
#pragma unroll
    for (int p = 0; p < 32; ++p) xb[33 * bitrev(p, 5)] = v[p];
}
__device__ __forceinline__ void fft_pass_c_compute(f32x2 (&v)[32], const LAS f32x2* X, int tid) {
#pragma unroll
    for (int u = 0; u < 2; ++u) {
        int jj = tid + 512 * u; asm volatile("" : "+v"(jj)); f32x2 w[16];
#pragma unroll
        for (int r = 0; r < 16; ++r) w[r] = X[jj + (jj >> 5) + 1056 * r];
        const float f1 = (float)jj * (1.0f / 16384.0f);
#pragma unroll
        for (int r = 1; r < 16; ++r) w[r] = cmul(w[r], twid((float)r * f1));
        dft_dif<16, 4>(w);
#pragma unroll
        for (int p = 0; p < 16; ++p) v[16 * u + p] = w[p];
    }
}

__device__ __forceinline__ void filter_spec_item(Frame& F, const Inputs& I, int pair) {
    const int c = 2 * pair, tid = F.tid;
    LAS f32x2* X = (LAS f32x2*)F.lds;
    LAS float* red = (LAS float*)(F.lds + 140 * 1024);
    const _Float16* filt = WSP(_Float16, WS_FILT);
    float ss0 = 0.f, ss1 = 0.f;
    for (int i = 0; i < 16; ++i) {
        const int lag = tid + 512 * i;
        const float f0 = (float)filt[(size_t)c * SEQ + lag], f1 = (float)filt[(size_t)(c + 1) * SEQ + lag], g0 = (float)filt[(size_t)(1024 + c) * SEQ + lag], g1 = (float)filt[(size_t)(1025 + c) * SEQ + lag];
        X[PADI(lag)] = (f32x2){f0, f1}; ss0 += f0 * f0; ss1 += f1 * f1;
        if (lag >= 1) { X[PADI(FFT_N - lag)] = (f32x2){g0, g1}; ss0 += g0 * g0; ss1 += g1 * g1; }
    }
    if (tid == 0) X[PADI(8192)] = (f32x2){0.f, 0.f};
    ss0 = wave_sum(ss0); ss1 = wave_sum(ss1);
    if (F.lane == 0) { red[F.wave * 2] = ss0; red[F.wave * 2 + 1] = ss1; }
    __syncthreads();
    float t0 = 0.f, t1 = 0.f;
#pragma unroll
    for (int w = 0; w < 8; ++w) { t0 += red[2 * w]; t1 += red[2 * w + 1]; }
    const float sc0 = (1.0f / sqrtf(t0 + EPS)) * (1.0f / 16384.0f), sc1 = (1.0f / sqrtf(t1 + EPS)) * (1.0f / 16384.0f);
    {   f32x2 v[32]; fft_load32(v, X, tid); __syncthreads(); fft_pass_a_store(v, X, tid); }
    __syncthreads();
    fft_pass_b(X, tid);
    __syncthreads();
    {   f32x2 v[32]; fft_pass_c_compute(v, X, tid); __syncthreads();
#pragma unroll
        for (int u = 0; u < 2; ++u) { int jj = tid + 512 * u; asm volatile("" : "+v"(jj)); LAS f32x2* xb = X + jj + (jj >> 5);
#pragma unroll
            for (int p = 0; p < 16; ++p) xb[1056 * bitrev(p, 4)] = v[16 * u + p]; } }
    __syncthreads();
    f32x2* fs = WSP(f32x2, WS_FSPEC);
    for (int k = tid; k <= 8192; k += 512) {
        const f32x2 zk = X[PADI(k)], zn = X[PADI((FFT_N - k) & (FFT_N - 1))];
        fs[(size_t)c * FS_PITCH + k] = (f32x2){0.5f * (zk.x + zn.x) * sc0, 0.5f * (zk.y - zn.y) * sc0};
        fs[(size_t)(c + 1) * FS_PITCH + k] = (f32x2){0.5f * (zk.y + zn.y) * sc1, -0.5f * (zk.x - zn.x) * sc1};
    }
    __syncthreads();
}
__device__ __forceinline__ void phase0b(Frame& F, const Inputs& I) {
    const int gw = F.vcu * 8 + F.wave, NGW = F.G * 8;
    const float* mods = WSP(float, WS_MODS);
    {
        bf16_t* H = WSP(bf16_t, WS_H);
        for (int row = gw; row < M_ALL; row += NGW) {
            const float* src = row < M_LAT ? I.x + (size_t)row * D : I.ctx + (size_t)(row - M_LAT) * D;
            const float* md = mods + (row < M_LAT ? row / SEQ : 2) * 6144;
            const f32x4* xr = (const f32x4*)src + F.lane;
            f32x4 v[4]; float s = 0.f;
#pragma unroll
            for (int j = 0; j < 4; ++j) { v[j] = xr[64 * j]; s += (v[j].x * v[j].x + v[j].y * v[j].y) + (v[j].z * v[j].z + v[j].w * v[j].w); }
            const float rstd = 1.0f / sqrtf(wave_sum(s) * (1.0f / D) + EPS);
            u32x2* o8 = (u32x2*)(H + (size_t)row * D) + F.lane;
#pragma unroll
            for (int j = 0; j < 4; ++j) { const int k = 4 * F.lane + 256 * j;
                const f32x4 g = *(const f32x4*)(I.g_norm1 + k), sh = *(const f32x4*)(md + k), sc = *(const f32x4*)(md + 1024 + k);
                const f32x4 h = v[j] * rstd * g * (sc + 1.0f) + sh;
                o8[64 * j] = (u32x2){pk2(h.x, h.y), pk2(h.z, h.w)}; }
        }
    }
    for (int it = gw; it < 144; it += NGW) { const int b = it / 72, j = it % 72; const float* sh2 = mods + b * 6144 + 3 * 1024;
        float s = 0.f;
        for (int k = F.lane; k < 1024; k += 64) s += sh2[k] * (j < 8 ? I.w_group[k * 8 + j] : I.w_router[k * 64 + (j - 8)]);
        s = wave_sum(s);
        if (F.lane == 0) WSP(float, WS_CST)[it] = s + (j < 8 ? I.b_group[j] : I.b_router[j - 8]); }
}

using pg8::Unit; using pg8::cvt_pk_bf16;
struct EpiIn {
    static constexpr bool PERM = true;
    bf16_t* Z; const float* bias; float* gates;
    __device__ __forceinline__ void operator()(const f32x4 (&acc)[2][2][4][2], const Unit& u, int wr, int wc, int fr, int fq) const {
        const int row0 = u.pm * 256 + wr * 64 + fr;
        if (u.pn == 36) {
            if (wc == 0 && fq < 2) {
                const f32x4 b0 = *(const f32x4*)(bias + ZC + 8 * fq), b1 = *(const f32x4*)(bias + ZC + 8 * fq + 4);
#pragma unroll
                for (int ai = 0; ai < 2; ++ai)
#pragma unroll
                    for (int m = 0; m < 4; ++m) { float* gp = gates + (size_t)(row0 + ai * 128 + m * 16) * 16 + 8 * fq;
                        *(f32x4*)gp = acc[ai][0][m][0] + b0; *(f32x4*)(gp + 4) = acc[ai][0][m][1] + b1; }
            }
            return;
        }
        const int col0 = u.pn * 256 + wc * 32 + 8 * fq;
        f32x4 bv[2][2];
#pragma unroll
        for (int bj = 0; bj < 2; ++bj)
#pragma unroll
            for (int n = 0; n < 2; ++n) bv[bj][n] = *(const f32x4*)(bias + col0 + bj * 128 + 4 * n);
#pragma unroll
        for (int ai = 0; ai < 2; ++ai)
#pragma unroll
            for (int m = 0; m < 4; ++m) { bf16_t* rowp = Z + (size_t)(row0 + ai * 128 + m * 16) * ZC + col0;
#pragma unroll
                for (int bj = 0; bj < 2; ++bj) { const f32x4 v0 = acc[ai][bj][m][0] + bv[bj][0], v1 = acc[ai][bj][m][1] + bv[bj][1];
                    u32x4 w; w.x = cvt_pk_bf16(v0[0], v0[1]); w.y = cvt_pk_bf16(v0[2], v0[3]); w.z = cvt_pk_bf16(v1[0], v1[1]); w.w = cvt_pk_bf16(v1[2], v1[3]);
                    *(u32x4*)(rowp + bj * 128) = w; } }
    }
};
template <bool STEP_B> struct EpiMerge {
    static constexpr bool PERM = true;
    const bf16_t* Zg; bf16_t* T1; bf16_t* G;
    __device__ __forceinline__ void operator()(const f32x4 (&acc)[2][2][4][2], const Unit& u, int wr, int wc, int fr, int fq) const {
        const int row0 = u.pm * 256 + wr * 64 + fr, col0 = u.pn * 256 + wc * 32 + 8 * fq;
#pragma unroll
        for (int ai = 0; ai < 2; ++ai)
#pragma unroll
            for (int m = 0; m < 4; ++m) { const size_t row = (size_t)(row0 + ai * 128 + m * 16);
#pragma unroll
                for (int bj = 0; bj < 2; ++bj) {
                    const int col = col0 + bj * 128;
                    const u32x4 gw = *(const u32x4*)(Zg + row * ZC + col);
                    f32x4 g0 = {sigmoidf_(bflo(gw.x)), sigmoidf_(bfhi(gw.x)), sigmoidf_(bflo(gw.y)), sigmoidf_(bfhi(gw.y))};
                    f32x4 g1 = {sigmoidf_(bflo(gw.z)), sigmoidf_(bfhi(gw.z)), sigmoidf_(bflo(gw.w)), sigmoidf_(bfhi(gw.w))};
                    f32x4 v0 = g0 * acc[ai][bj][m][0], v1 = g1 * acc[ai][bj][m][1];
                    bf16_t* tp = T1 + row * D + col;
                    if constexpr (!STEP_B) { u32x4 w; w.x = cvt_pk_bf16(v0[0], v0[1]); w.y = cvt_pk_bf16(v0[2], v0[3]); w.z = cvt_pk_bf16(v1[0], v1[1]); w.w = cvt_pk_bf16(v1[2], v1[3]); *(u32x4*)tp = w; }
                    else { const u32x4 t = *(const u32x4*)tp;
                        v0 += (f32x4){bflo(t.x), bfhi(t.x), bflo(t.y), bfhi(t.y)}; v1 += (f32x4){bflo(t.z), bfhi(t.z), bflo(t.w), bfhi(t.w)};
                        u32x4 w; w.x = cvt_pk_bf16(v0[0], v0[1]); w.y = cvt_pk_bf16(v0[2], v0[3]); w.z = cvt_pk_bf16(v1[0], v1[1]); w.w = cvt_pk_bf16(v1[2], v1[3]);
                        *(u32x4*)(G + row * D + col) = w; }
                } }
    }
};
struct EpiRes {
    static constexpr bool PERM = false;
    const float* x; const float* mods; float* out;
    __device__ __forceinline__ void operator()(const f32x4 (&acc)[2][2][4][2], const Unit& u, int wr, int wc, int fr, int fq) const {
        const int row0 = u.pm * 256 + wr * 64 + fr, col0 = u.pn * 256 + wc * 32 + 4 * fq;
        const float* gate = mods + (u.pm * 256 / SEQ) * 6144 + 2 * 1024;
        f32x4 gv[2][2];
#pragma unroll
        for (int bj = 0; bj < 2; ++bj)
#pragma unroll
            for (int n = 0; n < 2; ++n) gv[bj][n] = *(const f32x4*)(gate + col0 + bj * 128 + n * 16);
#pragma unroll
        for (int ai = 0; ai < 2; ++ai)
#pragma unroll
            for (int m = 0; m < 4; ++m) { const size_t off = (size_t)(row0 + ai * 128 + m * 16) * D + col0;
#pragma unroll
                for (int bj = 0; bj < 2; ++bj)
#pragma unroll
                    for (int n = 0; n < 2; ++n) *(f32x4*)(out + off + bj * 128 + n * 16) = *(const f32x4*)(x + off + bj * 128 + n * 16) + gv[bj][n] * acc[ai][bj][m][n]; }
    }
};
struct EpiMoe1 {
    static constexpr bool PERM = true;
    bf16_t* H2;
    __device__ __forceinline__ void operator()(const f32x4 (&acc)[2][2][4][2], const Unit& u, int wr, int wc, int fr, int fq) const {
        const int row0 = u.pm * 256 + wr * 64 + fr, col0 = u.pn * 128 + wc * 32 + 8 * fq;
#pragma unroll
        for (int ai = 0; ai < 2; ++ai)
#pragma unroll
            for (int m = 0; m < 4; ++m) { const size_t row = (size_t)(row0 + ai * 128 + m * 16);
                f32x4 v0, v1;
#pragma unroll
                for (int i = 0; i < 4; ++i) { v0[i] = siluf_(acc[ai][0][m][0][i]) * acc[ai][1][m][0][i]; v1[i] = siluf_(acc[ai][0][m][1][i]) * acc[ai][1][m][1][i]; }
                u32x4 w; w.x = cvt_pk_bf16(v0[0], v0[1]); w.y = cvt_pk_bf16(v0[2], v0[3]); w.z = cvt_pk_bf16(v1[0], v1[1]); w.w = cvt_pk_bf16(v1[2], v1[3]);
                *(u32x4*)(H2 + row * DEXP + col0) = w; }
    }
};
struct EpiBf {
    static constexpr bool PERM = true;
    bf16_t* O; int ldo;
    __device__ __forceinline__ void operator()(const f32x4 (&acc)[2][2][4][2], const Unit& u, int wr, int wc, int fr, int fq) const {
        const int row0 = u.pm * 256 + wr * 64 + fr, col0 = u.pn * 256 + wc * 32 + 8 * fq;
#pragma unroll
        for (int ai = 0; ai < 2; ++ai)
#pragma unroll
            for (int m = 0; m < 4; ++m) { bf16_t* rowp = O + (size_t)(row0 + ai * 128 + m * 16) * ldo + col0;
#pragma unroll
                for (int bj = 0; bj < 2; ++bj) { const f32x4 v0 = acc[ai][bj][m][0], v1 = acc[ai][bj][m][1];
                    u32x4 w; w.x = cvt_pk_bf16(v0[0], v0[1]); w.y = cvt_pk_bf16(v0[2], v0[3]); w.z = cvt_pk_bf16(v1[0], v1[1]); w.w = cvt_pk_bf16(v1[2], v1[3]);
                    *(u32x4*)(rowp + bj * 128) = w; } }
    }
};
struct EpiFilt {
    static constexpr bool PERM = false;
    _Float16* FILT;
    __device__ __forceinline__ void operator()(const f32x4 (&acc)[2][2][4][2], const Unit& u, int wr, int wc, int fr, int fq) const {
        typedef _Float16 h16x4 __attribute__((ext_vector_type(4)));
        const int row0 = u.pm * 256 + wr * 64 + fr, col0 = u.pn * 256 + wc * 32 + 4 * fq;
        const float dmin = -4.605170186f / 1.5f, dmax = -4.605170186f / 0.3f;
#pragma unroll
        for (int ai = 0; ai < 2; ++ai)
#pragma unroll
            for (int m = 0; m < 4; ++m) { const int r = row0 + ai * 128 + m * 16;
                const float dc = fabsf(dmin + (float)(r & 1023) * ((dmax - dmin) / 1023.0f)) * (1.0f / (float)(SEQ - 1));
#pragma unroll
                for (int bj = 0; bj < 2; ++bj)
#pragma unroll
                    for (int n = 0; n < 2; ++n) { const int lag = col0 + bj * 128 + n * 16; h16x4 o;
#pragma unroll
                        for (int i = 0; i < 4; ++i) o[i] = (_Float16)(acc[ai][bj][m][n][i] * __expf(-(float)(lag + i) * dc));
                        *(h16x4*)(FILT + (size_t)r * SEQ + lag) = o; } }
    }
};
struct InOrder {
    pg8::StaticOrder so; int G, c;
    __device__ bool next(int i, Unit& u) const {
        long L = (long)i * G + c;
        if (L < 64 * 37) return so.map(L, u);
        L -= 64 * 37; if (L >= 26) return false;
        const int j = (int)(L % 13); u.pm = 64 + (int)(L / 13); u.pn = j < 12 ? j : 36; u.e = 0; u.pad = 0; u.aoff = u.pm * so.astep; u.boff = u.pn * so.bstep; return true;
    }
};
struct MoeOrder {
    const LAS int* tile_e; int ntiles, G, c; long astep, bstep, estep;
    __device__ bool next(int i, Unit& u) const {
        const long L = (long)i * G + c; if (L >= (long)ntiles * 4) return false;
        u.pm = (int)(L >> 2); u.pn = (int)(L & 3); u.e = tile_e[u.pm]; u.pad = 0; u.aoff = u.pm * astep; u.boff = u.e * estep + u.pn * bstep; return true;
    }
};

__device__ __forceinline__ void qk_item(Frame& F, const Inputs& I, int b, int head, int ci) {
    constexpr int RPITCH = 1040, QP = 528, O_RAW = 0, O_QS = 69632, O_KS = 103424;
    bf16_t* Z = WSP(bf16_t, WS_Z); bf16_t* QKC = WSP(bf16_t, WS_QKC);
    LAS unsigned char* L = F.lds;
    const int tid = F.tid, lane = F.lane, w = F.wave, fr = lane & 15, fq = lane >> 4;
    const bool is_ctx = ci < 4; const int j = is_ctx ? ci : ci - 4;
    const int rbase = is_ctx ? M_LAT + b * CTXL : b * SEQ, t0 = 64 * j;
    const int seg_lo = is_ctx ? 0 : t0, seg_hi = is_ctx ? CTXL : t0 + 64;
    for (int id = tid; id < 66 * 64; id += 512) { const int r = id >> 6, c = id & 63, t = t0 - 1 + r;
        u32x4 v = {0u, 0u, 0u, 0u};
        if (t >= seg_lo && t < seg_hi) v = *(const u32x4*)(Z + (size_t)(rbase + t) * ZC + (c >> 5) * 1024 + head * 256 + 8 * (c & 31));
        *(LAS u32x4*)(L + O_RAW + r * RPITCH + c * 16) = v; }
    const int cc = tid & 63, colabs = (cc >> 5) * 1024 + head * 256 + 8 * (cc & 31);
    float wt[3][8], bs[8];
#pragma unroll
    for (int e = 0; e < 8; ++e) { wt[0][e] = I.w_qk_conv[colabs + e]; wt[1][e] = I.w_qk_conv[2048 + colabs + e]; wt[2][e] = I.w_qk_conv[4096 + colabs + e]; bs[e] = I.b_qk_conv[colabs + e]; }
    const float osc = cc >= 32 ? 0.0625f : 1.0f;
    __syncthreads();
#pragma unroll 2
    for (int i = 0; i < 8; ++i) { const int r = (tid >> 6) + 8 * i;
        const u32x4 c0 = *(const LAS u32x4*)(L + O_RAW + r * RPITCH + cc * 16), c1 = *(const LAS u32x4*)(L + O_RAW + (r + 1) * RPITCH + cc * 16), c2 = *(const LAS u32x4*)(L + O_RAW + (r + 2) * RPITCH + cc * 16);
        float o[8];
#pragma unroll
        for (int h = 0; h < 4; ++h) {
            const float v0 = wt[0][2 * h] * bflo(c0[h]) + wt[1][2 * h] * bflo(c1[h]) + wt[2][2 * h] * bflo(c2[h]) + bs[2 * h];
            const float v1 = wt[0][2 * h + 1] * bfhi(c0[h]) + wt[1][2 * h + 1] * bfhi(c1[h]) + wt[2][2 * h + 1] * bfhi(c2[h]) + bs[2 * h + 1];
            o[2 * h] = siluf_(v0) * osc; o[2 * h + 1] = siluf_(v1) * osc; }
        u32x4 ov; ov.x = pk2(o[0], o[1]); ov.y = pk2(o[2], o[3]); ov.z = pk2(o[4], o[5]); ov.w = pk2(o[6], o[7]);
        *(LAS u32x4*)(L + (cc >= 32 ? O_KS : O_QS) + r * QP + (cc & 31) * 16) = ov;
        if (is_ctx) *(u32x4*)(QKC + (size_t)(b * CTXL + t0 + r) * 2048 + colabs) = ov;
        else *(u32x4*)(Z + (size_t)(rbase + t0 + r) * ZC + colabs) = ov; }
    __syncthreads();
    {
        bf16_t* S0T = WSP(bf16_t, WS_S0T) + ((size_t)((b * 4 + head) * 132 + ci)) * 8192;
        const int tb = w >> 1;
#pragma unroll
        for (int sbi = 0; sbi < 2; ++sbi) { const int sb = 2 * (w & 1) + sbi;
            f32x4 acc = {0.f, 0.f, 0.f, 0.f};
#pragma unroll
            for (int kk = 0; kk < 8; ++kk) {
                const bf16x8 ka = *(const LAS bf16x8*)(L + O_KS + (16 * sb + fr) * QP + (32 * kk + 8 * fq) * 2);
                const bf16x8 qb = *(const LAS bf16x8*)(L + O_QS + (16 * tb + fr) * QP + (32 * kk + 8 * fq) * 2);
                acc = __builtin_amdgcn_mfma_f32_16x16x32_bf16(ka, qb, acc, 0, 0, 0); }
            const int t = 16 * tb + fr, s0 = 16 * sb + 4 * fq;
            u32x2 o; o.x = cvt_pk_bf16(s0 <= t ? acc[0] : 0.f, s0 + 1 <= t ? acc[1] : 0.f); o.y = cvt_pk_bf16(s0 + 2 <= t ? acc[2] : 0.f, s0 + 3 <= t ? acc[3] : 0.f);
            *(u32x2*)(S0T + t * 64 + s0) = o;
            o.x = cvt_pk_bf16(s0 + 3 >= t ? acc[3] : 0.f, s0 + 2 >= t ? acc[2] : 0.f); o.y = cvt_pk_bf16(s0 + 1 >= t ? acc[1] : 0.f, s0 >= t ? acc[0] : 0.f);
            *(u32x2*)(S0T + 4096 + (63 - t) * 64 + (60 - s0)) = o; }
    }
    __syncthreads();
}
__device__ __forceinline__ void hyprep_item(Frame& F, const Inputs& I, int tb, int chb) {
    const bf16_t* Z = WSP(bf16_t, WS_Z); bf16_t* SCM = WSP(bf16_t, WS_SCM);
    constexpr int PITCH = 144;
    LAS unsigned char* X1T = F.lds; LAS unsigned char* VT = F.lds + 64 * PITCH;
    const int p = chb >> 1, j0 = (chb & 1) * 64;
    {   const int r = F.tid >> 3, cc = F.tid & 7; const bf16_t* src = Z + (size_t)(tb * 64 + r) * ZC + ZC_PAIR + 256 * p + j0 + 8 * cc;
        *(LAS u32x4*)(X1T + r * PITCH + cc * 16) = *(const u32x4*)src;
        *(LAS u32x4*)(VT + r * PITCH + cc * 16) = *(const u32x4*)(src + 128); }
    __syncthreads();
    {   const int ch = F.tid >> 3, t8 = (F.tid & 7) * 8, c = chb * 64 + ch;
        float wx[3], wv[3];
#pragma unroll
        for (int k = 0; k < 3; ++k) { wx[k] = I.w_h_conv[k * 3072 + 1024 + c]; wv[k] = I.w_h_conv[k * 3072 + 2048 + c]; }
        const float bx = I.b_h_conv[1024 + c], bv = I.b_h_conv[2048 + c];
        float xs[10], vs[10];
#pragma unroll
        for (int i = 0; i < 10; ++i) { const int r = t8 - 1 + i; const bool ok = r >= 0 && r < 64;
            xs[i] = ok ? bf2f(*(const LAS bf16_t*)(X1T + r * PITCH + ch * 2)) : 0.f; vs[i] = ok ? bf2f(*(const LAS bf16_t*)(VT + r * PITCH + ch * 2)) : 0.f; }
        float s[8];
#pragma unroll
        for (int i = 0; i < 8; ++i) s[i] = (wx[0] * xs[i] + wx[1] * xs[i + 1] + wx[2] * xs[i + 2] + bx) * (wv[0] * vs[i] + wv[1] * vs[i + 1] + wv[2] * vs[i + 2] + bv);
        u32x4 o; o.x = pk2(s[0], s[1]); o.y = pk2(s[2], s[3]); o.z = pk2(s[4], s[5]); o.w = pk2(s[6], s[7]);
        const int b = tb >> 7, t0 = (tb & 127) * 64;
        *(u32x4*)(SCM + ((size_t)(b * 1024 + c)) * SEQ + t0 + t8) = o; }
    __syncthreads();
}
__device__ __forceinline__ void phase2a(Frame& F, const Inputs& I) {
    unsigned* q1 = WSP(unsigned, WS_CTL) + CW_Q1;
    volatile LAS int* itp = (volatile LAS int*)(F.lds + MISC_OFF + 64);
    for (;;) {
        if (F.tid == 0) *itp = (int)atomicAdd(q1, 1u);
        __syncthreads();
        const int it = *itp;
        __syncthreads();
        if (it >= 1056 + 4096) break;
        if (it < 1056) qk_item(F, I, it / 528, (it / 132) & 3, it % 132);
        else { const int j = it - 1056; hyprep_item(F, I, j >> 4, j & 15); }
    }
}

__device__ __forceinline__ bf16x8 tr_frag(const LAS unsigned char* p0, const LAS unsigned char* p1) {
    const s16x4 a = __builtin_amdgcn_ds_read_tr16_b64_v4i16((LAS s16x4*)p0);
    const s16x4 b = __builtin_amdgcn_ds_read_tr16_b64_v4i16((LAS s16x4*)p1);
    return (bf16x8){a[0], a[1], a[2], a[3], b[0], b[1], b[2], b[3]};
}
template <int CTRL, int RM, bool BC> __device__ __forceinline__ float dppf(float old, float x) {
    return __builtin_bit_cast(float, __builtin_amdgcn_update_dpp(__builtin_bit_cast(int, old), __builtin_bit_cast(int, x), CTRL, RM, 0xf, BC)); }
__device__ __forceinline__ float wave_scan_sum(float x) {
    x += dppf<0x111, 0xf, true>(0.f, x); x += dppf<0x112, 0xf, true>(0.f, x); x += dppf<0x114, 0xf, true>(0.f, x); x += dppf<0x118, 0xf, true>(0.f, x);
    x += dppf<0x142, 0xa, false>(0.f, x); x += dppf<0x143, 0xc, false>(0.f, x); return x; }
__device__ __forceinline__ float wave_scan_max(float x) {
    const float ninf = -__builtin_inff();
    x = fmaxf(x, dppf<0x111, 0xf, false>(ninf, x)); x = fmaxf(x, dppf<0x112, 0xf, false>(ninf, x)); x = fmaxf(x, dppf<0x114, 0xf, false>(ninf, x)); x = fmaxf(x, dppf<0x118, 0xf, false>(ninf, x));
    x = fmaxf(x, dppf<0x142, 0xa, false>(ninf, x)); x = fmaxf(x, dppf<0x143, 0xc, false>(ninf, x)); return x; }
__device__ __forceinline__ float lane63(float x) { return __builtin_bit_cast(float, __builtin_amdgcn_readlane(__builtin_bit_cast(int, x), 63)); }
__device__ __forceinline__ void mlstm_item(Frame& F, const Inputs& I, int item) {
    constexpr int QP = 528, VP = 112, PP = 144;
    constexpr int O_QS = 0, O_KS = 33792, O_VW = 67584, O_PS = 74752, O_CS = 83968, CS_BYTES = 25344, O_DEN = 134656, O_SC = 135168, SC_BYTES = 6 * 64 * 4;
    const int b = item >> 6, g = (item >> 3) & 7, dir = g >> 2, head = g & 3, eb = item & 7;
    int tid = F.tid; asm volatile("" : "+v"(tid));
    const int lane = tid & 63, w = F.wave, fr = lane & 15, fq = lane >> 4;
    LAS unsigned char* L = F.lds;
    bf16_t* Z = WSP(bf16_t, WS_Z); const float* gates = WSP(float, WS_GATES);
    const unsigned char* wsb = F.ws;
    const int qcol = head * 256, vcol = 2048 + head * 256 + eb * 32, ocol = 3072 + head * 256 + eb * 32;
    const int outcol = ZC_PAIR + dir * 1024 + head * 256 + eb * 32;
    const int gi = dir * 4 + head;
    for (int i = tid; i < 64 * 16; i += 512) { const int r = i >> 4, cidx = 32 + (i & 15);
        *(LAS bf16_t*)(L + O_VW + r * VP + cidx * 2) = (bf16_t)0; }
    for (int i = tid; i < 2 * CS_BYTES / 4; i += 512) *(LAS unsigned*)(L + O_CS + 4 * i) = 0u;
    f32x4 Cacc[2][3];
#pragma unroll
    for (int a = 0; a < 2; ++a)
#pragma unroll
        for (int c = 0; c < 3; ++c) Cacc[a][c] = (f32x4){0.f, 0.f, 0.f, 0.f};
    struct Stage { u32x4 q[4], k[4], v, s; float ig, fg; };
    Stage R0, R1;
    const int scc = tid & 31, srow0 = tid >> 5;
    const int ppos = tid >> 3, ps8 = (tid & 7) * 8;
    auto geom = [&](int st, int& rbase, int& tlo, int& ci) { const bool ctx = st < 4; const int j = ctx ? st : st - 4, sl = ctx ? CTXL : SEQ;
        rbase = ctx ? M_LAT + b * CTXL : b * SEQ; tlo = dir == 0 ? 64 * j : sl - 64 * (j + 1); ci = (ctx ? 0 : 4) + (tlo >> 6); };
    auto prefetch = [&](int st, Stage& R) { int rbase, tlo, ci; geom(st, rbase, tlo, ci);
        const int t = dir == 0 ? tlo + lane : tlo + 63 - lane;
        const unsigned goff = (unsigned)(rbase + t) * 64u + (unsigned)gi * 4u;
        R.ig = *(const float*)(wsb + (unsigned)WS_GATES + goff); R.fg = *(const float*)(wsb + (unsigned)WS_GATES + goff + 32u);
        const unsigned qoff = st < 4 ? (unsigned)WS_QKC + (unsigned)(b * CTXL + tlo + srow0) * 4096u + (unsigned)head * 512u + (unsigned)scc * 16u
                                     : (unsigned)WS_Z + (unsigned)(rbase + tlo + srow0) * (unsigned)(ZC * 2) + (unsigned)qcol * 2u + (unsigned)scc * 16u;
        const unsigned qpitch = st < 4 ? 16u * 4096u : 16u * (unsigned)(ZC * 2);
#pragma unroll
        for (int i = 0; i < 4; ++i) { R.q[i] = *(const u32x4*)(wsb + (qoff + i * qpitch)); R.k[i] = *(const u32x4*)(wsb + (qoff + i * qpitch + 2048u)); }
        R.v = *(const u32x4*)(wsb + ((unsigned)WS_Z + (unsigned)(rbase + tlo + ((tid & 255) >> 2)) * (unsigned)(ZC * 2) + (unsigned)vcol * 2u + (unsigned)(tid & 3) * 16u));
        const unsigned soff = (unsigned)WS_S0T + (unsigned)(((b * 4 + head) * 132 + ci) * 2 + dir) * 8192u + (unsigned)(ppos * 64 + ps8) * 2u;
        R.s = *(const u32x4*)(wsb + soff); };
    auto commit = [&](int buf, const Stage& R) {
        const LAS float* SCn = (const LAS float*)(L + O_SC + buf * SC_BYTES);
#pragma unroll
        for (int i = 0; i < 4; ++i) { const int mr = srow0 + 16 * i, p = dir ? 63 - mr : mr; *(LAS u32x4*)(L + O_QS + p * QP + scc * 16) = R.q[i]; *(LAS u32x4*)(L + O_KS + p * QP + scc * 16) = R.k[i]; }
        if (tid < 256) { const int mr = tid >> 2, p = dir ? 63 - mr : mr; const u32x4 pv = R.v;
            const float wg = SCn[256 + p]; u32x4 vo;
            vo.x = cvt_pk_bf16(bflo(pv.x) * wg, bfhi(pv.x) * wg); vo.y = cvt_pk_bf16(bflo(pv.y) * wg, bfhi(pv.y) * wg); vo.z = cvt_pk_bf16(bflo(pv.z) * wg, bfhi(pv.z) * wg); vo.w = cvt_pk_bf16(bflo(pv.w) * wg, bfhi(pv.w) * wg);
            *(LAS u32x4*)(L + O_VW + p * VP + (tid & 3) * 16) = vo; }
        else if (tid < 320) { const int p = tid - 256; *(LAS bf16_t*)(L + O_VW + p * VP + 64) = (bf16_t)f2bf(SCn[256 + p]); }
        *(LAS u32x4*)(L + O_PS + ppos * PP + ps8 * 2) = R.s; };
#define LDS_BAR() do { asm volatile("s_waitcnt lgkmcnt(0)" ::: "memory"); __builtin_amdgcn_s_barrier(); asm volatile("" ::: "memory"); } while (0)
    float mnext = 0.f;
    auto scalars = [&](float ig, float fg, int buf) {
        if (w == 7) {
            const float mprev = mnext;
            const float fc = fminf(fg, 0.f) - __logf(1.0f + __expf(-fabsf(fg)));
            const float bcum = wave_scan_sum(fc);
            const float aval = ig - bcum;
            const float cm = fmaxf(mprev, wave_scan_max(aval));
            const float cm63 = lane63(cm), b63 = lane63(bcum);
            mnext = b63 + cm63;
            LAS float* sc = (LAS float*)(L + O_SC + buf * SC_BYTES) + lane;
            sc[0] = __expf(fminf(cm63 - cm, 80.f)); sc[128] = __expf(mprev - cm); sc[192] = __expf(-(bcum + cm)); sc[256] = __expf(aval - cm63);
            if (lane == 0) sc[320] = __expf(mprev - cm63);
        } };
    prefetch(0, R0);
    scalars(R0.ig, R0.fg, 0);
    __syncthreads();
    commit(0, R0);
    prefetch(1, R1);
    __syncthreads();
    int cur = 0;
    auto step = [&](int st, Stage& RA, Stage& RB) {
        const bool has_next = st + 1 < 132, is_ctx = st < 4;
        int rbase_c, tlo_c, ci_c; geom(st, rbase_c, tlo_c, ci_c);
        unsigned short ov[4];
#pragma unroll
        for (int i = 0; i < 4; ++i) { const int p = 16 * (w & 3) + 4 * fq + i, t = dir == 0 ? tlo_c + p : tlo_c + 63 - p;
            ov[i] = *(const bf16_t*)(wsb + ((unsigned)WS_Z + (unsigned)(rbase_c + t) * (unsigned)(ZC * 2) + (unsigned)(ocol + 16 * (w >> 2) + fr) * 2u)); }
        prefetch(st + 2 < 132 ? st + 2 : 131, RA);
        const LAS float* SC = (const LAS float*)(L + O_SC + cur * SC_BYTES);
        const float c_decay = SC[320];
        const int tt = w & 3, et = w >> 2;
        const int trg = lane >> 4, trq = (lane & 15) >> 2, trp = lane & 3;
        f32x4 nacc;
        {
            const LAS unsigned char* CSc = L + O_CS + cur * CS_BYTES;
            const f32x4 cs4 = *(const LAS f32x4*)(SC + 128 + 16 * tt + 4 * fq), rs4 = *(const LAS f32x4*)(SC + 16 * tt + 4 * fq);
            f32x4 a = {0.f, 0.f, 0.f, 0.f}, ia = {0.f, 0.f, 0.f, 0.f}, da = {0.f, 0.f, 0.f, 0.f}, dia = {0.f, 0.f, 0.f, 0.f};
#pragma unroll
            for (int kk = 0; kk < 8; ++kk) {
                const bf16x8 qa = *(const LAS bf16x8*)(L + O_QS + (16 * tt + fr) * QP + (32 * kk + 8 * fq) * 2);
                const bf16x8 cb = *(const LAS bf16x8*)(CSc + (16 * et + fr) * QP + (32 * kk + 8 * fq) * 2);
                a = __builtin_amdgcn_mfma_f32_16x16x32_bf16(qa, cb, a, 0, 0, 0);
                if ((kk >> 2) == et) { const bf16x8 cd = *(const LAS bf16x8*)(CSc + (32 + fr) * QP + (32 * kk + 8 * fq) * 2);
                    da = __builtin_amdgcn_mfma_f32_16x16x32_bf16(qa, cd, da, 0, 0, 0); } }
#pragma unroll
            for (int ks = 0; ks < 2; ++ks) {
                const bf16x8 pa = *(const LAS bf16x8*)(L + O_PS + (16 * tt + fr) * PP + (32 * ks + 8 * fq) * 2);
                const LAS unsigned char* vb = L + O_VW + (32 * ks + 8 * trg + trq) * VP + (16 * et + 4 * trp) * 2;
                ia = __builtin_amdgcn_mfma_f32_16x16x32_bf16(pa, tr_frag(vb, vb + 4 * VP), ia, 0, 0, 0);
                if (ks == et) { const LAS unsigned char* vd = L + O_VW + (32 * ks + 8 * trg + trq) * VP + (32 + 4 * trp) * 2;
                    dia = __builtin_amdgcn_mfma_f32_16x16x32_bf16(pa, tr_frag(vd, vd + 4 * VP), dia, 0, 0, 0); } }
            nacc = a * cs4 + ia * rs4;
            const f32x4 dacc = da * cs4 + dia * rs4;
            if (fr == 0) *(LAS f32x4*)(L + O_DEN + et * 256 + (16 * tt + 4 * fq) * 4) = dacc;
        }
        {
            LAS unsigned char* CSn = L + O_CS + (cur ^ 1) * CS_BYTES;
#pragma unroll
            for (int a = 0; a < 2; ++a)
#pragma unroll
                for (int c = 0; c < 3; ++c) Cacc[a][c] = Cacc[a][c] * c_decay;
#pragma unroll
            for (int ks = 0; ks < 2; ++ks) {
                bf16x8 ka[2], vb[3];
#pragma unroll
                for (int a = 0; a < 2; ++a) { const LAS unsigned char* p = L + O_KS + (32 * ks + 8 * trg + trq) * QP + (16 * (2 * w + a) + 4 * trp) * 2; ka[a] = tr_frag(p, p + 4 * QP); }
#pragma unroll
                for (int c = 0; c < 3; ++c) { const LAS unsigned char* p = L + O_VW + (32 * ks + 8 * trg + trq) * VP + (16 * c + 4 * trp) * 2; vb[c] = tr_frag(p, p + 4 * VP); }
#pragma unroll
                for (int a = 0; a < 2; ++a)
#pragma unroll
                    for (int c = 0; c < 3; ++c) Cacc[a][c] = __builtin_amdgcn_mfma_f32_16x16x32_bf16(ka[a], vb[c], Cacc[a][c], 0, 0, 0);
            }
#pragma unroll
            for (int a = 0; a < 2; ++a)
#pragma unroll
                for (int c = 0; c < 3; ++c) { u32x2 o; o.x = cvt_pk_bf16(Cacc[a][c][0], Cacc[a][c][1]); o.y = cvt_pk_bf16(Cacc[a][c][2], Cacc[a][c][3]);
                    *(LAS u32x2*)(CSn + (16 * c + fr) * QP + (16 * (2 * w + a) + 4 * fq) * 2) = o; }
        }
        if (has_next) scalars(RB.ig, RB.fg, cur ^ 1);
        LDS_BAR();
        if (!is_ctx) {
            const f32x4 den4 = *(const LAS f32x4*)(L + O_DEN + (16 * tt + 4 * fq) * 4) + *(const LAS f32x4*)(L + O_DEN + 256 + (16 * tt + 4 * fq) * 4), em4 = *(const LAS f32x4*)(SC + 192 + 16 * tt + 4 * fq);
#pragma unroll
            for (int i = 0; i < 4; ++i) { const int p = 16 * tt + 4 * fq + i, t = dir == 0 ? tlo_c + p : tlo_c + 63 - p;
                const float h = nacc[i] * __builtin_amdgcn_rcpf(fmaxf(fabsf(den4[i]), em4[i]));
                *(bf16_t*)(F.ws + ((unsigned)WS_Z + (unsigned)(rbase_c + t) * (unsigned)(ZC * 2) + (unsigned)(outcol + 16 * et + fr) * 2u)) = (bf16_t)f2bf(sigmoidf_(bf2f(ov[i])) * h); }
        }
        if (has_next) commit(cur ^ 1, RB);
        cur ^= 1;
        LDS_BAR();
    };
    for (int st = 0; st < 132; st += 2) { step(st, R0, R1); step(st + 1, R1, R0); }
    __syncthreads();
#undef LDS_BAR
}

__device__ __forceinline__ void hyena_item(Frame& F, const Inputs& I, int c) {
    LAS f32x2* X = (LAS f32x2*)F.lds;
    int tid = F.tid; asm volatile("" : "+v"(tid));
    const bf16_t* s0 = WSP(bf16_t, WS_SCM) + (size_t)c * SEQ; const bf16_t* s1 = s0 + (size_t)1024 * SEQ;
    const f32x2* fs = WSP(f32x2, WS_FSPEC) + (size_t)c * FS_PITCH;
    bf16_t* y0 = WSP(bf16_t, WS_H) + (size_t)c * SEQ; bf16_t* y1 = y0 + (size_t)1024 * SEQ;
    unsigned skeep[16];
    {
        f32x2 v[32];
#pragma unroll
        for (int r = 0; r < 16; ++r) { const int t = tid + 512 * r; const unsigned a = s0[t], bq = s1[t]; skeep[r] = a | (bq << 16); v[r] = (f32x2){bf2f((unsigned short)a), bf2f((unsigned short)bq)}; }
#pragma unroll
        for (int r = 16; r < 32; ++r) v[r] = (f32x2){0.f, 0.f};
        __syncthreads();
        fft_pass_a_store(v, X, tid);
    }
    __syncthreads();
    fft_pass_b(X, tid);
    __syncthreads();
    {
        f32x2 v[32]; fft_pass_c_compute(v, X, tid);
        asm volatile("" ::: "memory"); __builtin_amdgcn_sched_barrier(0);
#pragma unroll
        for (int u = 0; u < 2; ++u)
#pragma unroll
            for (int p = 0; p < 16; ++p) { const int idx = tid + 512 * u + 1024 * bitrev(p, 4);
                f32x2 f = idx <= 8192 ? fs[idx] : fs[FFT_N - idx]; if (idx > 8192) f.y = -f.y;
                const f32x2 y = cmul(v[16 * u + p], f); v[16 * u + p] = (f32x2){y.x, -y.y}; }
        __syncthreads();
#pragma unroll
        for (int u = 0; u < 2; ++u) { int jj = tid + 512 * u; asm volatile("" : "+v"(jj)); LAS f32x2* xb = X + jj + (jj >> 5);
#pragma unroll
            for (int p = 0; p < 16; ++p) xb[1056 * bitrev(p, 4)] = v[16 * u + p]; }
    }
    __syncthreads();
    {   f32x2 v[32]; fft_load32(v, X, tid); __syncthreads(); fft_pass_a_store(v, X, tid); }
    __syncthreads();
    fft_pass_b(X, tid);
    __syncthreads();
    {   f32x2 v[32]; fft_pass_c_compute(v, X, tid);
        asm volatile("" ::: "memory"); __builtin_amdgcn_sched_barrier(0);
        const float hb = I.h_bias[c];
#pragma unroll
        for (int u = 0; u < 2; ++u)
#pragma unroll
            for (int p = 0; p < 16; ++p) { const int q = bitrev(p, 4);
                if (q < 8) { const int idx = tid + 512 * u + 1024 * q; const unsigned sk = skeep[u + 2 * q];
                    const float o0 = v[16 * u + p].x + hb * bflo(sk), o1 = -v[16 * u + p].y + hb * bfhi(sk);
                    y0[idx] = (bf16_t)f2bf(o0); y1[idx] = (bf16_t)f2bf(o1); } }
    }
    __syncthreads();
}
__device__ __forceinline__ void hy_item(Frame& F, const Inputs& I, int tb, int chb) {
    bf16_t* Z = WSP(bf16_t, WS_Z); const bf16_t* YCM = WSP(bf16_t, WS_H);
    constexpr int PITCH = 144;
    LAS unsigned char* X0T = F.lds; LAS unsigned char* YT = F.lds + 64 * PITCH;
    const int b = tb >> 7, t0 = (tb & 127) * 64;
    {   const int r = F.tid >> 3, cc = F.tid & 7;
        *(LAS u32x4*)(X0T + r * PITCH + cc * 16) = *(const u32x4*)(Z + (size_t)(tb * 64 + r) * ZC + ZC_X0 + chb * 64 + 8 * cc);
        *(LAS u32x4*)(YT + r * PITCH + cc * 16) = *(const u32x4*)(YCM + ((size_t)(b * 1024 + chb * 64 + r)) * SEQ + t0 + 8 * cc); }
    __syncthreads();
    {   const int r = F.tid >> 3, cc = F.tid & 7;
        const u32x4 z = {0u, 0u, 0u, 0u};
        const u32x4 c1 = *(const LAS u32x4*)(X0T + r * PITCH + cc * 16);
        const u32x4 c0 = r > 0 ? *(const LAS u32x4*)(X0T + (r - 1) * PITCH + cc * 16) : z;
        const u32x4 c2 = r < 63 ? *(const LAS u32x4*)(X0T + (r + 1) * PITCH + cc * 16) : z;
        float o[8];
        const int cb8 = chb * 64 + 8 * cc;
        const f32x4 w0a = *(const f32x4*)(I.w_h_conv + cb8), w0b = *(const f32x4*)(I.w_h_conv + cb8 + 4), w1a = *(const f32x4*)(I.w_h_conv + 3072 + cb8), w1b = *(const f32x4*)(I.w_h_conv + 3072 + cb8 + 4);
        const f32x4 w2a = *(const f32x4*)(I.w_h_conv + 6144 + cb8), w2b = *(const f32x4*)(I.w_h_conv + 6144 + cb8 + 4), bba = *(const f32x4*)(I.b_h_conv + cb8), bbb = *(const f32x4*)(I.b_h_conv + cb8 + 4);
#pragma unroll
        for (int e = 0; e < 8; ++e) { const int h = e >> 1;
            const float a0 = (e & 1) ? bfhi(c0[h]) : bflo(c0[h]), a1 = (e & 1) ? bfhi(c1[h]) : bflo(c1[h]), a2 = (e & 1) ? bfhi(c2[h]) : bflo(c2[h]);
            const float k0 = e < 4 ? w0a[e & 3] : w0b[e & 3], k1 = e < 4 ? w1a[e & 3] : w1b[e & 3], k2 = e < 4 ? w2a[e & 3] : w2b[e & 3], kb = e < 4 ? bba[e & 3] : bbb[e & 3];
            const float x0 = k0 * a0 + k1 * a1 + k2 * a2 + kb;
            o[e] = x0 * bf2f(*(const LAS bf16_t*)(YT + (8 * cc + e) * PITCH + r * 2)); }
        u32x4 ov; ov.x = pk2(o[0], o[1]); ov.y = pk2(o[2], o[3]); ov.z = pk2(o[4], o[5]); ov.w = pk2(o[6], o[7]);
        *(u32x4*)(Z + (size_t)(tb * 64 + r) * ZC + ZC_X0 + chb * 64 + 8 * cc) = ov; }
    __syncthreads();
}

__device__ __forceinline__ void phase2b(Frame& F, const Inputs& I) {
    const int GA = F.G >= 2 ? F.G / 2 : 1, GB = F.G - GA;
    if (F.vcu < GA) { for (int it = F.vcu; it < 128; it += GA) mlstm_item(F, I, it); __syncthreads(); }
    if (GB == 0 || F.vcu >= GA) {
        const int c0 = GB ? F.vcu - GA : 0, cs = GB ? GB : 1;
        unsigned* sub = WSP(unsigned, WS_CTL) + CW_SUB;
        const int cpw = (1024 / 2 + cs - 1) / cs * 2, cb = c0 * cpw, ce = cb + cpw < 1024 ? cb + cpw : 1024;
        fft_twiddle_init(F.lds, F.tid);
        __syncthreads();
        for (int c = cb; c < ce; c += 2) filter_spec_item(F, I, c >> 1);
        for (int c = cb; c < ce; ++c) hyena_item(F, I, c);
        subgrid_barrier(sub, (unsigned)cs, 1u);
        for (int it = c0; it < 4096; it += cs) hy_item(F, I, it >> 4, it & 15);
        subgrid_barrier(sub, (unsigned)cs, 2u);
        {
            bf16_t* Z = WSP(bf16_t, WS_Z);
            pg8::Gemm g{Z + ZC_X0, WSP(bf16_t, WS_WB_T), ZC, D, D};
            pg8::StaticOrder S; S.init(64, 4, cs, c0, 256L * ZC * 2, 256L * D * 2);
            EpiMerge<false> E{Z + ZC_GB, WSP(bf16_t, WS_FSPEC), nullptr};
            pg8::gemm_phase<EpiMerge<false>, pg8::StaticOrder, true>(F.lds, g, S, E);
        }
    }
}

struct XtItem { const float* W; int N, k0, n0; bf16_t* WT; int ldt, drow0; };
__device__ __forceinline__ XtItem xt_decode(const Inputs& I, bf16_t* W13T, bf16_t* W2T, int it) {
    constexpr int PER_E = 3 * 256;
    const int e = it / PER_E, r = it % PER_E, m = r >> 8, rr = r & 255; XtItem x;
    if (m < 2) { const int kb = rr >> 4, nb = rr & 15, n0 = 32 * nb;
        x.W = (m == 0 ? I.w1_e : I.w3_e) + (size_t)e * D * DEXP; x.N = DEXP; x.k0 = 64 * kb; x.n0 = n0; x.WT = W13T + (size_t)e * 1024 * 1024; x.ldt = D; x.drow0 = (n0 >> 7) * 256 + m * 128 + (n0 & 127); }
    else { const int kb = rr >> 5, nb = rr & 31;
        x.W = I.w2_e + (size_t)e * DEXP * D; x.N = D; x.k0 = 64 * kb; x.n0 = 32 * nb; x.WT = W2T + (size_t)e * 1024 * DEXP; x.ldt = DEXP; x.drow0 = 32 * nb; }
    return x;
}
__device__ __forceinline__ void xt_load(const XtItem& x, float (&v)[32], int lane) {
    const float* p = x.W + (size_t)(x.k0 + (lane >> 5)) * x.N + x.n0 + (lane & 31);
#pragma unroll
    for (int i = 0; i < 32; ++i) v[i] = p[(size_t)(2 * i) * x.N];
}
__device__ __forceinline__ void xt_finish(const XtItem& x, const float (&v)[32], LAS float* scr, int lane) {
#pragma unroll
    for (int i = 0; i < 32; ++i) scr[(2 * i + (lane >> 5)) * 33 + (lane & 31)] = v[i];
    asm volatile("s_waitcnt lgkmcnt(0)" ::: "memory");
    const int c = lane & 7;
#pragma unroll
    for (int j = 0; j < 4; ++j) { const int n = (lane >> 3) + 8 * j; const LAS float* s = scr + (8 * c) * 33 + n;
        u32x4 o; o.x = pk2(s[0 * 33], s[1 * 33]); o.y = pk2(s[2 * 33], s[3 * 33]); o.z = pk2(s[4 * 33], s[5 * 33]); o.w = pk2(s[6 * 33], s[7 * 33]);
        *(u32x4*)(x.WT + (size_t)(x.drow0 + n) * x.ldt + x.k0 + 8 * c) = o; }
    asm volatile("s_waitcnt lgkmcnt(0)" ::: "memory");
}
__device__ __forceinline__ void expert_transposes(Frame& F, const Inputs& I, int part, int nparts, int wg, int nwg) {
    LAS float* scr = (LAS float*)(F.lds + F.wave * 16384);
    const int gw = wg * 8 + F.wave, NGW = nwg * 8;
    constexpr int NIT = NEXP * 3 * 256;
    const int lo = (int)((long)NIT * part / nparts), hi = (int)((long)NIT * (part + 1) / nparts);
    bf16_t* W13T = WSP(bf16_t, WS_W13T); bf16_t* W2T = WSP(bf16_t, WS_W2T);
    int it = lo + gw; if (it >= hi) return;
    float va[32], vb[32];
    XtItem xa = xt_decode(I, W13T, W2T, it), xb = xa;
    xt_load(xa, va, F.lane);
    for (;;) {
        const bool nb = it + NGW < hi;
        if (nb) { xb = xt_decode(I, W13T, W2T, it + NGW); xt_load(xb, vb, F.lane); }
        xt_finish(xa, va, scr, F.lane);
        if (!nb) break;
        it += NGW;
        const bool na = it + NGW < hi;
        if (na) { xa = xt_decode(I, W13T, W2T, it + NGW); xt_load(xa, va, F.lane); }
        xt_finish(xb, vb, scr, F.lane);
        if (!na) break;
        it += NGW;
    }
}

struct Route { int e0, e1; float w0, w1; };
__device__ __forceinline__ void route_item(Frame& F, const Inputs& I, const float* x1, int blk) {
    constexpr int RP = 528;
    constexpr int O_AH = 0, O_AL = 33792, O_BH = 67584, O_BL = 109824, O_SSQ = 152064, O_LC = 152320;
    LAS unsigned char* L = F.lds;
    const int tid = F.tid, lane = F.lane, w = F.wave, fr = lane & 15, fq = lane >> 4;
    const int row0 = blk * 64, b = row0 / SEQ;
    const float* mods = WSP(float, WS_MODS) + b * 6144;
    const bf16_t* w72s = WSP(bf16_t, WS_W72S);
    f32x4 acc[3];
#pragma unroll
    for (int t = 0; t < 3; ++t) acc[t] = (f32x4){0.f, 0.f, 0.f, 0.f};
    const int sr = tid >> 3, seg = tid & 7;
    float ssq = 0.f;
    if (tid < 64) *(LAS int*)(L + O_LC + 4 * tid) = 0;
    for (int kt = 0; kt < 4; ++kt) {
#pragma unroll
        for (int i = 0; i < 8; ++i) { const int kk = 32 * i + 4 * seg, k = kt * 256 + kk;
            const f32x4 xv = *(const f32x4*)(x1 + (size_t)(row0 + sr) * D + k);
            ssq += (xv.x * xv.x + xv.y * xv.y) + (xv.z * xv.z + xv.w * xv.w);
            const f32x4 g = *(const f32x4*)(I.g_norm2 + k), sc = *(const f32x4*)(mods + 4 * 1024 + k);
            const f32x4 hv = xv * g * (sc + 1.0f);
            const unsigned h0 = f2bf(hv.x), h1 = f2bf(hv.y), h2 = f2bf(hv.z), h3 = f2bf(hv.w);
            const u32x2 hi = {h0 | (h1 << 16), h2 | (h3 << 16)};
            const u32x2 lo = {pk2(hv.x - bf2f((unsigned short)h0), hv.y - bf2f((unsigned short)h1)), pk2(hv.z - bf2f((unsigned short)h2), hv.w - bf2f((unsigned short)h3))};
            *(LAS u32x2*)(L + O_AH + sr * RP + kk * 2) = hi; *(LAS u32x2*)(L + O_AL + sr * RP + kk * 2) = lo; }
#pragma unroll
        for (int j = 0; j < 10; ++j) { const int id = tid + 512 * j, which = id / 2560, rem = id % 2560, col = rem >> 5, c16 = rem & 31;
            *(LAS u32x4*)(L + (which ? O_BL : O_BH) + col * RP + c16 * 16) = *(const u32x4*)(w72s + (size_t)(col * 2 + which) * 1024 + kt * 256 + c16 * 8); }
        __syncthreads();
#pragma unroll
        for (int ti = 0; ti < 3; ++ti) { const int T = w + 8 * ti;
            if (T < 20) { const int rt = T & 3, ct = T >> 2;
#pragma unroll
                for (int k8 = 0; k8 < 8; ++k8) {
                    const bf16x8 ah = *(const LAS bf16x8*)(L + O_AH + (16 * rt + fr) * RP + (32 * k8 + 8 * fq) * 2), al = *(const LAS bf16x8*)(L + O_AL + (16 * rt + fr) * RP + (32 * k8 + 8 * fq) * 2);
                    const bf16x8 bh = *(const LAS bf16x8*)(L + O_BH + (16 * ct + fr) * RP + (32 * k8 + 8 * fq) * 2), bl = *(const LAS bf16x8*)(L + O_BL + (16 * ct + fr) * RP + (32 * k8 + 8 * fq) * 2);
                    acc[ti] = __builtin_amdgcn_mfma_f32_16x16x32_bf16(ah, bh, acc[ti], 0, 0, 0);
                    acc[ti] = __builtin_amdgcn_mfma_f32_16x16x32_bf16(al, bh, acc[ti], 0, 0, 0);
                    acc[ti] = __builtin_amdgcn_mfma_f32_16x16x32_bf16(ah, bl, acc[ti], 0, 0, 0);
                } } }
        __syncthreads();
    }
    ssq += __shfl_xor(ssq, 1); ssq += __shfl_xor(ssq, 2); ssq += __shfl_xor(ssq, 4);
    if (seg == 0) *(LAS float*)(L + O_SSQ + 4 * sr) = ssq;
    LAS float* LOG = (LAS float*)L;
#pragma unroll
    for (int ti = 0; ti < 3; ++ti) { const int T = w + 8 * ti;
        if (T < 20) { const int rt = T & 3, ct = T >> 2;
#pragma unroll
            for (int i = 0; i < 4; ++i) LOG[(16 * rt + 4 * fq + i) * 81 + 16 * ct + fr] = acc[ti][i]; } }
    __syncthreads();
    if (w == 0) {
        const float rstd = 1.0f / sqrtf(*(const LAS float*)(L + O_SSQ + 4 * lane) * (1.0f / D) + EPS);
        const float* cst = WSP(float, WS_CST) + b * 72;
        float lg[72];
#pragma unroll
        for (int j = 0; j < 72; ++j) lg[j] = rstd * LOG[lane * 81 + j] + cst[j];
        int gsel = 0; float gmax = lg[0];
#pragma unroll
        for (int j = 1; j < 8; ++j) if (lg[j] > gmax) { gmax = lg[j]; gsel = j; }
        float gs = 0.f;
#pragma unroll
        for (int j = 0; j < 8; ++j) gs += __expf(lg[j] - gmax);
        const float gwt = 1.0f / gs;
        float el[8];
#pragma unroll
        for (int j = 0; j < 8; ++j) { float v = lg[8 + j];
#pragma unroll
            for (int gI = 1; gI < 8; ++gI) v = gsel == gI ? lg[8 + 8 * gI + j] : v;
            el[j] = v; }
        int i0 = 0; float v0 = el[0];
#pragma unroll
        for (int j = 1; j < 8; ++j) if (el[j] > v0) { v0 = el[j]; i0 = j; }
        int i1 = -1; float v1 = -3.0e38f;
#pragma unroll
        for (int j = 0; j < 8; ++j) if (j != i0 && el[j] > v1) { v1 = el[j]; i1 = j; }
        const float p1 = __expf(v1 - v0), inv = 1.0f / (1.0f + p1);
        const int e0 = gsel * 8 + i0, e1 = gsel * 8 + i1;
        const int r0 = __hip_atomic_fetch_add((LAS int*)(L + O_LC) + e0, 1, __ATOMIC_RELAXED, __HIP_MEMORY_SCOPE_WORKGROUP);
        const int r1 = __hip_atomic_fetch_add((LAS int*)(L + O_LC) + e1, 1, __ATOMIC_RELAXED, __HIP_MEMORY_SCOPE_WORKGROUP);
        Route r; r.e0 = e0 | (r0 << 8); r.e1 = e1 | (r1 << 8); r.w0 = gwt * inv; r.w1 = gwt * p1 * inv;
        WSP(Route, WS_ROUTE)[row0 + lane] = r;
        WSP(float, WS_RSTD2)[row0 + lane] = rstd;
    }
    __syncthreads();
    if (tid < 64) WSP(int, WS_BLKCNT)[blk * 64 + tid] = *(const LAS int*)(L + O_LC + 4 * tid);
    __syncthreads();
}
__device__ __forceinline__ int moe_tables(Frame& F, LAS int* seg_start, LAS int* tile_e) {
    const unsigned* cnt = WSP(unsigned, WS_CTL) + CW_CNT;
    if (F.tid < 64) seg_start[96 + F.tid] = (int)__hip_atomic_load(cnt + F.tid, RLX_AGENT);
    __syncthreads();
    if (F.tid < 64) { int s = 0; for (int e = 0; e < F.tid; ++e) s += (seg_start[96 + e] + 255) >> 8; seg_start[F.tid] = s * 256; }
    __syncthreads();
    if (F.tid < 64) { const int t0 = seg_start[F.tid] >> 8, nt = (seg_start[96 + F.tid] + 255) >> 8; for (int t = 0; t < nt; ++t) tile_e[t0 + t] = F.tid; if (F.tid == 63) seg_start[64] = (t0 + nt) * 256; }
    __syncthreads();
    return seg_start[64] >> 8;
}
__device__ __forceinline__ void phase4b(Frame& F, const Inputs& I, const float* x1) {
    LAS int* PART = (LAS int*)F.lds;
    LAS int* TOT = PART + 1024;
    LAS int* BEF = TOT + 64;
    LAS int* SEG = BEF + 64;
    const int* blkcnt = WSP(int, WS_BLKCNT);
    bf16_t* XS = WSP(bf16_t, WS_XS);
    for (int blk = F.vcu; blk < M_LAT / 64; blk += F.G) {
        {   const int e = F.tid & 63, part = F.tid >> 6; int sa = 0, sb = 0;
#pragma unroll 8
            for (int i = 0; i < 32; ++i) { const int bb = 32 * part + i; const int c = blkcnt[bb * 64 + e]; sa += c; sb += bb < blk ? c : 0; }
            PART[(part * 64 + e) * 2] = sa; PART[(part * 64 + e) * 2 + 1] = sb; }
        __syncthreads();
        if (F.tid < 64) { int ta = 0, tb = 0;
#pragma unroll
            for (int p = 0; p < 8; ++p) { ta += PART[(p * 64 + F.tid) * 2]; tb += PART[(p * 64 + F.tid) * 2 + 1]; }
            TOT[F.tid] = ta; BEF[F.tid] = tb;
            if (blk == 0) WSP(unsigned, WS_CTL)[CW_CNT + F.tid] = (unsigned)ta; }
        __syncthreads();
        if (F.tid == 0) { int run = 0; for (int e = 0; e < 64; ++e) { SEG[e] = run * 256; run += (TOT[e] + 255) >> 8; } SEG[64] = run * 256; }
        __syncthreads();
#pragma unroll 1
        for (int i = 0; i < 8; ++i) {
            const int row = blk * 64 + F.wave * 8 + i;
            const Route r = WSP(Route, WS_ROUTE)[row];
            const int e0 = r.e0 & 255, e1 = r.e1 & 255;
            const int sl0 = SEG[e0] + BEF[e0] + (r.e0 >> 8), sl1 = SEG[e1] + BEF[e1] + (r.e1 >> 8);
            if (F.lane == 0) { WSP(int, WS_TOKSLOT)[2 * row] = sl0; WSP(int, WS_TOKSLOT)[2 * row + 1] = sl1; }
            const float rstd = WSP(float, WS_RSTD2)[row];
            const float* md = WSP(float, WS_MODS) + (row / SEQ) * 6144;
            const f32x4* xr = (const f32x4*)(x1 + (size_t)row * D) + F.lane;
            u32x2* o0 = (u32x2*)(XS + (size_t)sl0 * D) + F.lane; u32x2* o1 = (u32x2*)(XS + (size_t)sl1 * D) + F.lane;
#pragma unroll
            for (int j = 0; j < 4; ++j) { const int k = 4 * F.lane + 256 * j; const f32x4 xv = xr[64 * j];
                const f32x4 g = *(const f32x4*)(I.g_norm2 + k), sh = *(const f32x4*)(md + 3 * 1024 + k), sc = *(const f32x4*)(md + 4 * 1024 + k);
                const f32x4 h = xv * rstd * g * (sc + 1.0f) + sh;
                const u32x2 o = {pk2(h.x, h.y), pk2(h.z, h.w)}; o0[64 * j] = o; o1[64 * j] = o; }
        }
        __syncthreads();
    }
}
__device__ __forceinline__ void phase6(Frame& F, const Inputs& I, float* out) {
    const int gw = F.vcu * 8 + F.wave, NGW = F.G * 8;
    const bf16_t* Y = WSP(bf16_t, WS_XS);
    for (int row = gw; row < M_LAT; row += NGW) {
        const Route r = WSP(Route, WS_ROUTE)[row];
        const int sl0 = WSP(int, WS_TOKSLOT)[2 * row], sl1 = WSP(int, WS_TOKSLOT)[2 * row + 1];
        const float* md = WSP(float, WS_MODS) + (row / SEQ) * 6144 + 5 * 1024;
        f32x4* xr = (f32x4*)(out + (size_t)row * D) + F.lane;
        const u32x2* y0 = (const u32x2*)(Y + (size_t)sl0 * D) + F.lane; const u32x2* y1 = (const u32x2*)(Y + (size_t)sl1 * D) + F.lane;
        f32x4 v[4]; float s = 0.f;
#pragma unroll
        for (int j = 0; j < 4; ++j) { const int k = 4 * F.lane + 256 * j; const u32x2 a = y0[64 * j], bq = y1[64 * j];
            const f32x4 ya = {bflo(a.x), bfhi(a.x), bflo(a.y), bfhi(a.y)}, yb = {bflo(bq.x), bfhi(bq.x), bflo(bq.y), bfhi(bq.y)};
            const f32x4 moe = ya * r.w0 + yb * r.w1;
            v[j] = xr[64 * j] + *(const f32x4*)(md + k) * moe;
            s += (v[j].x * v[j].x + v[j].y * v[j].y) + (v[j].z * v[j].z + v[j].w * v[j].w); }
        const float rstd = 1.0f / sqrtf(wave_sum(s) * (1.0f / D) + EPS);
#pragma unroll
        for (int j = 0; j < 4; ++j) { const int k = 4 * F.lane + 256 * j; xr[64 * j] = v[j] * rstd * *(const f32x4*)(I.g_final + k); }
    }
}

#ifndef MK_PER_PHASE
#define MK_PER_PHASE 0
#endif
constexpr int N_PHASES = 12;
constexpr int TAB_OFF = 150 * 1024;

__global__ void __launch_bounds__(512, 2) fwd_kernel(Args args) {
    extern __shared__ __attribute__((aligned(16))) unsigned char lds_raw[];
    Frame F;
    F.lds = (LAS unsigned char*)lds_raw;
    F.tid = threadIdx.x; F.lane = F.tid & 63; F.wave = __builtin_amdgcn_readfirstlane(F.tid >> 6);
    F.G = gridDim.x; { const int bx = blockIdx.x; F.vcu = (F.G % 8 == 0) ? (bx % 8) * (F.G / 8) + bx / 8 : bx; }
    F.ws = args.ws;
    const Inputs& I = args.in;
    volatile LAS unsigned* MISC = (volatile LAS unsigned*)(F.lds + MISC_OFF);
    if (F.tid < 32) MISC[F.tid] = 0u;
    __syncthreads();
    XcdBarrier bar; bar.bar = WSP(unsigned, WS_CTL) + CW_BAR; bar.x = 0; bar.st = nullptr;
#if !MK_PER_PHASE
    bar = xcd_barrier_post(WSP(unsigned, WS_CTL) + CW_BAR, MISC + 8);
#define GRID_BAR() xcd_barrier(bar)
#else
#define GRID_BAR() do {} while (0)
#endif
    const int lo = args.ph_lo, hi = args.ph_hi;
#ifndef PH_MASK
#define PH_MASK 0xffff
#endif
#define IN(k) (((PH_MASK >> (k)) & 1) && lo <= (k) && (k) < hi)
#define SEAM(k) do { if (IN(k) && IN((k) + 1)) GRID_BAR(); } while (0)
    bf16_t* Z = WSP(bf16_t, WS_Z);
    float* x1 = args.out;

    if (IN(0)) { phase0(F, I); } SEAM(0);
    if (IN(1)) {
        phase0b(F, I);
        __syncthreads();
        pg8::Gemm g{WSP(bf16_t, WS_W3S), WSP(bf16_t, WS_HID2), 256, 256, 256};
        pg8::StaticOrder S; S.init(8, 32, F.G, (int)blockIdx.x, 256L * 256 * 2, 256L * 256 * 2);
        EpiFilt E{WSP(_Float16, WS_FILT)};
        pg8::gemm_phase<EpiFilt, pg8::StaticOrder, false>(F.lds, g, S, E);
        __syncthreads();
        weight_transposes(F, I, 0, F.vcu, F.G);
    } SEAM(1);
    if (IN(2)) {
        pg8::Gemm g{WSP(bf16_t, WS_H), WSP(bf16_t, WS_WIN_T), D, D, D};
        InOrder S; S.so.init(64, 37, F.G, (int)blockIdx.x, 256L * D * 2, 256L * D * 2); S.G = F.G; S.c = (int)blockIdx.x;
        EpiIn E{Z, WSP(float, WS_BIASP), WSP(float, WS_GATES)};
        pg8::gemm_phase<EpiIn, InOrder, true>(F.lds, g, S, E);
        const int nfull = (64 * 37 + 26) % F.G, nlight = F.G - nfull;
        __syncthreads();
        if (nfull == 0) weight_transposes(F, I, 1, (int)blockIdx.x, F.G);
        else if ((int)blockIdx.x >= nfull) weight_transposes(F, I, 1, (int)blockIdx.x - nfull, nlight);
    } SEAM(2);
    if (IN(3)) { phase2a(F, I); } SEAM(3);
    if (IN(4)) { phase2b(F, I); } SEAM(4);
    if (IN(5)) {
        pg8::Gemm g{Z + ZC_PAIR, WSP(bf16_t, WS_WA2_T), ZC, 2 * D, 2 * D};
        pg8::StaticOrder S; S.init(64, 4, F.G, (int)blockIdx.x, 256L * ZC * 2, 256L * 2 * D * 2);
        EpiMerge<true> E{Z + ZC_GA, WSP(bf16_t, WS_FSPEC), WSP(bf16_t, WS_H)};
        pg8::gemm_phase<EpiMerge<true>, pg8::StaticOrder, false>(F.lds, g, S, E);
    } SEAM(5);
    if (IN(6)) {
        pg8::Gemm g{WSP(bf16_t, WS_H), WSP(bf16_t, WS_WOUT_T), D, D, D};
        pg8::StaticOrder S; S.init(64, 4, F.G, (int)blockIdx.x, 256L * D * 2, 256L * D * 2);
        EpiRes E{I.x, WSP(float, WS_MODS), x1};
        pg8::gemm_phase<EpiRes, pg8::StaticOrder, false>(F.lds, g, S, E);
        __syncthreads();
        expert_transposes(F, I, 0, 2, F.vcu, F.G);
    } SEAM(6);
    if (IN(7)) {
        for (int blk = F.vcu; blk < M_LAT / 64; blk += F.G) route_item(F, I, x1, blk);
        __syncthreads();
        expert_transposes(F, I, 1, 2, F.vcu, F.G);
    } SEAM(7);
    if (IN(8)) { phase4b(F, I, x1); } SEAM(8);
    if (IN(9)) {
        LAS int* seg_start = (LAS int*)(F.lds + TAB_OFF); LAS int* tile_e = seg_start + 192;
        const int ntiles = moe_tables(F, seg_start, tile_e);
        pg8::Gemm g{WSP(bf16_t, WS_XS), WSP(bf16_t, WS_W13T), D, D, D};
        MoeOrder S{tile_e, ntiles, F.G, F.vcu, 256L * D * 2, 256L * D * 2, 1024L * D * 2};
        EpiMoe1 E{WSP(bf16_t, WS_FSPEC)};
        pg8::gemm_phase<EpiMoe1, MoeOrder, true>(F.lds, g, S, E);
    } SEAM(9);
    if (IN(10)) {
        LAS int* seg_start = (LAS int*)(F.lds + TAB_OFF); LAS int* tile_e = seg_start + 192;
        const int ntiles = moe_tables(F, seg_start, tile_e);
        pg8::Gemm g{WSP(bf16_t, WS_FSPEC), WSP(bf16_t, WS_W2T), DEXP, DEXP, DEXP};
        MoeOrder S{tile_e, ntiles, F.G, F.vcu, 256L * DEXP * 2, 256L * DEXP * 2, 1024L * DEXP * 2};
        EpiBf E{WSP(bf16_t, WS_XS), D};
        pg8::gemm_phase<EpiBf, MoeOrder, true>(F.lds, g, S, E);
    } SEAM(10);
    if (IN(11)) { phase6(F, I, x1); }
#undef IN
#undef SEAM
}

extern "C" void kernel_launch(void* const* d_in, const int* in_sizes, int n_in, void* d_out, int out_size, void* d_ws, size_t ws_size, hipStream_t stream) {
    static int grid = 0;
    if (grid == 0) {
        if (n_in != 32 || in_sizes[0] != M_LAT * D || out_size != M_LAT * D || ws_size < WS_END) {
            fprintf(stderr, "kernel_launch: unexpected problem (n_in %d, in0 %d, out %d, ws %zu < %zu?)\n", n_in, n_in > 0 ? in_sizes[0] : -1, out_size, ws_size, (size_t)WS_END); grid = -1; return; }
        int dev = 0, cus = 0, per_cu = 0;
        if (hipGetDevice(&dev) != hipSuccess || hipDeviceGetAttribute(&cus, hipDeviceAttributeMultiprocessorCount, dev) != hipSuccess) { grid = -1; return; }
        if (hipFuncSetAttribute((const void*)fwd_kernel, hipFuncAttributeMaxDynamicSharedMemorySize, LDS_BYTES) != hipSuccess) { fprintf(stderr, "kernel_launch: hipFuncSetAttribute failed\n"); grid = -1; return; }
        if (hipOccupancyMaxActiveBlocksPerMultiprocessor(&per_cu, (const void*)fwd_kernel, 512, LDS_BYTES) != hipSuccess || per_cu < 1) { fprintf(stderr, "kernel_launch: occupancy query says %d\n", per_cu); per_cu = 1; }
        (void)hipGetLastError();
        grid = cus;
    }
    if (grid < 0) return;
    (void)hipMemsetAsync((char*)d_ws + WS_CTL, 0, CTL_ZERO_BYTES, stream);
    Args a{};
    const float** ip = (const float**)&a.in;
    for (int i = 0; i < 32; ++i) ip[i] = (const float*)d_in[i];
    a.out = (float*)d_out; a.ws = (unsigned char*)d_ws;
#if MK_PER_PHASE
    for (int p = 0; p < N_PHASES; ++p) { a.ph_lo = p; a.ph_hi = p + 1; hipLaunchKernelGGL(fwd_kernel, dim3(grid), dim3(512), LDS_BYTES, stream, a); }
#else
    a.ph_lo = 0; a.ph_hi = N_PHASES;
    hipLaunchKernelGGL(fwd_kernel, dim3(grid), dim3(512), LDS_BYTES, stream, a);
#endif
}
```

```cpp
#include <hip/hip_runtime.h>
#include <cstdio>
#include <cstdint>

#define LAS __attribute__((address_space(3)))
#define GAS __attribute__((address_space(1)))
typedef unsigned short bf16_t;
typedef short bf16x8 __attribute__((ext_vector_type(8)));
typedef short s16x4 __attribute__((ext_vector_type(4)));
typedef float f32x4 __attribute__((ext_vector_type(4)));
typedef float f32x2 __attribute__((ext_vector_type(2)));
typedef unsigned u32x4 __attribute__((ext_vector_type(4)));
typedef unsigned u32x2 __attribute__((ext_vector_type(2)));
typedef GAS unsigned gu32;

constexpr int D = 1024, BATCH = 2, SEQ = 8192, CTXL = 256;
constexpr int M_LAT = BATCH * SEQ, M_CTX = BATCH * CTXL, M_ALL = M_LAT + M_CTX;
constexpr int IN_COLS = 9232, IG0 = 4096, HY0 = 4112, GA0 = 7184, GB0 = 8208;
constexpr int ZC = 9216;
constexpr int ZC_X0 = 4096, ZC_PAIR = 5120, ZC_GA = 7168, ZC_GB = 8192;
constexpr int N_IN = 9472;
constexpr int NEXP = 64, DEXP = 512;
constexpr float EPS = 1e-6f;
constexpr int MAX_TILES = 192, MAX_SLOTS = MAX_TILES * 256;

constexpr size_t MiB = 1u << 20;
constexpr size_t WS_CTL = 0, CTL_ZERO_BYTES = 1 * MiB;
constexpr size_t WS_MODS = 1 * MiB;
constexpr size_t WS_BIASP = WS_MODS + 81920;
constexpr size_t WS_CST = WS_MODS + 122880;
constexpr size_t WS_RSTD2 = WS_MODS + 131072;
constexpr size_t WS_ROUTE = WS_MODS + 262144;
constexpr size_t WS_TOKSLOT = WS_MODS + 524288;
constexpr size_t WS_BLKCNT = WS_MODS + 196608;
constexpr size_t WS_W72S = WS_MODS + 720896;
constexpr size_t WS_GATES = 2 * MiB;
constexpr size_t WS_HID2 = 4 * MiB;
constexpr size_t WS_WIN_T = 8 * MiB;
constexpr size_t WS_WA2_T = 27 * MiB;
constexpr size_t WS_WB_T = 31 * MiB;
constexpr size_t WS_WOUT_T = 33 * MiB;
constexpr size_t WS_W3S = 35 * MiB;
constexpr size_t WS_H = 36 * MiB;
constexpr size_t WS_FSPEC = 70 * MiB;
constexpr int FS_PITCH = 8200;
constexpr size_t WS_SCM = 136 * MiB;
constexpr size_t WS_Z = 168 * MiB;
constexpr size_t WS_W13T = 168 * MiB;
constexpr size_t WS_W2T = 296 * MiB;
constexpr size_t WS_XS = 360 * MiB;
constexpr size_t WS_S0T = 466 * MiB;
constexpr size_t WS_QKC = WS_WIN_T;
constexpr size_t WS_FILT = 486 * MiB;
constexpr size_t WS_END = 518 * MiB;
static_assert(WS_Z + (size_t)M_ALL * ZC * 2 <= WS_END && WS_XS + (size_t)MAX_SLOTS * 1024 * 2 <= WS_END, "ws map");
static_assert(WS_FSPEC + (size_t)1024 * FS_PITCH * 8 <= WS_SCM && WS_H + (size_t)M_ALL * D * 2 <= WS_FSPEC, "ws map");
constexpr int CW_BAR = 4096;
constexpr int CW_CNT = 16384, CW_CUR = 16384 + 64;
constexpr int CW_Q0 = 16384 + 256, CW_Q1 = 16384 + 320;
constexpr int CW_SUB = 20480;

constexpr int LDS_BYTES = 160 * 1024;
constexpr int MISC_OFF = 159 * 1024;

#define RLX_AGENT __ATOMIC_RELAXED, __HIP_MEMORY_SCOPE_AGENT
__device__ __forceinline__ unsigned f2bf(float f) { unsigned u = __builtin_bit_cast(unsigned, f); return (u + 0x7fffu + ((u >> 16) & 1u)) >> 16; }
__device__ __forceinline__ unsigned pk2(float lo, float hi) { return f2bf(lo) | (f2bf(hi) << 16); }
__device__ __forceinline__ float bf2f(unsigned short u) { return __builtin_bit_cast(float, (unsigned)u << 16); }
__device__ __forceinline__ float bflo(unsigned w) { return __builtin_bit_cast(float, w << 16); }
__device__ __forceinline__ float bfhi(unsigned w) { return __builtin_bit_cast(float, w & 0xffff0000u); }
__device__ __forceinline__ float sigmoidf_(float x) { return __builtin_amdgcn_rcpf(1.0f + __expf(-x)); }
__device__ __forceinline__ float siluf_(float x) { return x * __builtin_amdgcn_rcpf(1.0f + __expf(-x)); }
__device__ __forceinline__ float wave_sum(float v) {
#pragma unroll
    for (int o = 1; o < 64; o <<= 1) v += __shfl_xor(v, o);
    return v;
}

namespace pg8 {
#define PG8_LAS __attribute__((address_space(3)))
constexpr int BM = 256, BK = 64, HALF = 128, HTB = HALF * BK * 2, STAGE_BYTES = 8 * HTB, NXCD = 8, WGM = 8;
__host__ __device__ __forceinline__ int lds_byte(int r, int c) { const int st = (r >> 4) * 2 + (c >> 5), rr = r & 15, cc = c & 31, ob = rr * 64 + cc * 2; return st * 1024 + (ob ^ (((ob >> 9) & 1) << 5)); }
__host__ __device__ __forceinline__ void stage_rc(int b, int& R, int& C) { const int st = b / 1024, sb = b % 1024, swz = sb ^ (((sb >> 9) & 1) << 5); R = (st >> 1) * 16 + swz / 64; C = (st & 1) * 32 + (swz % 64) / 2; }
__host__ __device__ __forceinline__ int perm32(int rho) { const int n = rho >> 4, i = rho & 15; return 8 * (i >> 2) + 4 * n + (i & 3); }

struct Unit { long aoff, boff; int pm, pn, e, pad; };
struct Gemm { const bf16_t* A; const bf16_t* Bt; int lda, ldb, K; };

struct StaticOrder {
    int nM, nN, nwg, G, c; long astep, bstep;
    __device__ void init(int nM_, int nN_, int G_, int c_, long astep_, long bstep_) { nM = nM_; nN = nN_; nwg = nM * nN; G = G_; c = c_; astep = astep_; bstep = bstep_; }
    __device__ bool map(long L, Unit& u) const {
        if (L >= nwg) return false;
        int wgid = (int)L; { const int q = nwg / NXCD, r = nwg % NXCD, xcd = wgid % NXCD, off = wgid / NXCD; wgid = (xcd < r ? xcd * (q + 1) : r * (q + 1) + (xcd - r) * q) + off; }
        const int nig = WGM * nN, gid = wgid / nig, fm = gid * WGM, gsz = (nM - fm) < WGM ? (nM - fm) : WGM;
        u.pm = fm + ((wgid % nig) % gsz); u.pn = (wgid % nig) / gsz; u.e = 0; u.pad = 0; u.aoff = u.pm * astep; u.boff = u.pn * bstep; return true;
    }
    __device__ bool next(int i, Unit& u) const { return map((long)i * G + c, u); }
};

typedef __bf16 bf16v2_t __attribute__((ext_vector_type(2)));
__device__ __forceinline__ unsigned cvt_pk_bf16(float lo, float hi) { const bf16v2_t v = __builtin_convertvector((f32x2){lo, hi}, bf16v2_t); return __builtin_bit_cast(unsigned, v); }

template <class Epi, class Sched, bool ALIGN_EPI>
__device__ __forceinline__ void gemm_phase(PG8_LAS unsigned char* lds, const Gemm g, const Sched& S, const Epi& E) {
    const int tid = threadIdx.x, wid = __builtin_amdgcn_readfirstlane(tid >> 6), lane = tid & 63, wr = wid >> 2, wc = wid & 3, fr = lane & 15, fq = lane >> 4;
    const int K = g.K, nt = K / BK;
    unsigned voffA[2], voffB[2];
#pragma unroll
    for (int i = 0; i < 2; ++i) { int R, C; stage_rc(tid * 16 + i * 8192, R, C); const int Rb = Epi::PERM ? ((R & ~31) + perm32(R & 31)) : R;
        voffA[i] = (unsigned)(R * g.lda + C) * 2u; voffB[i] = (unsigned)(Rb * g.ldb + C) * 2u; }
    const size_t kstep = (size_t)(BK * 2);
    const size_t hstepA = (size_t)HALF * g.lda * 2, hstepB = (size_t)HALF * g.ldb * 2;
    const unsigned ldsw = (unsigned)wid * 1024u;
    const int aoff = lds_byte(wr * 64 + fr, fq * 8), boff = lds_byte(wc * 32 + fr, fq * 8);
#define PG8_SA(b, h) (((b) * 2 + (h)) * HTB)
#define PG8_SB(b, h) ((4 + (b) * 2 + (h)) * HTB)
#define PG8_STAGE(bufoff, gbase, voff) do { _Pragma("unroll") for (int _i = 0; _i < 2; ++_i) \
        __builtin_amdgcn_global_load_lds((const unsigned*)((const char*)(gbase) + (voff)[_i]), (PG8_LAS unsigned*)(lds + (bufoff) + ldsw + _i * 8192), 16, 0, 0); } while (0)
#define PG8_LDA(dst, b, h) do { _Pragma("unroll") for (int m = 0; m < 4; ++m) _Pragma("unroll") for (int k = 0; k < 2; ++k) dst[m][k] = *(const PG8_LAS bf16x8*)(lds + PG8_SA(b, h) + aoff + m * 2048 + k * 1024); } while (0)
#define PG8_LDB(dst, b, h) do { _Pragma("unroll") for (int n = 0; n < 2; ++n) _Pragma("unroll") for (int k = 0; k < 2; ++k) dst[n][k] = *(const PG8_LAS bf16x8*)(lds + PG8_SB(b, h) + boff + n * 2048 + k * 1024); } while (0)
#define PG8_MMA(ai, bj, At, Bt) do { __builtin_amdgcn_s_setprio(1); _Pragma("unroll") for (int m = 0; m < 4; ++m) _Pragma("unroll") for (int n = 0; n < 2; ++n) _Pragma("unroll") for (int k = 0; k < 2; ++k) \
        acc[ai][bj][m][n] = __builtin_amdgcn_mfma_f32_16x16x32_bf16(Bt[n][k], At[m][k], acc[ai][bj][m][n], 0, 0, 0); __builtin_amdgcn_s_setprio(0); } while (0)
#define PG8_WAIT_V(n) asm volatile("s_waitcnt vmcnt(" #n ")" ::: "memory")
#define PG8_WAIT_L(n) asm volatile("s_waitcnt lgkmcnt(" #n ")" ::: "memory")
#define PG8_BAR __builtin_amdgcn_s_barrier()
#define PG8_SCHED __builtin_amdgcn_sched_barrier(0)
    Unit cur, nxt; int ui = 0;
    if (!S.next(0, cur)) return;
    f32x4 acc[2][2][4][2];
#pragma unroll
    for (int a = 0; a < 2; ++a)
#pragma unroll
        for (int b = 0; b < 2; ++b)
#pragma unroll
            for (int m = 0; m < 4; ++m)
#pragma unroll
                for (int n = 0; n < 2; ++n) acc[a][b][m][n] = (f32x4){0.f, 0.f, 0.f, 0.f};
    bf16x8 At[4][2], B0[2][2], B1[2][2];
    const char* cA = (const char*)g.A + cur.aoff; const char* cB = (const char*)g.Bt + cur.boff;
    PG8_STAGE(PG8_SB(0, 0), cB, voffB); PG8_STAGE(PG8_SB(0, 1), cB + hstepB, voffB); PG8_STAGE(PG8_SA(0, 0), cA, voffA); PG8_STAGE(PG8_SA(0, 1), cA + hstepA, voffA);
    if (wr == 1) PG8_BAR;
    PG8_WAIT_V(2); PG8_BAR;
    PG8_STAGE(PG8_SB(1, 0), cB + kstep, voffB); PG8_STAGE(PG8_SA(1, 0), cA + kstep, voffA); PG8_STAGE(PG8_SB(1, 1), cB + hstepB + kstep, voffB);
    PG8_WAIT_V(6); PG8_BAR;
    for (;;) {
        const bool has_next = S.next(ui + 1, nxt);
        const char* nA = has_next ? (const char*)g.A + nxt.aoff : cA; const char* nB = has_next ? (const char*)g.Bt + nxt.boff : cB;
        for (int t = 0; t < nt; t += 2) {
            const bool last = (t == nt - 2);
            const char* a1 = cA + (size_t)(t + 1) * kstep;
            const char* a2 = last ? nA : cA + (size_t)(t + 2) * kstep; const char* b2 = last ? nB : cB + (size_t)(t + 2) * kstep;
            const char* a3 = a2 + kstep; const char* b3 = b2 + kstep;
            PG8_LDB(B0, 0, 0); PG8_LDB(B1, 0, 1); PG8_SCHED; PG8_LDA(At, 0, 0); PG8_STAGE(PG8_SA(1, 1), a1 + hstepA, voffA);
            PG8_WAIT_V(8); PG8_WAIT_L(0); PG8_BAR; PG8_MMA(0, 0, At, B0); PG8_MMA(0, 1, At, B1); PG8_BAR; PG8_SCHED;
            PG8_LDA(At, 0, 1); PG8_STAGE(PG8_SB(0, 0), b2, voffB); PG8_STAGE(PG8_SB(0, 1), b2 + hstepB, voffB); PG8_STAGE(PG8_SA(0, 0), a2, voffA);
            PG8_WAIT_V(8); PG8_WAIT_L(0); PG8_BAR; PG8_MMA(1, 0, At, B0); PG8_MMA(1, 1, At, B1); PG8_BAR; PG8_SCHED;
            PG8_LDB(B0, 1, 0); PG8_LDB(B1, 1, 1); PG8_SCHED; PG8_LDA(At, 1, 0); PG8_STAGE(PG8_SA(0, 1), a2 + hstepA, voffA);
            PG8_WAIT_V(8); PG8_WAIT_L(0); PG8_BAR; PG8_MMA(0, 0, At, B0); PG8_MMA(0, 1, At, B1); PG8_BAR; PG8_SCHED;
            PG8_LDA(At, 1, 1); PG8_STAGE(PG8_SB(1, 0), b3, voffB); PG8_STAGE(PG8_SB(1, 1), b3 + hstepB, voffB); PG8_STAGE(PG8_SA(1, 0), a3, voffA);
            PG8_WAIT_V(8); PG8_WAIT_L(0); PG8_BAR; PG8_MMA(1, 0, At, B0); PG8_MMA(1, 1, At, B1); PG8_BAR; PG8_SCHED;
        }
        if constexpr (ALIGN_EPI) { if (wr == 0) PG8_BAR; }
        E(acc, cur, wr, wc, fr, fq);
        if (!has_next) break;
#pragma unroll
        for (int a = 0; a < 2; ++a)
#pragma unroll
            for (int b = 0; b < 2; ++b)
#pragma unroll
                for (int m = 0; m < 4; ++m)
#pragma unroll
                    for (int n = 0; n < 2; ++n) acc[a][b][m][n] = (f32x4){0.f, 0.f, 0.f, 0.f};
        cur = nxt; cA = nA; cB = nB; ++ui;
        if constexpr (ALIGN_EPI) { if (wr == 1) PG8_BAR; }
    }
    PG8_WAIT_V(0);
    if constexpr (!ALIGN_EPI) { if (wr == 0) PG8_BAR; }
    PG8_BAR;
#undef PG8_SA
#undef PG8_SB
#undef PG8_STAGE
#undef PG8_LDA
#undef PG8_LDB
#undef PG8_MMA
#undef PG8_WAIT_V
#undef PG8_WAIT_L
#undef PG8_BAR
#undef PG8_SCHED
}
}

#define XB_TMO      128
#define XB_XCNT(j)  (256  + 64 * (j))
#define XB_XSUB(j)  (1280 + 64 * (j))
#define XB_XGEN(j)  (2304 + 64 * (j))
#define XB_TOP      3328
#define XB_TOPGEN   3392
#define XCD_BAR_WORDS 3456
#define XB_SPIN_CAP (1u << 18)
__device__ __forceinline__ unsigned xb_ld(unsigned* p)              { return __hip_atomic_load(p, __ATOMIC_RELAXED, __HIP_MEMORY_SCOPE_AGENT); }
__device__ __forceinline__ unsigned xb_add(unsigned* p, unsigned v) { return __hip_atomic_fetch_add(p, v, __ATOMIC_RELAXED, __HIP_MEMORY_SCOPE_AGENT); }
__device__ __forceinline__ unsigned xb_xcc_id() { return (unsigned)__builtin_amdgcn_s_getreg((3 << 11) | 20) & 0xFu; }
#define XB_SPIN(cond, bar) do { unsigned _sp = 0; while (cond) { __builtin_amdgcn_s_sleep(1); \
    if ((++_sp & 255u) == 0u) { if (xb_ld(&(bar)[XB_TMO])) break; if (_sp > XB_SPIN_CAP) { atomicAdd(&(bar)[XB_TMO], 1u); break; } } } } while (0)
struct XcdBarrier { unsigned* bar; unsigned x; volatile LAS unsigned* st; };
__device__ __forceinline__ XcdBarrier xcd_barrier_post(unsigned* bar, volatile LAS unsigned* st) {
    XcdBarrier b; b.bar = bar; b.x = xb_xcc_id(); b.st = st;
    if (threadIdx.x == 0) (void)xb_add(&bar[XB_XCNT(b.x)], 1u);
    return b;
}
__device__ __forceinline__ void xcd_barrier_complete(unsigned* bar, unsigned x, unsigned& nloc, unsigned& nx) {
    const unsigned G = gridDim.x * gridDim.y * gridDim.z;
    unsigned sum, cnt, mine, sp = 0u;
    for (;;) {
        sum = 0u; cnt = 0u; mine = 0u;
#pragma unroll
        for (unsigned j = 0; j < 16; ++j) { const unsigned c = xb_ld(&bar[XB_XCNT(j)]); sum += c; cnt += (c > 0u) ? 1u : 0u; mine = (j == x) ? c : mine; }
        if (sum == G) break;
        __builtin_amdgcn_s_sleep(1);
        if ((++sp & 255u) == 0u) { if (xb_ld(&bar[XB_TMO])) break; if (sp > XB_SPIN_CAP) { atomicAdd(&bar[XB_TMO], 1u); break; } }
    }
    nloc = mine > 0u ? mine : 1u; nx = cnt > 0u ? cnt : 1u;
}
__device__ __forceinline__ void xcd_barrier(const XcdBarrier& b) {
    asm volatile("s_waitcnt vmcnt(0)" ::: "memory");
    __syncthreads();
    if (threadIdx.x == 0) {
        unsigned* bar = b.bar;
        __builtin_amdgcn_s_waitcnt(0);
        unsigned nloc = b.st[0], nx = b.st[1];
        if (nloc == 0u) { xcd_barrier_complete(bar, b.x, nloc, nx); b.st[0] = nloc; b.st[1] = nx; }
        const unsigned old = xb_add(&bar[XB_XSUB(b.x)], 1u);
        const unsigned gen = old / nloc;
        if (old + 1u == (gen + 1u) * nloc) {
            __builtin_amdgcn_fence(__ATOMIC_RELEASE, "agent");
            asm volatile("s_waitcnt vmcnt(0)" ::: "memory");
            const unsigned og = xb_add(&bar[XB_TOP], 1u);
            const unsigned tg = og / nx;
            if (og + 1u == (tg + 1u) * nx) xb_add(&bar[XB_TOPGEN], 1u);
            else XB_SPIN(xb_ld(&bar[XB_TOPGEN]) == tg, bar);
            __builtin_amdgcn_fence(__ATOMIC_ACQUIRE, "agent");
            xb_add(&bar[XB_XGEN(b.x)], 1u);
            asm volatile("s_waitcnt vmcnt(0)" ::: "memory");
        } else {
            XB_SPIN(xb_ld(&bar[XB_XGEN(b.x)]) == gen, bar);
            __builtin_amdgcn_fence(__ATOMIC_ACQUIRE, "agent");
            asm volatile("s_waitcnt vmcnt(0)" ::: "memory");
        }
    }
    __syncthreads();
}

__device__ __forceinline__ void subgrid_barrier(unsigned* cnt, unsigned n, unsigned round) {
    asm volatile("s_waitcnt vmcnt(0)" ::: "memory");
    __syncthreads();
    if (threadIdx.x == 0) {
        __builtin_amdgcn_fence(__ATOMIC_RELEASE, "agent");
        asm volatile("s_waitcnt vmcnt(0)" ::: "memory");
        xb_add(cnt, 1u);
        unsigned sp = 0;
        while (xb_ld(cnt) < n * round) { __builtin_amdgcn_s_sleep(2); if (++sp > (1u << 22)) break; }
        __builtin_amdgcn_fence(__ATOMIC_ACQUIRE, "agent");
        asm volatile("s_waitcnt vmcnt(0)" ::: "memory");
    }
    __syncthreads();
}

struct Inputs {
    const float *x, *c, *ctx, *c_ctx, *w_mod, *b_mod, *g_norm1, *g_norm2, *w_in, *b_in, *w_qk_conv, *b_qk_conv, *w_h_conv, *b_h_conv,
        *hf_w1, *hf_b1, *hf_w2, *hf_b2, *hf_w3, *hf_freq, *h_bias, *w_a, *w_b, *w_out, *w_group, *b_group, *w_router, *b_router, *w1_e, *w3_e, *w2_e, *g_final;
};
struct Args { Inputs in; float* out; unsigned char* ws; int ph_lo, ph_hi; };
struct Frame {
    LAS unsigned char* lds;
    int tid, lane, wave, vcu, G;
    unsigned char* ws;
};
#define WSP(T, off) ((T*)(F.ws + (off)))

__device__ __forceinline__ int win_src(int rho) {
    if (rho < 4096) return rho;
    if (rho < ZC_PAIR) return HY0 + (rho - ZC_X0);
    if (rho < ZC_GA) { const int t = rho - ZC_PAIR, p = t >> 8, bj = (t >> 7) & 1, j = t & 127; return HY0 + 1024 + bj * 1024 + 128 * p + j; }
    if (rho < ZC_GB) return GA0 + (rho - ZC_GA);
    if (rho < ZC) return GB0 + (rho - ZC_GB);
    if (rho < ZC + 16) return IG0 + (rho - ZC);
    return -1;
}
template <class SrcCol>
__device__ __forceinline__ void transpose_item(const float* W, int N, int k0, SrcCol scol, bf16_t* WT, int ldt, int drow0, int kdst, LAS float* scr, int lane) {
    const int sc = scol(lane & 31);
#pragma unroll 16
    for (int i = 0; i < 32; ++i) { const int kk = 2 * i + (lane >> 5); scr[kk * 33 + (lane & 31)] = sc >= 0 ? W[(size_t)(k0 + kk) * N + sc] : 0.f; }
    asm volatile("s_waitcnt lgkmcnt(0)" ::: "memory");
    const int c = lane & 7;
#pragma unroll
    for (int j = 0; j < 4; ++j) { const int n = (lane >> 3) + 8 * j; const LAS float* s = scr + (8 * c) * 33 + n;
        u32x4 o; o.x = pk2(s[0 * 33], s[1 * 33]); o.y = pk2(s[2 * 33], s[3 * 33]); o.z = pk2(s[4 * 33], s[5 * 33]); o.w = pk2(s[6 * 33], s[7 * 33]);
        *(u32x4*)(WT + (size_t)(drow0 + n) * ldt + kdst + 8 * c) = o; }
    asm volatile("s_waitcnt lgkmcnt(0)" ::: "memory");
}


__device__ __forceinline__ void weight_transposes(Frame& F, const Inputs& I, int which, int wg, int nwg) {
    LAS float* scr = (LAS float*)(F.lds + F.wave * 16384);
    const int gw = wg * 8 + F.wave, NGW = nwg * 8;
    {
        constexpr int I_IN = (D / 64) * (N_IN / 32), I_SQ = (D / 64) * (D / 32);
        const int lo = which == 0 ? 0 : I_IN, hi = which == 0 ? I_IN : I_IN + 3 * I_SQ;
        for (int it = lo + gw; it < hi; it += NGW) {
            int r = it;
            if (r < I_IN) { const int nblk = N_IN / 32, kb = r / nblk, nb = r % nblk;
                transpose_item(I.w_in, IN_COLS, 64 * kb, [&](int i) { return win_src(32 * nb + i); }, WSP(bf16_t, WS_WIN_T), D, 32 * nb, 64 * kb, scr, F.lane); continue; }
            r -= I_IN;
            const int m = r / I_SQ, rr = r % I_SQ, kb = rr / 32, nb = rr % 32;
            if (m == 0) { transpose_item(I.w_a, D, 64 * kb, [&](int i) { return 32 * nb + i; }, WSP(bf16_t, WS_WA2_T), 2 * D, 32 * nb, 64 * kb, scr, F.lane);
                          transpose_item(I.w_a, D, 64 * kb, [&](int i) { return 32 * nb + i; }, WSP(bf16_t, WS_WA2_T), 2 * D, 32 * nb, D + 64 * kb, scr, F.lane); }
            else if (m == 1) transpose_item(I.w_b, D, 64 * kb, [&](int i) { return 32 * nb + i; }, WSP(bf16_t, WS_WB_T), D, 32 * nb, 64 * kb, scr, F.lane);
            else transpose_item(I.w_out, D, 64 * kb, [&](int i) { return 32 * nb + i; }, WSP(bf16_t, WS_WOUT_T), D, 32 * nb, 64 * kb, scr, F.lane);
        }
    }
    __syncthreads();
}
__device__ __forceinline__ void phase0(Frame& F, const Inputs& I) {
    LAS float* scr = (LAS float*)(F.lds + F.wave * 16384);
    const int gw = F.vcu * 8 + F.wave, NGW = F.G * 8;
    {
        LAS float* red = (LAS float*)F.lds;
        LAS float* sl = red + 8 * 3 * 32;
        float* mods = WSP(float, WS_MODS);
        for (int i = F.tid; i < 3 * 1024; i += 512) { const int v = i >> 10, k = i & 1023; sl[i] = siluf_(v == 0 ? I.c[k] : v == 1 ? I.c[D + k] : I.c_ctx[k]); }
        __syncthreads();
        for (int it = F.vcu; it < 256; it += F.G) {
            const int col = F.lane & 31, kr = F.lane >> 5, n = it * 24 + col; const bool act = col < 24;
            float a0 = 0.f, a1 = 0.f, a2 = 0.f;
#pragma unroll 16
            for (int i = 0; i < 64; ++i) { const int k = F.wave * 128 + 2 * i + kr; const float w = act ? I.w_mod[(size_t)k * 6144 + n] : 0.f;
                a0 += sl[k] * w; a1 += sl[1024 + k] * w; a2 += sl[2048 + k] * w; }
            a0 += __shfl_xor(a0, 32); a1 += __shfl_xor(a1, 32); a2 += __shfl_xor(a2, 32);
            if (F.lane < 32) { red[(F.wave * 3 + 0) * 32 + col] = a0; red[(F.wave * 3 + 1) * 32 + col] = a1; red[(F.wave * 3 + 2) * 32 + col] = a2; }
            __syncthreads();
            if (F.tid < 96) { const int v = F.tid >> 5, l = F.tid & 31; float s = 0.f;
#pragma unroll
                for (int w = 0; w < 8; ++w) s += red[(w * 3 + v) * 32 + l];
                if (l < 24) mods[v * 6144 + it * 24 + l] = s + I.b_mod[it * 24 + l]; }
            __syncthreads();
        }
    }
    __syncthreads();
    for (int i = F.vcu * 512 + F.tid; i < N_IN; i += F.G * 512) { const int s = win_src(i); WSP(float, WS_BIASP)[i] = s >= 0 ? I.b_in[s] : 0.f; }
    for (int i = F.vcu * 512 + F.tid; i < 80 * 2048; i += F.G * 512) { const int col = i >> 11, which = (i >> 10) & 1, k = i & 1023;
        const float v = col < 8 ? I.w_group[k * 8 + col] : col < 72 ? I.w_router[k * 64 + (col - 8)] : 0.f;
        const unsigned hi = f2bf(v); WSP(bf16_t, WS_W72S)[i] = (bf16_t)(which ? f2bf(v - bf2f((unsigned short)hi)) : hi); }
    {
        bf16_t* hids = WSP(bf16_t, WS_HID2);
        const int j = F.lane;
        const float fr = I.hf_freq[j], b1 = I.hf_b1[j], b2 = I.hf_b2[j];
        for (int pos = gw; pos < SEQ; pos += NGW) {
            const float t = (float)pos / (float)(SEQ - 1);
            float a = b1 + t * I.hf_w1[0 * 64 + j];
#pragma unroll 4
            for (int i = 0; i < 16; ++i) { const float band = 1e-4f + (float)i * ((15.0f - 1e-4f) / 15.0f);
                const float rev = ((float)pos * (1.0f / (float)SEQ)) * band;
                const float sn = __builtin_amdgcn_sinf(rev), cs = __builtin_amdgcn_cosf(rev);
                a += cs * I.hf_w1[(1 + i) * 64 + j] - sn * I.hf_w1[(17 + i) * 64 + j]; }
            const float h1 = __builtin_amdgcn_sinf(fr * a * 0.15915494309189535f);
            float a2 = b2;
#pragma unroll 8
            for (int i = 0; i < 64; ++i) a2 += __shfl(h1, i) * I.hf_w2[i * 64 + j];
            const float h2 = __builtin_amdgcn_sinf(fr * a2 * 0.15915494309189535f);
            const unsigned hi = f2bf(h2), lo = f2bf(h2 - bf2f((unsigned short)hi));
            bf16_t* hp = hids + (size_t)pos * 256;
            hp[j] = (bf16_t)hi; hp[64 + j] = (bf16_t)hi; hp[128 + j] = (bf16_t)lo; hp[192 + j] = 0;
        }
        bf16_t* w3s = WSP(bf16_t, WS_W3S);
        for (int i = F.vcu * 512 + F.tid; i < 2048 * 64; i += F.G * 512) { const int h = i >> 11, col = i & 2047;
            const float wv = I.hf_w3[i]; const unsigned hi = f2bf(wv), lo = f2bf(wv - bf2f((unsigned short)hi));
            bf16_t* wp = w3s + (size_t)col * 256;
            wp[h] = (bf16_t)hi; wp[64 + h] = (bf16_t)lo; wp[128 + h] = (bf16_t)hi; wp[192 + h] = 0; }
    }
}

constexpr int FFT_N = 16384;
__device__ __forceinline__ int PADI(int i) { return i + (i >> 5); }
__device__ __forceinline__ constexpr int bitrev(int x, int bits) { int r = 0; for (int i = 0; i < bits; ++i) r = (r << 1) | ((x >> i) & 1); return r; }
template <int R, int LOG2R>
__device__ __forceinline__ void dft_dif(f32x2 (&v)[R]) {
    constexpr float C32[16] = {1.000000000e+00f, 9.807852804e-01f, 9.238795325e-01f, 8.314696123e-01f, 7.071067812e-01f, 5.555702330e-01f, 3.826834324e-01f, 1.950903220e-01f,
                               0.0f, -1.950903220e-01f, -3.826834324e-01f, -5.555702330e-01f, -7.071067812e-01f, -8.314696123e-01f, -9.238795325e-01f, -9.807852804e-01f};
    constexpr float S32[16] = {0.0f, 1.950903220e-01f, 3.826834324e-01f, 5.555702330e-01f, 7.071067812e-01f, 8.314696123e-01f, 9.238795325e-01f, 9.807852804e-01f,
                               1.0f, 9.807852804e-01f, 9.238795325e-01f, 8.314696123e-01f, 7.071067812e-01f, 5.555702330e-01f, 3.826834324e-01f, 1.950903220e-01f};
#pragma unroll
    for (int st = 0; st < LOG2R; ++st) {
        const int half = R >> (st + 1);
#pragma unroll
        for (int blk = 0; blk < R; blk += 2 * half)
#pragma unroll
            for (int i = 0; i < half; ++i) {
                const f32x2 a = v[blk + i], b = v[blk + i + half];
                v[blk + i] = a + b;
                const f32x2 t = a - b;
                const int ti = i * (16 / half);
                if (ti == 0) v[blk + i + half] = t;
                else if (ti == 8) v[blk + i + half] = (f32x2){t.y, -t.x};
                else { const float c = C32[ti], s = S32[ti]; v[blk + i + half] = (f32x2){t.x * c + t.y * s, t.y * c - t.x * s}; }
            }
    }
}
__device__ __forceinline__ f32x2 cmul(f32x2 a, f32x2 b) { return (f32x2){a.x * b.x - a.y * b.y, a.x * b.y + a.y * b.x}; }
__device__ __forceinline__ f32x2 twid(float frac) { return (f32x2){__builtin_amdgcn_cosf(frac), -__builtin_amdgcn_sinf(frac)}; }
__device__ __forceinline__ void fft_pass_a_store(f32x2 (&v)[32], LAS f32x2* X, int j) {
    dft_dif<32, 5>(v);
    int jq = j; asm volatile("" : "+v"(jq));
    LAS f32x2* xb = X + 33 * jq;
#pragma unroll
    for (int p = 0; p < 32; ++p) xb[bitrev(p, 5)] = v[p];
}
__device__ __forceinline__ void fft_load32(f32x2 (&v)[32], const LAS f32x2* X, int j) {
    int jq = j; asm volatile("" : "+v"(jq));
    const LAS f32x2* xb = X + jq + (jq >> 5);
#pragma unroll
    for (int r = 0; r < 32; ++r) v[r] = xb[528 * r];
}
constexpr int TW_OFF = 144 * 1024;
__device__ __forceinline__ void fft_twiddle_init(LAS unsigned char* lds, int tid) {
    LAS f32x2* T = (LAS f32x2*)(lds + TW_OFF);
    for (int m = tid; m < 1024; m += 512) T[m] = twid((float)m * (1.0f / 1024.0f));
}
__device__ __forceinline__ void fft_pass_b(LAS f32x2* X, int j) {
    f32x2 v[32]; fft_load32(v, X, j);
    int jo = j; asm volatile("" : "+v"(jo));
    const int k = jo & 31;
    j = jo;
    const LAS f32x2* T = (const LAS f32x2*)((const LAS unsigned char*)X + TW_OFF) + k;
#pragma unroll
    for (int r = 1; r < 32; ++r) v[r] = cmul(v[r], T[(r - 1) * k]);
    dft_dif<32, 5>(v);
    __syncthreads();
    LAS f32x2* xb = X + (j >> 5) * 1056 + k;
#pragma unroll
    for (int p = 0; p < 32; ++p) xb[33 * bitrev(p, 5)] = v[p];
}
__device__ __forceinline__ void fft_pass_c_compute(f32x2 (&v)[32], const LAS f32x2* X, int tid) {
#pragma unroll
    for (int u = 0; u < 2; ++u) {
        int jj = tid + 512 * u; asm volatile("" : "+v"(jj)); f32x2 w[16];
#pragma unroll
        for (int r = 0; r < 16; ++r) w[r] = X[jj + (jj >> 5) + 1056 * r];
        const float f1 = (float)jj * (1.0f / 16384.0f);
#pragma unroll
        for (int r = 1; r < 16; ++r) w[r] = cmul(w[r], twid((float)r * f1));
        dft_dif<16, 4>(w);
#pragma unroll
        for (int p = 0; p < 16; ++p) v[16 * u + p] = w[p];
    }
}

__device__ __forceinline__ void filter_spec_item(Frame& F, const Inputs& I, int pair) {
    const int c = 2 * pair, tid = F.tid;
    LAS f32x2* X = (LAS f32x2*)F.lds;
    LAS float* red = (LAS float*)(F.lds + 140 * 1024);
    const _Float16* filt = WSP(_Float16, WS_FILT);
    float ss0 = 0.f, ss1 = 0.f;
    for (int i = 0; i < 16; ++i) {
        const int lag = tid + 512 * i;
        const float f0 = (float)filt[(size_t)c * SEQ + lag], f1 = (float)filt[(size_t)(c + 1) * SEQ + lag], g0 = (float)filt[(size_t)(1024 + c) * SEQ + lag], g1 = (float)filt[(size_t)(1025 + c) * SEQ + lag];
        X[PADI(lag)] = (f32x2){f0, f1}; ss0 += f0 * f0; ss1 += f1 * f1;
        if (lag >= 1) { X[PADI(FFT_N - lag)] = (f32x2){g0, g1}; ss0 += g0 * g0; ss1 += g1 * g1; }
    }
    if (tid == 0) X[PADI(8192)] = (f32x2){0.f, 0.f};
    ss0 = wave_sum(ss0); ss1 = wave_sum(ss1);
    if (F.lane == 0) { red[F.wave * 2] = ss0; red[F.wave * 2 + 1] = ss1; }
    __syncthreads();
    float t0 = 0.f, t1 = 0.f;
#pragma unroll
    for (int w = 0; w < 8; ++w) { t0 += red[2 * w]; t1 += red[2 * w + 1]; }
    const float sc0 = (1.0f / sqrtf(t0 + EPS)) * (1.0f / 16384.0f), sc1 = (1.0f / sqrtf(t1 + EPS)) * (1.0f / 16384.0f);
    {   f32x2 v[32]; fft_load32(v, X, tid); __syncthreads(); fft_pass_a_store(v, X, tid); }
    __syncthreads();
    fft_pass_b(X, tid);
    __syncthreads();
    {   f32x2 v[32]; fft_pass_c_compute(v, X, tid); __syncthreads();
#pragma unroll
        for (int u = 0; u < 2; ++u) { int jj = tid + 512 * u; asm volatile("" : "+v"(jj)); LAS f32x2* xb = X + jj + (jj >> 5);
#pragma unroll
            for (int p = 0; p < 16; ++p) xb[1056 * bitrev(p, 4)] = v[16 * u + p]; } }
    __syncthreads();
    f32x2* fs = WSP(f32x2, WS_FSPEC);
    for (int k = tid; k <= 8192; k += 512) {
        const f32x2 zk = X[PADI(k)], zn = X[PADI((FFT_N - k) & (FFT_N - 1))];
        fs[(size_t)c * FS_PITCH + k] = (f32x2){0.5f * (zk.x + zn.x) * sc0, 0.5f * (zk.y - zn.y) * sc0};
        fs[(size_t)(c + 1) * FS_PITCH + k] = (f32x2){0.5f * (zk.y + zn.y) * sc1, -0.5f * (zk.x - zn.x) * sc1};
    }
    __syncthreads();
}
__device__ __forceinline__ void phase0b(Frame& F, const Inputs& I) {
    const int gw = F.vcu * 8 + F.wave, NGW = F.G * 8;
    const float* mods = WSP(float, WS_MODS);
    {
        bf16_t* H = WSP(bf16_t, WS_H);
        for (int row = gw; row < M_ALL; row += NGW) {
            const float* src = row < M_LAT ? I.x + (size_t)row * D : I.ctx + (size_t)(row - M_LAT) * D;
            const float* md = mods + (row < M_LAT ? row / SEQ : 2) * 6144;
            const f32x4* xr = (const f32x4*)src + F.lane;
            f32x4 v[4]; float s = 0.f;
#pragma unroll
            for (int j = 0; j < 4; ++j) { v[j] = xr[64 * j]; s += (v[j].x * v[j].x + v[j].y * v[j].y) + (v[j].z * v[j].z + v[j].w * v[j].w); }
            const float rstd = 1.0f / sqrtf(wave_sum(s) * (1.0f / D) + EPS);
            u32x2* o8 = (u32x2*)(H + (size_t)row * D) + F.lane;
#pragma unroll
            for (int j = 0; j < 4; ++j) { const int k = 4 * F.lane + 256 * j;
                const f32x4 g = *(const f32x4*)(I.g_norm1 + k), sh = *(const f32x4*)(md + k), sc = *(const f32x4*)(md + 1024 + k);
                const f32x4 h = v[j] * rstd * g * (sc + 1.0f) + sh;
                o8[64 * j] = (u32x2){pk2(h.x, h.y), pk2(h.z, h.w)}; }
        }
    }
    for (int it = gw; it < 144; it += NGW) { const int b = it / 72, j = it % 72; const float* sh2 = mods + b * 6144 + 3 * 1024;
        float s = 0.f;
        for (int k = F.lane; k < 1024; k += 64) s += sh2[k] * (j < 8 ? I.w_group[k * 8 + j] : I.w_router[k * 64 + (j - 8)]);
        s = wave_sum(s);
        if (F.lane == 0) WSP(float, WS_CST)[it] = s + (j < 8 ? I.b_group[j] : I.b_router[j - 8]); }
}

using pg8::Unit; using pg8::cvt_pk_bf16;
struct EpiIn {
    static constexpr bool PERM = true;
    bf16_t* Z; const float* bias; float* gates;
    __device__ __forceinline__ void operator()(const f32x4 (&acc)[2][2][4][2], const Unit& u, int wr, int wc, int fr, int fq) const {
        const int row0 = u.pm * 256 + wr * 64 + fr;
        if (u.pn == 36) {
            if (wc == 0 && fq < 2) {
                const f32x4 b0 = *(const f32x4*)(bias + ZC + 8 * fq), b1 = *(const f32x4*)(bias + ZC + 8 * fq + 4);
#pragma unroll
                for (int ai = 0; ai < 2; ++ai)
#pragma unroll
                    for (int m = 0; m < 4; ++m) { float* gp = gates + (size_t)(row0 + ai * 128 + m * 16) * 16 + 8 * fq;
                        *(f32x4*)gp = acc[ai][0][m][0] + b0; *(f32x4*)(gp + 4) = acc[ai][0][m][1] + b1; }
            }
            return;
        }
        const int col0 = u.pn * 256 + wc * 32 + 8 * fq;
        f32x4 bv[2][2];
#pragma unroll
        for (int bj = 0; bj < 2; ++bj)
#pragma unroll
            for (int n = 0; n < 2; ++n) bv[bj][n] = *(const f32x4*)(bias + col0 + bj * 128 + 4 * n);
#pragma unroll
        for (int ai = 0; ai < 2; ++ai)
#pragma unroll
            for (int m = 0; m < 4; ++m) { bf16_t* rowp = Z + (size_t)(row0 + ai * 128 + m * 16) * ZC + col0;
#pragma unroll
                for (int bj = 0; bj < 2; ++bj) { const f32x4 v0 = acc[ai][bj][m][0] + bv[bj][0], v1 = acc[ai][bj][m][1] + bv[bj][1];
                    u32x4 w; w.x = cvt_pk_bf16(v0[0], v0[1]); w.y = cvt_pk_bf16(v0[2], v0[3]); w.z = cvt_pk_bf16(v1[0], v1[1]); w.w = cvt_pk_bf16(v1[2], v1[3]);
                    *(u32x4*)(rowp + bj * 128) = w; } }
    }
};
template <bool STEP_B> struct EpiMerge {
    static constexpr bool PERM = true;
    const bf16_t* Zg; bf16_t* T1; bf16_t* G;
    __device__ __forceinline__ void operator()(const f32x4 (&acc)[2][2][4][2], const Unit& u, int wr, int wc, int fr, int fq) const {
        const int row0 = u.pm * 256 + wr * 64 + fr, col0 = u.pn * 256 + wc * 32 + 8 * fq;
#pragma unroll
        for (int ai = 0; ai < 2; ++ai)
#pragma unroll
            for (int m = 0; m < 4; ++m) { const size_t row = (size_t)(row0 + ai * 128 + m * 16);
#pragma unroll
                for (int bj = 0; bj < 2; ++bj) {
                    const int col = col0 + bj * 128;
                    const u32x4 gw = *(const u32x4*)(Zg + row * ZC + col);
                    f32x4 g0 = {sigmoidf_(bflo(gw.x)), sigmoidf_(bfhi(gw.x)), sigmoidf_(bflo(gw.y)), sigmoidf_(bfhi(gw.y))};
                    f32x4 g1 = {sigmoidf_(bflo(gw.z)), sigmoidf_(bfhi(gw.z)), sigmoidf_(bflo(gw.w)), sigmoidf_(bfhi(gw.w))};
                    f32x4 v0 = g0 * acc[ai][bj][m][0], v1 = g1 * acc[ai][bj][m][1];
                    bf16_t* tp = T1 + row * D + col;
                    if constexpr (!STEP_B) { u32x4 w; w.x = cvt_pk_bf16(v0[0], v0[1]); w.y = cvt_pk_bf16(v0[2], v0[3]); w.z = cvt_pk_bf16(v1[0], v1[1]); w.w = cvt_pk_bf16(v1[2], v1[3]); *(u32x4*)tp = w; }
                    else { const u32x4 t = *(const u32x4*)tp;
                        v0 += (f32x4){bflo(t.x), bfhi(t.x), bflo(t.y), bfhi(t.y)}; v1 += (f32x4){bflo(t.z), bfhi(t.z), bflo(t.w), bfhi(t.w)};
                        u32x4 w; w.x = cvt_pk_bf16(v0[0], v0[1]); w.y = cvt_pk_bf16(v0[2], v0[3]); w.z = cvt_pk_bf16(v1[0], v1[1]); w.w = cvt_pk_bf16(v1[2], v1[3]);
                        *(u32x4*)(G + row * D + col) = w; }
                } }
    }
};
struct EpiRes {
    static constexpr bool PERM = false;
    const float* x; const float* mods; float* out;
    __device__ __forceinline__ void operator()(const f32x4 (&acc)[2][2][4][2], const Unit& u, int wr, int wc, int fr, int fq) const {
        const int row0 = u.pm * 256 + wr * 64 + fr, col0 = u.pn * 256 + wc * 32 + 4 * fq;
        const float* gate = mods + (u.pm * 256 / SEQ) * 6144 + 2 * 1024;
        f32x4 gv[2][2];
#pragma unroll
        for (int bj = 0; bj < 2; ++bj)
#pragma unroll
            for (int n = 0; n < 2; ++n) gv[bj][n] = *(const f32x4*)(gate + col0 + bj * 128 + n * 16);
#pragma unroll
        for (int ai = 0; ai < 2; ++ai)
#pragma unroll
            for (int m = 0; m < 4; ++m) { const size_t off = (size_t)(row0 + ai * 128 + m * 16) * D + col0;
#pragma unroll
                for (int bj = 0; bj < 2; ++bj)
#pragma unroll
                    for (int n = 0; n < 2; ++n) *(f32x4*)(out + off + bj * 128 + n * 16) = *(const f32x4*)(x + off + bj * 128 + n * 16) + gv[bj][n] * acc[ai][bj][m][n]; }
    }
};
struct EpiMoe1 {
    static constexpr bool PERM = true;
    bf16_t* H2;
    __device__ __forceinline__ void operator()(const f32x4 (&acc)[2][2][4][2], const Unit& u, int wr, int wc, int fr, int fq) const {
        const int row0 = u.pm * 256 + wr * 64 + fr, col0 = u.pn * 128 + wc * 32 + 8 * fq;
#pragma unroll
        for (int ai = 0; ai < 2; ++ai)
#pragma unroll
            for (int m = 0; m < 4; ++m) { const size_t row = (size_t)(row0 + ai * 128 + m * 16);
                f32x4 v0, v1;
#pragma unroll
                for (int i = 0; i < 4; ++i) { v0[i] = siluf_(acc[ai][0][m][0][i]) * acc[ai][1][m][0][i]; v1[i] = siluf_(acc[ai][0][m][1][i]) * acc[ai][1][m][1][i]; }
                u32x4 w; w.x = cvt_pk_bf16(v0[0], v0[1]); w.y = cvt_pk_bf16(v0[2], v0[3]); w.z = cvt_pk_bf16(v1[0], v1[1]); w.w = cvt_pk_bf16(v1[2], v1[3]);
                *(u32x4*)(H2 + row * DEXP + col0) = w; }
    }
};
struct EpiBf {
    static constexpr bool PERM = true;
    bf16_t* O; int ldo;
    __device__ __forceinline__ void operator()(const f32x4 (&acc)[2][2][4][2], const Unit& u, int wr, int wc, int fr, int fq) const {
        const int row0 = u.pm * 256 + wr * 64 + fr, col0 = u.pn * 256 + wc * 32 + 8 * fq;
#pragma unroll
        for (int ai = 0; ai < 2; ++ai)
#pragma unroll
            for (int m = 0; m < 4; ++m) { bf16_t* rowp = O + (size_t)(row0 + ai * 128 + m * 16) * ldo + col0;
#pragma unroll
                for (int bj = 0; bj < 2; ++bj) { const f32x4 v0 = acc[ai][bj][m][0], v1 = acc[ai][bj][m][1];
                    u32x4 w; w.x = cvt_pk_bf16(v0[0], v0[1]); w.y = cvt_pk_bf16(v0[2], v0[3]); w.z = cvt_pk_bf16(v1[0], v1[1]); w.w = cvt_pk_bf16(v1[2], v1[3]);
                    *(u32x4*)(rowp + bj * 128) = w; } }
    }
};
struct EpiFilt {
    static constexpr bool PERM = false;
    _Float16* FILT;
    __device__ __forceinline__ void operator()(const f32x4 (&acc)[2][2][4][2], const Unit& u, int wr, int wc, int fr, int fq) const {
        typedef _Float16 h16x4 __attribute__((ext_vector_type(4)));
        const int row0 = u.pm * 256 + wr * 64 + fr, col0 = u.pn * 256 + wc * 32 + 4 * fq;
        const float dmin = -4.605170186f / 1.5f, dmax = -4.605170186f / 0.3f;
#pragma unroll
        for (int ai = 0; ai < 2; ++ai)
#pragma unroll
            for (int m = 0; m < 4; ++m) { const int r = row0 + ai * 128 + m * 16;
                const float dc = fabsf(dmin + (float)(r & 1023) * ((dmax - dmin) / 1023.0f)) * (1.0f / (float)(SEQ - 1));
#pragma unroll
                for (int bj = 0; bj < 2; ++bj)
#pragma unroll
                    for (int n = 0; n < 2; ++n) { const int lag = col0 + bj * 128 + n * 16; h16x4 o;
#pragma unroll
                        for (int i = 0; i < 4; ++i) o[i] = (_Float16)(acc[ai][bj][m][n][i] * __expf(-(float)(lag + i) * dc));
                        *(h16x4*)(FILT + (size_t)r * SEQ + lag) = o; } }
    }
};
struct InOrder {
    pg8::StaticOrder so; int G, c;
    __device__ bool next(int i, Unit& u) const {
        long L = (long)i * G + c;
        if (L < 64 * 37) return so.map(L, u);
        L -= 64 * 37; if (L >= 26) return false;
        const int j = (int)(L % 13); u.pm = 64 + (int)(L / 13); u.pn = j < 12 ? j : 36; u.e = 0; u.pad = 0; u.aoff = u.pm * so.astep; u.boff = u.pn * so.bstep; return true;
    }
};
struct MoeOrder {
    const LAS int* tile_e; int ntiles, G, c; long astep, bstep, estep;
    __device__ bool next(int i, Unit& u) const {
        const long L = (long)i * G + c; if (L >= (long)ntiles * 4) return false;
        u.pm = (int)(L >> 2); u.pn = (int)(L & 3); u.e = tile_e[u.pm]; u.pad = 0; u.aoff = u.pm * astep; u.boff = u.e * estep + u.pn * bstep; return true;
    }
};

__device__ __forceinline__ void qk_item(Frame& F, const Inputs& I, int b, int head, int ci) {
    constexpr int RPITCH = 1040, QP = 528, O_RAW = 0, O_QS = 69632, O_KS = 103424;
    bf16_t* Z = WSP(bf16_t, WS_Z); bf16_t* QKC = WSP(bf16_t, WS_QKC);
    LAS unsigned char* L = F.lds;
    const int tid = F.tid, lane = F.lane, w = F.wave, fr = lane & 15, fq = lane >> 4;
    const bool is_ctx = ci < 4; const int j = is_ctx ? ci : ci - 4;
    const int rbase = is_ctx ? M_LAT + b * CTXL : b * SEQ, t0 = 64 * j;
    const int seg_lo = is_ctx ? 0 : t0, seg_hi = is_ctx ? CTXL : t0 + 64;
    for (int id = tid; id < 66 * 64; id += 512) { const int r = id >> 6, c = id & 63, t = t0 - 1 + r;
        u32x4 v = {0u, 0u, 0u, 0u};
        if (t >= seg_lo && t < seg_hi) v = *(const u32x4*)(Z + (size_t)(rbase + t) * ZC + (c >> 5) * 1024 + head * 256 + 8 * (c & 31));
        *(LAS u32x4*)(L + O_RAW + r * RPITCH + c * 16) = v; }
    const int cc = tid & 63, colabs = (cc >> 5) * 1024 + head * 256 + 8 * (cc & 31);
    float wt[3][8], bs[8];
#pragma unroll
    for (int e = 0; e < 8; ++e) { wt[0][e] = I.w_qk_conv[colabs + e]; wt[1][e] = I.w_qk_conv[2048 + colabs + e]; wt[2][e] = I.w_qk_conv[4096 + colabs + e]; bs[e] = I.b_qk_conv[colabs + e]; }
    const float osc = cc >= 32 ? 0.0625f : 1.0f;
    __syncthreads();
#pragma unroll 2
    for (int i = 0; i < 8; ++i) { const int r = (tid >> 6) + 8 * i;
        const u32x4 c0 = *(const LAS u32x4*)(L + O_RAW + r * RPITCH + cc * 16), c1 = *(const LAS u32x4*)(L + O_RAW + (r + 1) * RPITCH + cc * 16), c2 = *(const LAS u32x4*)(L + O_RAW + (r + 2) * RPITCH + cc * 16);
        float o[8];
#pragma unroll
        for (int h = 0; h < 4; ++h) {
            const float v0 = wt[0][2 * h] * bflo(c0[h]) + wt[1][2 * h] * bflo(c1[h]) + wt[2][2 * h] * bflo(c2[h]) + bs[2 * h];
            const float v1 = wt[0][2 * h + 1] * bfhi(c0[h]) + wt[1][2 * h + 1] * bfhi(c1[h]) + wt[2][2 * h + 1] * bfhi(c2[h]) + bs[2 * h + 1];
            o[2 * h] = siluf_(v0) * osc; o[2 * h + 1] = siluf_(v1) * osc; }
        u32x4 ov; ov.x = pk2(o[0], o[1]); ov.y = pk2(o[2], o[3]); ov.z = pk2(o[4], o[5]); ov.w = pk2(o[6], o[7]);
        *(LAS u32x4*)(L + (cc >= 32 ? O_KS : O_QS) + r * QP + (cc & 31) * 16) = ov;
        if (is_ctx) *(u32x4*)(QKC + (size_t)(b * CTXL + t0 + r) * ZC + colabs) = ov;
        else *(u32x4*)(Z + (size_t)(rbase + t0 + r) * ZC + colabs) = ov; }
    __syncthreads();
    {
        bf16_t* S0T = WSP(bf16_t, WS_S0T) + ((size_t)((b * 4 + head) * 132 + ci)) * 8192;
        const int tb = w >> 1;
#pragma unroll
        for (int sbi = 0; sbi < 2; ++sbi) { const int sb = 2 * (w & 1) + sbi;
            f32x4 acc = {0.f, 0.f, 0.f, 0.f};
#pragma unroll
            for (int kk = 0; kk < 8; ++kk) {
                const bf16x8 ka = *(const LAS bf16x8*)(L + O_KS + (16 * sb + fr) * QP + (32 * kk + 8 * fq) * 2);
                const bf16x8 qb = *(const LAS bf16x8*)(L + O_QS + (16 * tb + fr) * QP + (32 * kk + 8 * fq) * 2);
                acc = __builtin_amdgcn_mfma_f32_16x16x32_bf16(ka, qb, acc, 0, 0, 0); }
            const int t = 16 * tb + fr, s0 = 16 * sb + 4 * fq;
            u32x2 o; o.x = cvt_pk_bf16(s0 <= t ? acc[0] : 0.f, s0 + 1 <= t ? acc[1] : 0.f); o.y = cvt_pk_bf16(s0 + 2 <= t ? acc[2] : 0.f, s0 + 3 <= t ? acc[3] : 0.f);
            *(u32x2*)(S0T + t * 64 + s0) = o;
            o.x = cvt_pk_bf16(s0 + 3 >= t ? acc[3] : 0.f, s0 + 2 >= t ? acc[2] : 0.f); o.y = cvt_pk_bf16(s0 + 1 >= t ? acc[1] : 0.f, s0 >= t ? acc[0] : 0.f);
            *(u32x2*)(S0T + 4096 + (63 - t) * 64 + (60 - s0)) = o; }
    }
    __syncthreads();
}
__device__ __forceinline__ void hyprep_item(Frame& F, const Inputs& I, int tb, int chb) {
    const bf16_t* Z = WSP(bf16_t, WS_Z); bf16_t* SCM = WSP(bf16_t, WS_SCM);
    constexpr int PITCH = 144;
    LAS unsigned char* X1T = F.lds; LAS unsigned char* VT = F.lds + 64 * PITCH;
    const int p = chb >> 1, j0 = (chb & 1) * 64;
    {   const int r = F.tid >> 3, cc = F.tid & 7; const bf16_t* src = Z + (size_t)(tb * 64 + r) * ZC + ZC_PAIR + 256 * p + j0 + 8 * cc;
        *(LAS u32x4*)(X1T + r * PITCH + cc * 16) = *(const u32x4*)src;
        *(LAS u32x4*)(VT + r * PITCH + cc * 16) = *(const u32x4*)(src + 128); }
    __syncthreads();
    {   const int ch = F.tid >> 3, t8 = (F.tid & 7) * 8, c = chb * 64 + ch;
        float wx[3], wv[3];
#pragma unroll
        for (int k = 0; k < 3; ++k) { wx[k] = I.w_h_conv[k * 3072 + 1024 + c]; wv[k] = I.w_h_conv[k * 3072 + 2048 + c]; }
        const float bx = I.b_h_conv[1024 + c], bv = I.b_h_conv[2048 + c];
        float xs[10], vs[10];
#pragma unroll
        for (int i = 0; i < 10; ++i) { const int r = t8 - 1 + i; const bool ok = r >= 0 && r < 64;
            xs[i] = ok ? bf2f(*(const LAS bf16_t*)(X1T + r * PITCH + ch * 2)) : 0.f; vs[i] = ok ? bf2f(*(const LAS bf16_t*)(VT + r * PITCH + ch * 2)) : 0.f; }
        float s[8];
#pragma unroll
        for (int i = 0; i < 8; ++i) s[i] = (wx[0] * xs[i] + wx[1] * xs[i + 1] + wx[2] * xs[i + 2] + bx) * (wv[0] * vs[i] + wv[1] * vs[i + 1] + wv[2] * vs[i + 2] + bv);
        u32x4 o; o.x = pk2(s[0], s[1]); o.y = pk2(s[2], s[3]); o.z = pk2(s[4], s[5]); o.w = pk2(s[6], s[7]);
        const int b = tb >> 7, t0 = (tb & 127) * 64;
        *(u32x4*)(SCM + ((size_t)(b * 1024 + c)) * SEQ + t0 + t8) = o; }
    __syncthreads();
}
__device__ __forceinline__ void phase2a(Frame& F, const Inputs& I) {
    unsigned* q1 = WSP(unsigned, WS_CTL) + CW_Q1;
    volatile LAS int* itp = (volatile LAS int*)(F.lds + MISC_OFF + 64);
    for (;;) {
        if (F.tid == 0) *itp = (int)atomicAdd(q1, 1u);
        __syncthreads();
        const int it = *itp;
        __syncthreads();
        if (it >= 1056 + 4096) break;
        if (it < 1056) qk_item(F, I, it / 528, (it / 132) & 3, it % 132);
        else { const int j = it - 1056; hyprep_item(F, I, j >> 4, j & 15); }
    }
}

__device__ __forceinline__ bf16x8 tr_frag(const LAS unsigned char* p0, const LAS unsigned char* p1) {
    const s16x4 a = __builtin_amdgcn_ds_read_tr16_b64_v4i16((LAS s16x4*)p0);
    const s16x4 b = __builtin_amdgcn_ds_read_tr16_b64_v4i16((LAS s16x4*)p1);
    return (bf16x8){a[0], a[1], a[2], a[3], b[0], b[1], b[2], b[3]};
}
template <int CTRL, int RM, bool BC> __device__ __forceinline__ float dppf(float old, float x) {
    return __builtin_bit_cast(float, __builtin_amdgcn_update_dpp(__builtin_bit_cast(int, old), __builtin_bit_cast(int, x), CTRL, RM, 0xf, BC)); }
__device__ __forceinline__ float wave_scan_sum(float x) {
    x += dppf<0x111, 0xf, true>(0.f, x); x += dppf<0x112, 0xf, true>(0.f, x); x += dppf<0x114, 0xf, true>(0.f, x); x += dppf<0x118, 0xf, true>(0.f, x);
    x += dppf<0x142, 0xa, false>(0.f, x); x += dppf<0x143, 0xc, false>(0.f, x); return x; }
__device__ __forceinline__ float wave_scan_max(float x) {
    const float ninf = -__builtin_inff();
    x = fmaxf(x, dppf<0x111, 0xf, false>(ninf, x)); x = fmaxf(x, dppf<0x112, 0xf, false>(ninf, x)); x = fmaxf(x, dppf<0x114, 0xf, false>(ninf, x)); x = fmaxf(x, dppf<0x118, 0xf, false>(ninf, x));
    x = fmaxf(x, dppf<0x142, 0xa, false>(ninf, x)); x = fmaxf(x, dppf<0x143, 0xc, false>(ninf, x)); return x; }
__device__ __forceinline__ float lane63(float x) { return __builtin_bit_cast(float, __builtin_amdgcn_readlane(__builtin_bit_cast(int, x), 63)); }
__device__ __forceinline__ void mlstm_item(Frame& F, const Inputs& I, int item) {
    constexpr int QP = 528, VP = 112, PP = 144;
    constexpr int O_QS = 0, O_KS = 33792, O_VW = 67584, O_PS = 74752, O_CS = 83968, CS_BYTES = 25344, O_DEN = 134656, O_SC = 135168, SC_BYTES = 6 * 64 * 4;
    const int b = item >> 6, g = (item >> 3) & 7, dir = g >> 2, head = g & 3, eb = item & 7;
    int tid = F.tid; asm volatile("" : "+v"(tid));
    const int lane = tid & 63, w = F.wave, fr = lane & 15, fq = lane >> 4;
    LAS unsigned char* L = F.lds;
    const unsigned char* wsb = F.ws;
    const int qcol = head * 256, vcol = 2048 + head * 256 + eb * 32, ocol = 3072 + head * 256 + eb * 32;
    const int outcol = ZC_PAIR + dir * 1024 + head * 256 + eb * 32;
    const int gi = dir * 4 + head;
    for (int i = tid; i < 64 * 16; i += 512) { const int r = i >> 4, cidx = 32 + (i & 15);
        *(LAS bf16_t*)(L + O_VW + r * VP + cidx * 2) = (bf16_t)0; }
    for (int i = tid; i < 2 * CS_BYTES / 4; i += 512) *(LAS unsigned*)(L + O_CS + 4 * i) = 0u;
    f32x4 Cacc[2][3];
#pragma unroll
    for (int a = 0; a < 2; ++a)
#pragma unroll
        for (int c = 0; c < 3; ++c) Cacc[a][c] = (f32x4){0.f, 0.f, 0.f, 0.f};
    struct Stage { u32x4 q[4], k[4], v, s; float ig, fg; };
    Stage R0, R1;
    const int scc = tid & 31, srow0 = tid >> 5;
    const int ppos = tid >> 3, ps8 = (tid & 7) * 8;
    auto geom = [&](int st, int& rbase, int& tlo, int& ci) { const bool ctx = st < 4; const int j = ctx ? st : st - 4, sl = ctx ? CTXL : SEQ;
        rbase = ctx ? M_LAT + b * CTXL : b * SEQ; tlo = dir == 0 ? 64 * j : sl - 64 * (j + 1); ci = (ctx ? 0 : 4) + (tlo >> 6); };
    constexpr unsigned PITCH = (unsigned)(ZC * 2);
    const unsigned vo_g = (unsigned)(dir == 0 ? lane : 63 - lane) * 64u + (unsigned)gi * 4u;
    unsigned vo_q[4];
#pragma unroll
    for (int i = 0; i < 4; ++i) vo_q[i] = (unsigned)(srow0 + 16 * i) * PITCH + (unsigned)qcol * 2u + (unsigned)scc * 16u;
    const unsigned vo_v = (unsigned)((tid & 255) >> 2) * PITCH + (unsigned)vcol * 2u + (unsigned)(tid & 3) * 16u;
    const unsigned vo_s = (unsigned)(ppos * 64 + ps8) * 2u;
    unsigned vo_o[4];
#pragma unroll
    for (int i = 0; i < 4; ++i) { const int p = 16 * (w & 3) + 4 * fq + i; vo_o[i] = (unsigned)(dir == 0 ? p : 63 - p) * PITCH + (unsigned)(ocol + 16 * (w >> 2) + fr) * 2u; }
    auto prefetch = [&](int st, Stage& R) { int rbase, tlo, ci; geom(st, rbase, tlo, ci);
        const unsigned char* ug = wsb + ((unsigned)WS_GATES + (unsigned)(rbase + tlo) * 64u);
        R.ig = *(const float*)(ug + vo_g); R.fg = *(const float*)(ug + vo_g + 32u);
        const unsigned char* uq = wsb + (st < 4 ? (unsigned)WS_QKC + (unsigned)(b * CTXL + tlo) * PITCH : (unsigned)WS_Z + (unsigned)(rbase + tlo) * PITCH);
#pragma unroll
        for (int i = 0; i < 4; ++i) { R.q[i] = *(const u32x4*)(uq + vo_q[i]); R.k[i] = *(const u32x4*)(uq + vo_q[i] + 2048u); }
        R.v = *(const u32x4*)(wsb + ((unsigned)WS_Z + (unsigned)(rbase + tlo) * PITCH) + vo_v);
        R.s = *(const u32x4*)(wsb + ((unsigned)WS_S0T + (unsigned)(((b * 4 + head) * 132 + ci) * 2 + dir) * 8192u) + vo_s); };
    auto commit = [&](int buf, const Stage& R) {
        const LAS float* SCn = (const LAS float*)(L + O_SC + buf * SC_BYTES);
#pragma unroll
        for (int i = 0; i < 4; ++i) { const int mr = srow0 + 16 * i, p = dir ? 63 - mr : mr; *(LAS u32x4*)(L + O_QS + p * QP + scc * 16) = R.q[i]; *(LAS u32x4*)(L + O_KS + p * QP + scc * 16) = R.k[i]; }
        if (tid < 256) { const int mr = tid >> 2, p = dir ? 63 - mr : mr; const u32x4 pv = R.v;
            const float wg = SCn[256 + p]; u32x4 vo;
            vo.x = cvt_pk_bf16(bflo(pv.x) * wg, bfhi(pv.x) * wg); vo.y = cvt_pk_bf16(bflo(pv.y) * wg, bfhi(pv.y) * wg); vo.z = cvt_pk_bf16(bflo(pv.z) * wg, bfhi(pv.z) * wg); vo.w = cvt_pk_bf16(bflo(pv.w) * wg, bfhi(pv.w) * wg);
            *(LAS u32x4*)(L + O_VW + p * VP + (tid & 3) * 16) = vo; }
        else if (tid < 320) { const int p = tid - 256; *(LAS bf16_t*)(L + O_VW + p * VP + 64) = (bf16_t)f2bf(SCn[256 + p]); }
        *(LAS u32x4*)(L + O_PS + ppos * PP + ps8 * 2) = R.s; };
#define LDS_BAR() do { asm volatile("s_waitcnt lgkmcnt(0)" ::: "memory"); __builtin_amdgcn_s_barrier(); asm volatile("" ::: "memory"); } while (0)
    float mnext = 0.f;
    auto scalars = [&](float ig, float fg, int buf) {
        if (w == 7) {
            const float mprev = mnext;
            const float fc = fminf(fg, 0.f) - __logf(1.0f + __expf(-fabsf(fg)));
            const float bcum = wave_scan_sum(fc);
            const float aval = ig - bcum;
            const float cm = fmaxf(mprev, wave_scan_max(aval));
            const float cm63 = lane63(cm), b63 = lane63(bcum);
            mnext = b63 + cm63;
            LAS float* sc = (LAS float*)(L + O_SC + buf * SC_BYTES) + lane;
            sc[0] = __expf(fminf(cm63 - cm, 80.f)); sc[128] = __expf(mprev - cm); sc[192] = __expf(-(bcum + cm)); sc[256] = __expf(aval - cm63);
            if (lane == 0) sc[320] = __expf(mprev - cm63);
        } };
    prefetch(0, R0);
    scalars(R0.ig, R0.fg, 0);
    __syncthreads();
    commit(0, R0);
    prefetch(1, R1);
    __syncthreads();
    int cur = 0;
    auto step = [&](int st, Stage& RA, Stage& RB) {
        const bool has_next = st + 1 < 132, is_ctx = st < 4;
        int rbase_c, tlo_c, ci_c; geom(st, rbase_c, tlo_c, ci_c);
        unsigned short ov[4];
        const unsigned char* uo = wsb + ((unsigned)WS_Z + (unsigned)(rbase_c + tlo_c) * PITCH);
#pragma unroll
        for (int i = 0; i < 4; ++i) ov[i] = *(const bf16_t*)(uo + vo_o[i]);
        prefetch(st + 2 < 132 ? st + 2 : 131, RA);
        const LAS float* SC = (const LAS float*)(L + O_SC + cur * SC_BYTES);
        const float c_decay = SC[320];
        const int tt = w & 3, et = w >> 2;
        const int trg = lane >> 4, trq = (lane & 15) >> 2, trp = lane & 3;
        f32x4 nacc;
        {
            const LAS unsigned char* CSc = L + O_CS + cur * CS_BYTES;
            const f32x4 cs4 = *(const LAS f32x4*)(SC + 128 + 16 * tt + 4 * fq), rs4 = *(const LAS f32x4*)(SC + 16 * tt + 4 * fq);
            f32x4 a = {0.f, 0.f, 0.f, 0.f}, ia = {0.f, 0.f, 0.f, 0.f}, da = {0.f, 0.f, 0.f, 0.f}, dia = {0.f, 0.f, 0.f, 0.f};
#pragma unroll
            for (int kk = 0; kk < 8; ++kk) {
                const bf16x8 qa = *(const LAS bf16x8*)(L + O_QS + (16 * tt + fr) * QP + (32 * kk + 8 * fq) * 2);
                const bf16x8 cb = *(const LAS bf16x8*)(CSc + (16 * et + fr) * QP + (32 * kk + 8 * fq) * 2);
                a = __builtin_amdgcn_mfma_f32_16x16x32_bf16(qa, cb, a, 0, 0, 0);
                if ((kk >> 2) == et) { const bf16x8 cd = *(const LAS bf16x8*)(CSc + (32 + fr) * QP + (32 * kk + 8 * fq) * 2);
                    da = __builtin_amdgcn_mfma_f32_16x16x32_bf16(qa, cd, da, 0, 0, 0); } }
#pragma unroll
            for (int ks = 0; ks < 2; ++ks) {
                const bf16x8 pa = *(const LAS bf16x8*)(L + O_PS + (16 * tt + fr) * PP + (32 * ks + 8 * fq) * 2);
                const LAS unsigned char* vb = L + O_VW + (32 * ks + 8 * trg + trq) * VP + (16 * et + 4 * trp) * 2;
                ia = __builtin_amdgcn_mfma_f32_16x16x32_bf16(pa, tr_frag(vb, vb + 4 * VP), ia, 0, 0, 0);
                if (ks == et) { const LAS unsigned char* vd = L + O_VW + (32 * ks + 8 * trg + trq) * VP + (32 + 4 * trp) * 2;
                    dia = __builtin_amdgcn_mfma_f32_16x16x32_bf16(pa, tr_frag(vd, vd + 4 * VP), dia, 0, 0, 0); } }
            nacc = a * cs4 + ia * rs4;
            const f32x4 dacc = da * cs4 + dia * rs4;
            if (fr == 0) *(LAS f32x4*)(L + O_DEN + et * 256 + (16 * tt + 4 * fq) * 4) = dacc;
        }
        {
            LAS unsigned char* CSn = L + O_CS + (cur ^ 1) * CS_BYTES;
#pragma unroll
            for (int a = 0; a < 2; ++a)
#pragma unroll
                for (int c = 0; c < 3; ++c) Cacc[a][c] = Cacc[a][c] * c_decay;
#pragma unroll
            for (int ks = 0; ks < 2; ++ks) {
                bf16x8 ka[2], vb[3];
#pragma unroll
                for (int a = 0; a < 2; ++a) { const LAS unsigned char* p = L + O_KS + (32 * ks + 8 * trg + trq) * QP + (16 * (2 * w + a) + 4 * trp) * 2; ka[a] = tr_frag(p, p + 4 * QP); }
#pragma unroll
                for (int c = 0; c < 3; ++c) { const LAS unsigned char* p = L + O_VW + (32 * ks + 8 * trg + trq) * VP + (16 * c + 4 * trp) * 2; vb[c] = tr_frag(p, p + 4 * VP); }
#pragma unroll
                for (int a = 0; a < 2; ++a)
#pragma unroll
                    for (int c = 0; c < 3; ++c) Cacc[a][c] = __builtin_amdgcn_mfma_f32_16x16x32_bf16(ka[a], vb[c], Cacc[a][c], 0, 0, 0);
            }
#pragma unroll
            for (int a = 0; a < 2; ++a)
#pragma unroll
                for (int c = 0; c < 3; ++c) { u32x2 o; o.x = cvt_pk_bf16(Cacc[a][c][0], Cacc[a][c][1]); o.y = cvt_pk_bf16(Cacc[a][c][2], Cacc[a][c][3]);
                    *(LAS u32x2*)(CSn + (16 * c + fr) * QP + (16 * (2 * w + a) + 4 * fq) * 2) = o; }
        }
        if (has_next) scalars(RB.ig, RB.fg, cur ^ 1);
        LDS_BAR();
        if (!is_ctx) {
            const f32x4 den4 = *(const LAS f32x4*)(L + O_DEN + (16 * tt + 4 * fq) * 4) + *(const LAS f32x4*)(L + O_DEN + 256 + (16 * tt + 4 * fq) * 4), em4 = *(const LAS f32x4*)(SC + 192 + 16 * tt + 4 * fq);
#pragma unroll
            for (int i = 0; i < 4; ++i) { const float h = nacc[i] * __builtin_amdgcn_rcpf(fmaxf(fabsf(den4[i]), em4[i]));
                *(bf16_t*)((unsigned char*)uo + (vo_o[i] + (unsigned)(outcol - ocol) * 2u)) = (bf16_t)f2bf(sigmoidf_(bf2f(ov[i])) * h); }
        }
        if (has_next) commit(cur ^ 1, RB);
        cur ^= 1;
        LDS_BAR();
    };
    for (int st = 0; st < 132; st += 2) { step(st, R0, R1); step(st + 1, R1, R0); }
    __syncthreads();
#undef LDS_BAR
}

__device__ __forceinline__ void hyena_item(Frame& F, const Inputs& I, int c) {
    LAS f32x2* X = (LAS f32x2*)F.lds;
    int tid = F.tid; asm volatile("" : "+v"(tid));
    const bf16_t* s0 = WSP(bf16_t, WS_SCM) + (size_t)c * SEQ; const bf16_t* s1 = s0 + (size_t)1024 * SEQ;
    const f32x2* fs = WSP(f32x2, WS_FSPEC) + (size_t)c * FS_PITCH;
    bf16_t* y0 = WSP(bf16_t, WS_H) + (size_t)c * SEQ; bf16_t* y1 = y0 + (size_t)1024 * SEQ;
    unsigned skeep[16];
    {
        f32x2 v[32];
#pragma unroll
        for (int r = 0; r < 16; ++r) { const int t = tid + 512 * r; const unsigned a = s0[t], bq = s1[t]; skeep[r] = a | (bq << 16); v[r] = (f32x2){bf2f((unsigned short)a), bf2f((unsigned short)bq)}; }
#pragma unroll
        for (int r = 16; r < 32; ++r) v[r] = (f32x2){0.f, 0.f};
        __syncthreads();
        fft_pass_a_store(v, X, tid);
    }
    __syncthreads();
    fft_pass_b(X, tid);
    __syncthreads();
    {
        f32x2 v[32]; fft_pass_c_compute(v, X, tid);
        asm volatile("" ::: "memory"); __builtin_amdgcn_sched_barrier(0);
#pragma unroll
        for (int u = 0; u < 2; ++u)
#pragma unroll
            for (int p = 0; p < 16; ++p) { const int idx = tid + 512 * u + 1024 * bitrev(p, 4);
                f32x2 f = idx <= 8192 ? fs[idx] : fs[FFT_N - idx]; if (idx > 8192) f.y = -f.y;
                const f32x2 y = cmul(v[16 * u + p], f); v[16 * u + p] = (f32x2){y.x, -y.y}; }
        __syncthreads();
#pragma unroll
        for (int u = 0; u < 2; ++u) { int jj = tid + 512 * u; asm volatile("" : "+v"(jj)); LAS f32x2* xb = X + jj + (jj >> 5);
#pragma unroll
            for (int p = 0; p < 16; ++p) xb[1056 * bitrev(p, 4)] = v[16 * u + p]; }
    }
    __syncthreads();
    {   f32x2 v[32]; fft_load32(v, X, tid); __syncthreads(); fft_pass_a_store(v, X, tid); }
    __syncthreads();
    fft_pass_b(X, tid);
    __syncthreads();
    {   f32x2 v[32]; fft_pass_c_compute(v, X, tid);
        asm volatile("" ::: "memory"); __builtin_amdgcn_sched_barrier(0);
        const float hb = I.h_bias[c];
#pragma unroll
        for (int u = 0; u < 2; ++u)
#pragma unroll
            for (int p = 0; p < 16; ++p) { const int q = bitrev(p, 4);
                if (q < 8) { const int idx = tid + 512 * u + 1024 * q; const unsigned sk = skeep[u + 2 * q];
                    const float o0 = v[16 * u + p].x + hb * bflo(sk), o1 = -v[16 * u + p].y + hb * bfhi(sk);
                    y0[idx] = (bf16_t)f2bf(o0); y1[idx] = (bf16_t)f2bf(o1); } }
    }
    __syncthreads();
}
__device__ __forceinline__ void hy_item(Frame& F, const Inputs& I, int tb, int chb) {
    bf16_t* Z = WSP(bf16_t, WS_Z); const bf16_t* YCM = WSP(bf16_t, WS_H);
    constexpr int PITCH = 144;
    LAS unsigned char* X0T = F.lds; LAS unsigned char* YT = F.lds + 64 * PITCH;
    const int b = tb >> 7, t0 = (tb & 127) * 64;
    {   const int r = F.tid >> 3, cc = F.tid & 7;
        *(LAS u32x4*)(X0T + r * PITCH + cc * 16) = *(const u32x4*)(Z + (size_t)(tb * 64 + r) * ZC + ZC_X0 + chb * 64 + 8 * cc);
        *(LAS u32x4*)(YT + r * PITCH + cc * 16) = *(const u32x4*)(YCM + ((size_t)(b * 1024 + chb * 64 + r)) * SEQ + t0 + 8 * cc); }
    __syncthreads();
    {   const int r = F.tid >> 3, cc = F.tid & 7;
        const u32x4 z = {0u, 0u, 0u, 0u};
        const u32x4 c1 = *(const LAS u32x4*)(X0T + r * PITCH + cc * 16);
        const u32x4 c0 = r > 0 ? *(const LAS u32x4*)(X0T + (r - 1) * PITCH + cc * 16) : z;
        const u32x4 c2 = r < 63 ? *(const LAS u32x4*)(X0T + (r + 1) * PITCH + cc * 16) : z;
        float o[8];
        const int cb8 = chb * 64 + 8 * cc;
        const f32x4 w0a = *(const f32x4*)(I.w_h_conv + cb8), w0b = *(const f32x4*)(I.w_h_conv + cb8 + 4), w1a = *(const f32x4*)(I.w_h_conv + 3072 + cb8), w1b = *(const f32x4*)(I.w_h_conv + 3072 + cb8 + 4);
        const f32x4 w2a = *(const f32x4*)(I.w_h_conv + 6144 + cb8), w2b = *(const f32x4*)(I.w_h_conv + 6144 + cb8 + 4), bba = *(const f32x4*)(I.b_h_conv + cb8), bbb = *(const f32x4*)(I.b_h_conv + cb8 + 4);
#pragma unroll
        for (int e = 0; e < 8; ++e) { const int h = e >> 1;
            const float a0 = (e & 1) ? bfhi(c0[h]) : bflo(c0[h]), a1 = (e & 1) ? bfhi(c1[h]) : bflo(c1[h]), a2 = (e & 1) ? bfhi(c2[h]) : bflo(c2[h]);
            const float k0 = e < 4 ? w0a[e & 3] : w0b[e & 3], k1 = e < 4 ? w1a[e & 3] : w1b[e & 3], k2 = e < 4 ? w2a[e & 3] : w2b[e & 3], kb = e < 4 ? bba[e & 3] : bbb[e & 3];
            const float x0 = k0 * a0 + k1 * a1 + k2 * a2 + kb;
            o[e] = x0 * bf2f(*(const LAS bf16_t*)(YT + (8 * cc + e) * PITCH + r * 2)); }
        u32x4 ov; ov.x = pk2(o[0], o[1]); ov.y = pk2(o[2], o[3]); ov.z = pk2(o[4], o[5]); ov.w = pk2(o[6], o[7]);
        *(u32x4*)(Z + (size_t)(tb * 64 + r) * ZC + ZC_X0 + chb * 64 + 8 * cc) = ov; }
    __syncthreads();
}

__device__ __forceinline__ void phase2b(Frame& F, const Inputs& I) {
    const int GA = F.G >= 2 ? F.G / 2 : 1, GB = F.G - GA;
    if (F.vcu < GA) { for (int it = F.vcu; it < 128; it += GA) mlstm_item(F, I, it); __syncthreads(); }
    if (GB == 0 || F.vcu >= GA) {
        const int c0 = GB ? F.vcu - GA : 0, cs = GB ? GB : 1;
        unsigned* sub = WSP(unsigned, WS_CTL) + CW_SUB;
        const int cpw = (1024 / 2 + cs - 1) / cs * 2, cb = c0 * cpw, ce = cb + cpw < 1024 ? cb + cpw : 1024;
        fft_twiddle_init(F.lds, F.tid);
        __syncthreads();
        for (int c = cb; c < ce; c += 2) filter_spec_item(F, I, c >> 1);
        for (int c = cb; c < ce; ++c) hyena_item(F, I, c);
        subgrid_barrier(sub, (unsigned)cs, 1u);
        for (int it = c0; it < 4096; it += cs) hy_item(F, I, it >> 4, it & 15);
        subgrid_barrier(sub, (unsigned)cs, 2u);
        {
            bf16_t* Z = WSP(bf16_t, WS_Z);
            pg8::Gemm g{Z + ZC_X0, WSP(bf16_t, WS_WB_T), ZC, D, D};
            pg8::StaticOrder S; S.init(64, 4, cs, c0, 256L * ZC * 2, 256L * D * 2);
            EpiMerge<false> E{Z + ZC_GB, WSP(bf16_t, WS_FSPEC), nullptr};
            pg8::gemm_phase<EpiMerge<false>, pg8::StaticOrder, true>(F.lds, g, S, E);
        }
    }
}

struct XtItem { const float* W; int N, k0, n0; bf16_t* WT; int ldt, drow0; };
__device__ __forceinline__ XtItem xt_decode(const Inputs& I, bf16_t* W13T, bf16_t* W2T, int it) {
    constexpr int PER_E = 3 * 256;
    const int e = it / PER_E, r = it % PER_E, m = r >> 8, rr = r & 255; XtItem x;
    if (m < 2) { const int kb = rr >> 4, nb = rr & 15, n0 = 32 * nb;
        x.W = (m == 0 ? I.w1_e : I.w3_e) + (size_t)e * D * DEXP; x.N = DEXP; x.k0 = 64 * kb; x.n0 = n0; x.WT = W13T + (size_t)e * 1024 * 1024; x.ldt = D; x.drow0 = (n0 >> 7) * 256 + m * 128 + (n0 & 127); }
    else { const int kb = rr >> 5, nb = rr & 31;
        x.W = I.w2_e + (size_t)e * DEXP * D; x.N = D; x.k0 = 64 * kb; x.n0 = 32 * nb; x.WT = W2T + (size_t)e * 1024 * DEXP; x.ldt = DEXP; x.drow0 = 32 * nb; }
    return x;
}
__device__ __forceinline__ void xt_load(const XtItem& x, float (&v)[32], int lane) {
    const float* p = x.W + (size_t)(x.k0 + (lane >> 5)) * x.N + x.n0 + (lane & 31);
#pragma unroll
    for (int i = 0; i < 32; ++i) v[i] = p[(size_t)(2 * i) * x.N];
}
__device__ __forceinline__ void xt_finish(const XtItem& x, const float (&v)[32], LAS float* scr, int lane) {
#pragma unroll
    for (int i = 0; i < 32; ++i) scr[(2 * i + (lane >> 5)) * 33 + (lane & 31)] = v[i];
    asm volatile("s_waitcnt lgkmcnt(0)" ::: "memory");
    const int c = lane & 7;
#pragma unroll
    for (int j = 0; j < 4; ++j) { const int n = (lane >> 3) + 8 * j; const LAS float* s = scr + (8 * c) * 33 + n;
        u32x4 o; o.x = pk2(s[0 * 33], s[1 * 33]); o.y = pk2(s[2 * 33], s[3 * 33]); o.z = pk2(s[4 * 33], s[5 * 33]); o.w = pk2(s[6 * 33], s[7 * 33]);
        *(u32x4*)(x.WT + (size_t)(x.drow0 + n) * x.ldt + x.k0 + 8 * c) = o; }
    asm volatile("s_waitcnt lgkmcnt(0)" ::: "memory");
}
__device__ __forceinline__ void expert_transposes(Frame& F, const Inputs& I, int part, int nparts, int wg, int nwg) {
    LAS float* scr = (LAS float*)(F.lds + F.wave * 16384);
    const int gw = wg * 8 + F.wave, NGW = nwg * 8;
    constexpr int NIT = NEXP * 3 * 256;
    const int lo = (int)((long)NIT * part / nparts), hi = (int)((long)NIT * (part + 1) / nparts);
    bf16_t* W13T = WSP(bf16_t, WS_W13T); bf16_t* W2T = WSP(bf16_t, WS_W2T);
    int it = lo + gw; if (it >= hi) return;
    float va[32], vb[32];
    XtItem xa = xt_decode(I, W13T, W2T, it), xb = xa;
    xt_load(xa, va, F.lane);
    for (;;) {
        const bool nb = it + NGW < hi;
        if (nb) { xb = xt_decode(I, W13T, W2T, it + NGW); xt_load(xb, vb, F.lane); }
        xt_finish(xa, va, scr, F.lane);
        if (!nb) break;
        it += NGW;
        const bool na = it + NGW < hi;
        if (na) { xa = xt_decode(I, W13T, W2T, it + NGW); xt_load(xa, va, F.lane); }
        xt_finish(xb, vb, scr, F.lane);
        if (!na) break;
        it += NGW;
    }
}

struct Route { int e0, e1; float w0, w1; };
__device__ __forceinline__ void route_item(Frame& F, const Inputs& I, const float* x1, int blk) {
    constexpr int RP = 528;
    constexpr int O_AH = 0, O_AL = 33792, O_BH = 67584, O_BL = 109824, O_SSQ = 152064, O_LC = 152320;
    LAS unsigned char* L = F.lds;
    const int tid = F.tid, lane = F.lane, w = F.wave, fr = lane & 15, fq = lane >> 4;
    const int row0 = blk * 64, b = row0 / SEQ;
    const float* mods = WSP(float, WS_MODS) + b * 6144;
    const bf16_t* w72s = WSP(bf16_t, WS_W72S);
    f32x4 acc[3];
#pragma unroll
    for (int t = 0; t < 3; ++t) acc[t] = (f32x4){0.f, 0.f, 0.f, 0.f};
    const int sr = tid >> 3, seg = tid & 7;
    float ssq = 0.f;
    if (tid < 64) *(LAS int*)(L + O_LC + 4 * tid) = 0;
    for (int kt = 0; kt < 4; ++kt) {
#pragma unroll
        for (int i = 0; i < 8; ++i) { const int kk = 32 * i + 4 * seg, k = kt * 256 + kk;
            const f32x4 xv = *(const f32x4*)(x1 + (size_t)(row0 + sr) * D + k);
            ssq += (xv.x * xv.x + xv.y * xv.y) + (xv.z * xv.z + xv.w * xv.w);
            const f32x4 g = *(const f32x4*)(I.g_norm2 + k), sc = *(const f32x4*)(mods + 4 * 1024 + k);
            const f32x4 hv = xv * g * (sc + 1.0f);
            const unsigned h0 = f2bf(hv.x), h1 = f2bf(hv.y), h2 = f2bf(hv.z), h3 = f2bf(hv.w);
            const u32x2 hi = {h0 | (h1 << 16), h2 | (h3 << 16)};
            const u32x2 lo = {pk2(hv.x - bf2f((unsigned short)h0), hv.y - bf2f((unsigned short)h1)), pk2(hv.z - bf2f((unsigned short)h2), hv.w - bf2f((unsigned short)h3))};
            *(LAS u32x2*)(L + O_AH + sr * RP + kk * 2) = hi; *(LAS u32x2*)(L + O_AL + sr * RP + kk * 2) = lo; }
#pragma unroll
        for (int j = 0; j < 10; ++j) { const int id = tid + 512 * j, which = id / 2560, rem = id % 2560, col = rem >> 5, c16 = rem & 31;
            *(LAS u32x4*)(L + (which ? O_BL : O_BH) + col * RP + c16 * 16) = *(const u32x4*)(w72s + (size_t)(col * 2 + which) * 1024 + kt * 256 + c16 * 8); }
        __syncthreads();
#pragma unroll
        for (int ti = 0; ti < 3; ++ti) { const int T = w + 8 * ti;
            if (T < 20) { const int rt = T & 3, ct = T >> 2;
#pragma unroll
                for (int k8 = 0; k8 < 8; ++k8) {
                    const bf16x8 ah = *(const LAS bf16x8*)(L + O_AH + (16 * rt + fr) * RP + (32 * k8 + 8 * fq) * 2), al = *(const LAS bf16x8*)(L + O_AL + (16 * rt + fr) * RP + (32 * k8 + 8 * fq) * 2);
                    const bf16x8 bh = *(const LAS bf16x8*)(L + O_BH + (16 * ct + fr) * RP + (32 * k8 + 8 * fq) * 2), bl = *(const LAS bf16x8*)(L + O_BL + (16 * ct + fr) * RP + (32 * k8 + 8 * fq) * 2);
                    acc[ti] = __builtin_amdgcn_mfma_f32_16x16x32_bf16(ah, bh, acc[ti], 0, 0, 0);
                    acc[ti] = __builtin_amdgcn_mfma_f32_16x16x32_bf16(al, bh, acc[ti], 0, 0, 0);
                    acc[ti] = __builtin_amdgcn_mfma_f32_16x16x32_bf16(ah, bl, acc[ti], 0, 0, 0);
                } } }
        __syncthreads();
    }
    ssq += __shfl_xor(ssq, 1); ssq += __shfl_xor(ssq, 2); ssq += __shfl_xor(ssq, 4);
    if (seg == 0) *(LAS float*)(L + O_SSQ + 4 * sr) = ssq;
    LAS float* LOG = (LAS float*)L;
#pragma unroll
    for (int ti = 0; ti < 3; ++ti) { const int T = w + 8 * ti;
        if (T < 20) { const int rt = T & 3, ct = T >> 2;
#pragma unroll
            for (int i = 0; i < 4; ++i) LOG[(16 * rt + 4 * fq + i) * 81 + 16 * ct + fr] = acc[ti][i]; } }
    __syncthreads();
    if (w == 0) {
        const float rstd = 1.0f / sqrtf(*(const LAS float*)(L + O_SSQ + 4 * lane) * (1.0f / D) + EPS);
        const float* cst = WSP(float, WS_CST) + b * 72;
        float lg[72];
#pragma unroll
        for (int j = 0; j < 72; ++j) lg[j] = rstd * LOG[lane * 81 + j] + cst[j];
        int gsel = 0; float gmax = lg[0];
#pragma unroll
        for (int j = 1; j < 8; ++j) if (lg[j] > gmax) { gmax = lg[j]; gsel = j; }
        float gs = 0.f;
#pragma unroll
        for (int j = 0; j < 8; ++j) gs += __expf(lg[j] - gmax);
        const float gwt = 1.0f / gs;
        float el[8];
#pragma unroll
        for (int j = 0; j < 8; ++j) { float v = lg[8 + j];
#pragma unroll
            for (int gI = 1; gI < 8; ++gI) v = gsel == gI ? lg[8 + 8 * gI + j] : v;
            el[j] = v; }
        int i0 = 0; float v0 = el[0];
#pragma unroll
        for (int j = 1; j < 8; ++j) if (el[j] > v0) { v0 = el[j]; i0 = j; }
        int i1 = -1; float v1 = -3.0e38f;
#pragma unroll
        for (int j = 0; j < 8; ++j) if (j != i0 && el[j] > v1) { v1 = el[j]; i1 = j; }
        const float p1 = __expf(v1 - v0), inv = 1.0f / (1.0f + p1);
        const int e0 = gsel * 8 + i0, e1 = gsel * 8 + i1;
        const int r0 = __hip_atomic_fetch_add((LAS int*)(L + O_LC) + e0, 1, __ATOMIC_RELAXED, __HIP_MEMORY_SCOPE_WORKGROUP);
        const int r1 = __hip_atomic_fetch_add((LAS int*)(L + O_LC) + e1, 1, __ATOMIC_RELAXED, __HIP_MEMORY_SCOPE_WORKGROUP);
        Route r; r.e0 = e0 | (r0 << 8); r.e1 = e1 | (r1 << 8); r.w0 = gwt * inv; r.w1 = gwt * p1 * inv;
        WSP(Route, WS_ROUTE)[row0 + lane] = r;
        WSP(float, WS_RSTD2)[row0 + lane] = rstd;
    }
    __syncthreads();
    if (tid < 64) WSP(int, WS_BLKCNT)[blk * 64 + tid] = *(const LAS int*)(L + O_LC + 4 * tid);
    __syncthreads();
}
__device__ __forceinline__ int moe_tables(Frame& F, LAS int* seg_start, LAS int* tile_e) {
    const unsigned* cnt = WSP(unsigned, WS_CTL) + CW_CNT;
    if (F.tid < 64) seg_start[96 + F.tid] = (int)__hip_atomic_load(cnt + F.tid, RLX_AGENT);
    __syncthreads();
    if (F.tid < 64) { int s = 0; for (int e = 0; e < F.tid; ++e) s += (seg_start[96 + e] + 255) >> 8; seg_start[F.tid] = s * 256; }
    __syncthreads();
    if (F.tid < 64) { const int t0 = seg_start[F.tid] >> 8, nt = (seg_start[96 + F.tid] + 255) >> 8; for (int t = 0; t < nt; ++t) tile_e[t0 + t] = F.tid; if (F.tid == 63) seg_start[64] = (t0 + nt) * 256; }
    __syncthreads();
    return seg_start[64] >> 8;
}
__device__ __forceinline__ void phase4b(Frame& F, const Inputs& I, const float* x1) {
    LAS int* PART = (LAS int*)F.lds;
    LAS int* TOT = PART + 1024;
    LAS int* BEF = TOT + 64;
    LAS int* SEG = BEF + 64;
    const int* blkcnt = WSP(int, WS_BLKCNT);
    bf16_t* XS = WSP(bf16_t, WS_XS);
    for (int blk = F.vcu; blk < M_LAT / 64; blk += F.G) {
        {   const int e = F.tid & 63, part = F.tid >> 6; int sa = 0, sb = 0;
#pragma unroll 8
            for (int i = 0; i < 32; ++i) { const int bb = 32 * part + i; const int c = blkcnt[bb * 64 + e]; sa += c; sb += bb < blk ? c : 0; }
            PART[(part * 64 + e) * 2] = sa; PART[(part * 64 + e) * 2 + 1] = sb; }
        __syncthreads();
        if (F.tid < 64) { int ta = 0, tb = 0;
#pragma unroll
            for (int p = 0; p < 8; ++p) { ta += PART[(p * 64 + F.tid) * 2]; tb += PART[(p * 64 + F.tid) * 2 + 1]; }
            TOT[F.tid] = ta; BEF[F.tid] = tb;
            if (blk == 0) WSP(unsigned, WS_CTL)[CW_CNT + F.tid] = (unsigned)ta; }
        __syncthreads();
        if (F.tid == 0) { int run = 0; for (int e = 0; e < 64; ++e) { SEG[e] = run * 256; run += (TOT[e] + 255) >> 8; } SEG[64] = run * 256; }
        __syncthreads();
#pragma unroll 1
        for (int i = 0; i < 8; ++i) {
            const int row = blk * 64 + F.wave * 8 + i;
            const Route r = WSP(Route, WS_ROUTE)[row];
            const int e0 = r.e0 & 255, e1 = r.e1 & 255;
            const int sl0 = SEG[e0] + BEF[e0] + (r.e0 >> 8), sl1 = SEG[e1] + BEF[e1] + (r.e1 >> 8);
            if (F.lane == 0) { WSP(int, WS_TOKSLOT)[2 * row] = sl0; WSP(int, WS_TOKSLOT)[2 * row + 1] = sl1; }
            const float rstd = WSP(float, WS_RSTD2)[row];
            const float* md = WSP(float, WS_MODS) + (row / SEQ) * 6144;
            const f32x4* xr = (const f32x4*)(x1 + (size_t)row * D) + F.lane;
            u32x2* o0 = (u32x2*)(XS + (size_t)sl0 * D) + F.lane; u32x2* o1 = (u32x2*)(XS + (size_t)sl1 * D) + F.lane;
#pragma unroll
            for (int j = 0; j < 4; ++j) { const int k = 4 * F.lane + 256 * j; const f32x4 xv = xr[64 * j];
                const f32x4 g = *(const f32x4*)(I.g_norm2 + k), sh = *(const f32x4*)(md + 3 * 1024 + k), sc = *(const f32x4*)(md + 4 * 1024 + k);
                const f32x4 h = xv * rstd * g * (sc + 1.0f) + sh;
                const u32x2 o = {pk2(h.x, h.y), pk2(h.z, h.w)}; o0[64 * j] = o; o1[64 * j] = o; }
        }
        __syncthreads();
    }
}
__device__ __forceinline__ void phase6(Frame& F, const Inputs& I, float* out) {
    const int gw = F.vcu * 8 + F.wave, NGW = F.G * 8;
    const bf16_t* Y = WSP(bf16_t, WS_XS);
    for (int row = gw; row < M_LAT; row += NGW) {
        const Route r = WSP(Route, WS_ROUTE)[row];
        const int sl0 = WSP(int, WS_TOKSLOT)[2 * row], sl1 = WSP(int, WS_TOKSLOT)[2 * row + 1];
        const float* md = WSP(float, WS_MODS) + (row / SEQ) * 6144 + 5 * 1024;
        f32x4* xr = (f32x4*)(out + (size_t)row * D) + F.lane;
        const u32x2* y0 = (const u32x2*)(Y + (size_t)sl0 * D) + F.lane; const u32x2* y1 = (const u32x2*)(Y + (size_t)sl1 * D) + F.lane;
        f32x4 v[4]; float s = 0.f;
#pragma unroll
        for (int j = 0; j < 4; ++j) { const int k = 4 * F.lane + 256 * j; const u32x2 a = y0[64 * j], bq = y1[64 * j];
            const f32x4 ya = {bflo(a.x), bfhi(a.x), bflo(a.y), bfhi(a.y)}, yb = {bflo(bq.x), bfhi(bq.x), bflo(bq.y), bfhi(bq.y)};
            const f32x4 moe = ya * r.w0 + yb * r.w1;
            v[j] = xr[64 * j] + *(const f32x4*)(md + k) * moe;
            s += (v[j].x * v[j].x + v[j].y * v[j].y) + (v[j].z * v[j].z + v[j].w * v[j].w); }
        const float rstd = 1.0f / sqrtf(wave_sum(s) * (1.0f / D) + EPS);
#pragma unroll
        for (int j = 0; j < 4; ++j) { const int k = 4 * F.lane + 256 * j; xr[64 * j] = v[j] * rstd * *(const f32x4*)(I.g_final + k); }
    }
}

#ifndef MK_PER_PHASE
#define MK_PER_PHASE 0
#endif
constexpr int N_PHASES = 12;
constexpr int TAB_OFF = 150 * 1024;

__global__ void __launch_bounds__(512, 2) fwd_kernel(Args args) {
    extern __shared__ __attribute__((aligned(16))) unsigned char lds_raw[];
    Frame F;
    F.lds = (LAS unsigned char*)lds_raw;
    F.tid = threadIdx.x; F.lane = F.tid & 63; F.wave = __builtin_amdgcn_readfirstlane(F.tid >> 6);
    F.G = gridDim.x; { const int bx = blockIdx.x; F.vcu = (F.G % 8 == 0) ? (bx % 8) * (F.G / 8) + bx / 8 : bx; }
    F.ws = args.ws;
    const Inputs& I = args.in;
    volatile LAS unsigned* MISC = (volatile LAS unsigned*)(F.lds + MISC_OFF);
    if (F.tid < 32) MISC[F.tid] = 0u;
    __syncthreads();
    XcdBarrier bar; bar.bar = WSP(unsigned, WS_CTL) + CW_BAR; bar.x = 0; bar.st = nullptr;
#if !MK_PER_PHASE
    bar = xcd_barrier_post(WSP(unsigned, WS_CTL) + CW_BAR, MISC + 8);
#define GRID_BAR() xcd_barrier(bar)
#else
#define GRID_BAR() do {} while (0)
#endif
    const int lo = args.ph_lo, hi = args.ph_hi;
#ifndef PH_MASK
#define PH_MASK 0xffff
#endif
#define IN(k) (((PH_MASK >> (k)) & 1) && lo <= (k) && (k) < hi)
#define SEAM(k) do { if (IN(k) && IN((k) + 1)) GRID_BAR(); } while (0)
    bf16_t* Z = WSP(bf16_t, WS_Z);
    float* x1 = args.out;

    if (IN(0)) { phase0(F, I); } SEAM(0);
    if (IN(1)) {
        phase0b(F, I);
        __syncthreads();
        pg8::Gemm g{WSP(bf16_t, WS_W3S), WSP(bf16_t, WS_HID2), 256, 256, 256};
        pg8::StaticOrder S; S.init(8, 32, F.G, (int)blockIdx.x, 256L * 256 * 2, 256L * 256 * 2);
        EpiFilt E{WSP(_Float16, WS_FILT)};
        pg8::gemm_phase<EpiFilt, pg8::StaticOrder, false>(F.lds, g, S, E);
        __syncthreads();
        weight_transposes(F, I, 0, F.vcu, F.G);
    } SEAM(1);
    if (IN(2)) {
        pg8::Gemm g{WSP(bf16_t, WS_H), WSP(bf16_t, WS_WIN_T), D, D, D};
        InOrder S; S.so.init(64, 37, F.G, (int)blockIdx.x, 256L * D * 2, 256L * D * 2); S.G = F.G; S.c = (int)blockIdx.x;
        EpiIn E{Z, WSP(float, WS_BIASP), WSP(float, WS_GATES)};
        pg8::gemm_phase<EpiIn, InOrder, true>(F.lds, g, S, E);
        const int nfull = (64 * 37 + 26) % F.G, nlight = F.G - nfull;
        __syncthreads();
        if (nfull == 0) weight_transposes(F, I, 1, (int)blockIdx.x, F.G);
        else if ((int)blockIdx.x >= nfull) weight_transposes(F, I, 1, (int)blockIdx.x - nfull, nlight);
    } SEAM(2);
    if (IN(3)) { phase2a(F, I); } SEAM(3);
    if (IN(4)) { phase2b(F, I); } SEAM(4);
    if (IN(5)) {
        pg8::Gemm g{Z + ZC_PAIR, WSP(bf16_t, WS_WA2_T), ZC, 2 * D, 2 * D};
        pg8::StaticOrder S; S.init(64, 4, F.G, (int)blockIdx.x, 256L * ZC * 2, 256L * 2 * D * 2);
        EpiMerge<true> E{Z + ZC_GA, WSP(bf16_t, WS_FSPEC), WSP(bf16_t, WS_H)};
        pg8::gemm_phase<EpiMerge<true>, pg8::StaticOrder, false>(F.lds, g, S, E);
    } SEAM(5);
    if (IN(6)) {
        pg8::Gemm g{WSP(bf16_t, WS_H), WSP(bf16_t, WS_WOUT_T), D, D, D};
        pg8::StaticOrder S; S.init(64, 4, F.G, (int)blockIdx.x, 256L * D * 2, 256L * D * 2);
        EpiRes E{I.x, WSP(float, WS_MODS), x1};
        pg8::gemm_phase<EpiRes, pg8::StaticOrder, false>(F.lds, g, S, E);
        __syncthreads();
        expert_transposes(F, I, 0, 2, F.vcu, F.G);
    } SEAM(6);
    if (IN(7)) {
        for (int blk = F.vcu; blk < M_LAT / 64; blk += F.G) route_item(F, I, x1, blk);
        __syncthreads();
        expert_transposes(F, I, 1, 2, F.vcu, F.G);
    } SEAM(7);
    if (IN(8)) { phase4b(F, I, x1); } SEAM(8);
    if (IN(9)) {
        LAS int* seg_start = (LAS int*)(F.lds + TAB_OFF); LAS int* tile_e = seg_start + 192;
        const int ntiles = moe_tables(F, seg_start, tile_e);
        pg8::Gemm g{WSP(bf16_t, WS_XS), WSP(bf16_t, WS_W13T), D, D, D};
        MoeOrder S{tile_e, ntiles, F.G, F.vcu, 256L * D * 2, 256L * D * 2, 1024L * D * 2};
        EpiMoe1 E{WSP(bf16_t, WS_FSPEC)};
        pg8::gemm_phase<EpiMoe1, MoeOrder, true>(F.lds, g, S, E);
    } SEAM(9);
    if (IN(10)) {
        LAS int* seg_start = (LAS int*)(F.lds + TAB_OFF); LAS int* tile_e = seg_start + 192;
        const int ntiles = moe_tables(F, seg_start, tile_e);
        pg8::Gemm g{WSP(bf16_t, WS_FSPEC), WSP(bf16_t, WS_W2T), DEXP, DEXP, DEXP};
        MoeOrder S{tile_e, ntiles, F.G, F.vcu, 256L * DEXP * 2, 256L * DEXP * 2, 1024L * DEXP * 2};
        EpiBf E{WSP(bf16_t, WS_XS), D};
        pg8::gemm_phase<EpiBf, MoeOrder, true>(F.lds, g, S, E);
    } SEAM(10);
    if (IN(11)) { phase6(F, I, x1); }
#undef IN
#undef SEAM
}

extern "C" void kernel_launch(void* const* d_in, const int* in_sizes, int n_in, void* d_out, int out_size, void* d_ws, size_t ws_size, hipStream_t stream) {
    static int grid = 0;
    if (grid == 0) {
        if (n_in != 32 || in_sizes[0] != M_LAT * D || out_size != M_LAT * D || ws_size < WS_END) {
            fprintf(stderr, "kernel_launch: unexpected problem (n_in %d, in0 %d, out %d, ws %zu < %zu?)\n", n_in, n_in > 0 ? in_sizes[0] : -1, out_size, ws_size, (size_t)WS_END); grid = -1; return; }
        int dev = 0, cus = 0, per_cu = 0;
        if (hipGetDevice(&dev) != hipSuccess || hipDeviceGetAttribute(&cus, hipDeviceAttributeMultiprocessorCount, dev) != hipSuccess) { grid = -1; return; }
        if (hipFuncSetAttribute((const void*)fwd_kernel, hipFuncAttributeMaxDynamicSharedMemorySize, LDS_BYTES) != hipSuccess) { fprintf(stderr, "kernel_launch: hipFuncSetAttribute failed\n"); grid = -1; return; }
        if (hipOccupancyMaxActiveBlocksPerMultiprocessor(&per_cu, (const void*)fwd_kernel, 512, LDS_BYTES) != hipSuccess || per_cu < 1) { fprintf(stderr, "kernel_launch: occupancy query says %d\n", per_cu); per_cu = 1; }
        (void)hipGetLastError();
        grid = cus;
    }
    if (grid < 0) return;
    (void)hipMemsetAsync((char*)d_ws + WS_CTL, 0, CTL_ZERO_BYTES, stream);
    Args a{};
    const float** ip = (const float**)&a.in;
    for (int i = 0; i < 32; ++i) ip[i] = (const float*)d_in[i];
    a.out = (float*)d_out; a.ws = (unsigned char*)d_ws;
#if MK_PER_PHASE
    for (int p = 0; p < N_PHASES; ++p) { a.ph_lo = p; a.ph_hi = p + 1; hipLaunchKernelGGL(fwd_kernel, dim3(grid), dim3(512), LDS_BYTES, stream, a); }
#else
    a.ph_lo = 0; a.ph_hi = N_PHASES;
    hipLaunchKernelGGL(fwd_kernel, dim3(grid), dim3(512), LDS_BYTES, stream, a);
#endif
}
```

```cpp
#include <hip/hip_runtime.h>
#include <cstdio>
#include <cstdint>

#define LAS __attribute__((address_space(3)))
#define GAS __attribute__((address_space(1)))
typedef unsigned short bf16_t;
typedef short bf16x8 __attribute__((ext_vector_type(8)));
typedef short s16x4 __attribute__((ext_vector_type(4)));
typedef float f32x4 __attribute__((ext_vector_type(4)));
typedef float f32x2 __attribute__((ext_vector_type(2)));
typedef unsigned u32x4 __attribute__((ext_vector_type(4)));
typedef unsigned u32x2 __attribute__((ext_vector_type(2)));
typedef GAS unsigned gu32;

constexpr int D = 1024, BATCH = 2, SEQ = 8192, CTXL = 256;
constexpr int M_LAT = BATCH * SEQ, M_CTX = BATCH * CTXL, M_ALL = M_LAT + M_CTX;
constexpr int IN_COLS = 9232, IG0 = 4096, HY0 = 4112, GA0 = 7184, GB0 = 8208;
constexpr int ZC = 9216;
constexpr int ZC_X0 = 4096, ZC_PAIR = 5120, ZC_GA = 7168, ZC_GB = 8192;
constexpr int N_IN = 9472;
constexpr int NEXP = 64, DEXP = 512;
constexpr float EPS = 1e-6f;
constexpr int MAX_TILES = 192, MAX_SLOTS = MAX_TILES * 256;

constexpr size_t MiB = 1u << 20;
constexpr size_t WS_CTL = 0, CTL_ZERO_BYTES = 1 * MiB;
constexpr size_t WS_MODS = 1 * MiB;
constexpr size_t WS_BIASP = WS_MODS + 81920;
constexpr size_t WS_CST = WS_MODS + 122880;
constexpr size_t WS_RSTD2 = WS_MODS + 131072;
constexpr size_t WS_ROUTE = WS_MODS + 262144;
constexpr size_t WS_TOKSLOT = WS_MODS + 524288;
constexpr size_t WS_BLKCNT = WS_MODS + 196608;
constexpr size_t WS_W72S = WS_MODS + 720896;
constexpr size_t WS_GATES = 2 * MiB;
constexpr size_t WS_SCG = 4 * MiB;
constexpr size_t WS_HID2 = 4 * MiB;
constexpr size_t WS_WIN_T = 8 * MiB;
constexpr size_t WS_WA2_T = 27 * MiB;
constexpr size_t WS_WB_T = 31 * MiB;
constexpr size_t WS_WOUT_T = 33 * MiB;
constexpr size_t WS_W3S = 35 * MiB;
constexpr size_t WS_H = 36 * MiB;
constexpr size_t WS_FSPEC = 70 * MiB;
constexpr int FS_PITCH = 8200;
constexpr size_t WS_SCM = 136 * MiB;
constexpr size_t WS_Z = 168 * MiB;
constexpr size_t WS_W13T = 168 * MiB;
constexpr size_t WS_W2T = 296 * MiB;
constexpr size_t WS_XS = 360 * MiB;
constexpr size_t WS_S0T = 466 * MiB;
constexpr size_t WS_QKC = WS_WIN_T;
constexpr size_t WS_FILT = 486 * MiB;
constexpr size_t WS_END = 518 * MiB;
static_assert(WS_Z + (size_t)M_ALL * ZC * 2 <= WS_END && WS_XS + (size_t)MAX_SLOTS * 1024 * 2 <= WS_END, "ws map");
static_assert(WS_FSPEC + (size_t)1024 * FS_PITCH * 8 <= WS_SCM && WS_H + (size_t)M_ALL * D * 2 <= WS_FSPEC, "ws map");
constexpr int CW_BAR = 4096;
constexpr int CW_CNT = 16384, CW_CUR = 16384 + 64;
constexpr int CW_Q0 = 16384 + 256, CW_Q1 = 16384 + 320;
constexpr int CW_SUB = 20480;

constexpr int LDS_BYTES = 160 * 1024;
constexpr int MISC_OFF = 159 * 1024;

#define RLX_AGENT __ATOMIC_RELAXED, __HIP_MEMORY_SCOPE_AGENT
__device__ __forceinline__ unsigned f2bf(float f) { unsigned u = __builtin_bit_cast(unsigned, f); return (u + 0x7fffu + ((u >> 16) & 1u)) >> 16; }
__device__ __forceinline__ unsigned pk2(float lo, float hi) { return f2bf(lo) | (f2bf(hi) << 16); }
__device__ __forceinline__ float bf2f(unsigned short u) { return __builtin_bit_cast(float, (unsigned)u << 16); }
__device__ __forceinline__ float bflo(unsigned w) { return __builtin_bit_cast(float, w << 16); }
__device__ __forceinline__ float bfhi(unsigned w) { return __builtin_bit_cast(float, w & 0xffff0000u); }
__device__ __forceinline__ float sigmoidf_(float x) { return __builtin_amdgcn_rcpf(1.0f + __expf(-x)); }
__device__ __forceinline__ float siluf_(float x) { return x * __builtin_amdgcn_rcpf(1.0f + __expf(-x)); }
__device__ __forceinline__ float wave_sum(float v) {
#pragma unroll
    for (int o = 1; o < 64; o <<= 1) v += __shfl_xor(v, o);
    return v;
}

template <int CTRL, int RM, bool BC> __device__ __forceinline__ float dppf(float old, float x) {
    return __builtin_bit_cast(float, __builtin_amdgcn_update_dpp(__builtin_bit_cast(int, old), __builtin_bit_cast(int, x), CTRL, RM, 0xf, BC)); }
__device__ __forceinline__ float wave_scan_sum(float x) {
    x += dppf<0x111, 0xf, true>(0.f, x); x += dppf<0x112, 0xf, true>(0.f, x); x += dppf<0x114, 0xf, true>(0.f, x); x += dppf<0x118, 0xf, true>(0.f, x);
    x += dppf<0x142, 0xa, false>(0.f, x); x += dppf<0x143, 0xc, false>(0.f, x); return x; }
__device__ __forceinline__ float wave_scan_max(float x) {
    const float ninf = -__builtin_inff();
    x = fmaxf(x, dppf<0x111, 0xf, false>(ninf, x)); x = fmaxf(x, dppf<0x112, 0xf, false>(ninf, x)); x = fmaxf(x, dppf<0x114, 0xf, false>(ninf, x)); x = fmaxf(x, dppf<0x118, 0xf, false>(ninf, x));
    x = fmaxf(x, dppf<0x142, 0xa, false>(ninf, x)); x = fmaxf(x, dppf<0x143, 0xc, false>(ninf, x)); return x; }
__device__ __forceinline__ float lane63(float x) { return __builtin_bit_cast(float, __builtin_amdgcn_readlane(__builtin_bit_cast(int, x), 63)); }

namespace pg8 {
#define PG8_LAS __attribute__((address_space(3)))
constexpr int BM = 256, BK = 64, HALF = 128, HTB = HALF * BK * 2, STAGE_BYTES = 8 * HTB, NXCD = 8, WGM = 8;
__host__ __device__ __forceinline__ int lds_byte(int r, int c) { const int st = (r >> 4) * 2 + (c >> 5), rr = r & 15, cc = c & 31, ob = rr * 64 + cc * 2; return st * 1024 + (ob ^ (((ob >> 9) & 1) << 5)); }
__host__ __device__ __forceinline__ void stage_rc(int b, int& R, int& C) { const int st = b / 1024, sb = b % 1024, swz = sb ^ (((sb >> 9) & 1) << 5); R = (st >> 1) * 16 + swz / 64; C = (st & 1) * 32 + (swz % 64) / 2; }
__host__ __device__ __forceinline__ int perm32(int rho) { const int n = rho >> 4, i = rho & 15; return 8 * (i >> 2) + 4 * n + (i & 3); }

struct Unit { long aoff, boff; int pm, pn, e, pad; };
struct Gemm { const bf16_t* A; const bf16_t* Bt; int lda, ldb, K; };

struct StaticOrder {
    int nM, nN, nwg, G, c; long astep, bstep;
    __device__ void init(int nM_, int nN_, int G_, int c_, long astep_, long bstep_) { nM = nM_; nN = nN_; nwg = nM * nN; G = G_; c = c_; astep = astep_; bstep = bstep_; }
    __device__ bool map(long L, Unit& u) const {
        if (L >= nwg) return false;
        int wgid = (int)L; { const int q = nwg / NXCD, r = nwg % NXCD, xcd = wgid % NXCD, off = wgid / NXCD; wgid = (xcd < r ? xcd * (q + 1) : r * (q + 1) + (xcd - r) * q) + off; }
        const int nig = WGM * nN, gid = wgid / nig, fm = gid * WGM, gsz = (nM - fm) < WGM ? (nM - fm) : WGM;
        u.pm = fm + ((wgid % nig) % gsz); u.pn = (wgid % nig) / gsz; u.e = 0; u.pad = 0; u.aoff = u.pm * astep; u.boff = u.pn * bstep; return true;
    }
    __device__ bool next(int i, Unit& u) const { return map((long)i * G + c, u); }
};

typedef __bf16 bf16v2_t __attribute__((ext_vector_type(2)));
__device__ __forceinline__ unsigned cvt_pk_bf16(float lo, float hi) { const bf16v2_t v = __builtin_convertvector((f32x2){lo, hi}, bf16v2_t); return __builtin_bit_cast(unsigned, v); }

template <class Epi, class Sched, bool ALIGN_EPI>
__device__ __forceinline__ void gemm_phase(PG8_LAS unsigned char* lds, const Gemm g, const Sched& S, const Epi& E) {
    const int tid = threadIdx.x, wid = __builtin_amdgcn_readfirstlane(tid >> 6), lane = tid & 63, wr = wid >> 2, wc = wid & 3, fr = lane & 15, fq = lane >> 4;
    const int K = g.K, nt = K / BK;
    unsigned voffA[2], voffB[2];
#pragma unroll
    for (int i = 0; i < 2; ++i) { int R, C; stage_rc(tid * 16 + i * 8192, R, C); const int Rb = Epi::PERM ? ((R & ~31) + perm32(R & 31)) : R;
        voffA[i] = (unsigned)(R * g.lda + C) * 2u; voffB[i] = (unsigned)(Rb * g.ldb + C) * 2u; }
    const size_t kstep = (size_t)(BK * 2);
    const size_t hstepA = (size_t)HALF * g.lda * 2, hstepB = (size_t)HALF * g.ldb * 2;
    const unsigned ldsw = (unsigned)wid * 1024u;
    const int aoff = lds_byte(wr * 64 + fr, fq * 8), boff = lds_byte(wc * 32 + fr, fq * 8);
#define PG8_SA(b, h) (((b) * 2 + (h)) * HTB)
#define PG8_SB(b, h) ((4 + (b) * 2 + (h)) * HTB)
#define PG8_STAGE(bufoff, gbase, voff) do { _Pragma("unroll") for (int _i = 0; _i < 2; ++_i) \
        __builtin_amdgcn_global_load_lds((const unsigned*)((const char*)(gbase) + (voff)[_i]), (PG8_LAS unsigned*)(lds + (bufoff) + ldsw + _i * 8192), 16, 0, 0); } while (0)
#define PG8_LDA(dst, b, h) do { _Pragma("unroll") for (int m = 0; m < 4; ++m) _Pragma("unroll") for (int k = 0; k < 2; ++k) dst[m][k] = *(const PG8_LAS bf16x8*)(lds + PG8_SA(b, h) + aoff + m * 2048 + k * 1024); } while (0)
#define PG8_LDB(dst, b, h) do { _Pragma("unroll") for (int n = 0; n < 2; ++n) _Pragma("unroll") for (int k = 0; k < 2; ++k) dst[n][k] = *(const PG8_LAS bf16x8*)(lds + PG8_SB(b, h) + boff + n * 2048 + k * 1024); } while (0)
#define PG8_MMA(ai, bj, At, Bt) do { __builtin_amdgcn_s_setprio(1); _Pragma("unroll") for (int m = 0; m < 4; ++m) _Pragma("unroll") for (int n = 0; n < 2; ++n) _Pragma("unroll") for (int k = 0; k < 2; ++k) \
        acc[ai][bj][m][n] = __builtin_amdgcn_mfma_f32_16x16x32_bf16(Bt[n][k], At[m][k], acc[ai][bj][m][n], 0, 0, 0); __builtin_amdgcn_s_setprio(0); } while (0)
#define PG8_WAIT_V(n) asm volatile("s_waitcnt vmcnt(" #n ")" ::: "memory")
#define PG8_WAIT_L(n) asm volatile("s_waitcnt lgkmcnt(" #n ")" ::: "memory")
#define PG8_BAR __builtin_amdgcn_s_barrier()
#define PG8_SCHED __builtin_amdgcn_sched_barrier(0)
    Unit cur, nxt; int ui = 0;
    if (!S.next(0, cur)) return;
    f32x4 acc[2][2][4][2];
#pragma unroll
    for (int a = 0; a < 2; ++a)
#pragma unroll
        for (int b = 0; b < 2; ++b)
#pragma unroll
            for (int m = 0; m < 4; ++m)
#pragma unroll
                for (int n = 0; n < 2; ++n) acc[a][b][m][n] = (f32x4){0.f, 0.f, 0.f, 0.f};
    bf16x8 At[4][2], B0[2][2], B1[2][2];
    const char* cA = (const char*)g.A + cur.aoff; const char* cB = (const char*)g.Bt + cur.boff;
    PG8_STAGE(PG8_SB(0, 0), cB, voffB); PG8_STAGE(PG8_SB(0, 1), cB + hstepB, voffB); PG8_STAGE(PG8_SA(0, 0), cA, voffA); PG8_STAGE(PG8_SA(0, 1), cA + hstepA, voffA);
    if (wr == 1) PG8_BAR;
    PG8_WAIT_V(2); PG8_BAR;
    PG8_STAGE(PG8_SB(1, 0), cB + kstep, voffB); PG8_STAGE(PG8_SA(1, 0), cA + kstep, voffA); PG8_STAGE(PG8_SB(1, 1), cB + hstepB + kstep, voffB);
    PG8_WAIT_V(6); PG8_BAR;
    for (;;) {
        const bool has_next = S.next(ui + 1, nxt);
        const char* nA = has_next ? (const char*)g.A + nxt.aoff : cA; const char* nB = has_next ? (const char*)g.Bt + nxt.boff : cB;
        for (int t = 0; t < nt; t += 2) {
            const bool last = (t == nt - 2);
            const char* a1 = cA + (size_t)(t + 1) * kstep;
            const char* a2 = last ? nA : cA + (size_t)(t + 2) * kstep; const char* b2 = last ? nB : cB + (size_t)(t + 2) * kstep;
            const char* a3 = a2 + kstep; const char* b3 = b2 + kstep;
            PG8_LDB(B0, 0, 0); PG8_LDB(B1, 0, 1); PG8_SCHED; PG8_LDA(At, 0, 0); PG8_STAGE(PG8_SA(1, 1), a1 + hstepA, voffA);
            PG8_WAIT_V(8); PG8_WAIT_L(0); PG8_BAR; PG8_MMA(0, 0, At, B0); PG8_MMA(0, 1, At, B1); PG8_BAR; PG8_SCHED;
            PG8_LDA(At, 0, 1); PG8_STAGE(PG8_SB(0, 0), b2, voffB); PG8_STAGE(PG8_SB(0, 1), b2 + hstepB, voffB); PG8_STAGE(PG8_SA(0, 0), a2, voffA);
            PG8_WAIT_V(8); PG8_WAIT_L(0); PG8_BAR; PG8_MMA(1, 0, At, B0); PG8_MMA(1, 1, At, B1); PG8_BAR; PG8_SCHED;
            PG8_LDB(B0, 1, 0); PG8_LDB(B1, 1, 1); PG8_SCHED; PG8_LDA(At, 1, 0); PG8_STAGE(PG8_SA(0, 1), a2 + hstepA, voffA);
            PG8_WAIT_V(8); PG8_WAIT_L(0); PG8_BAR; PG8_MMA(0, 0, At, B0); PG8_MMA(0, 1, At, B1); PG8_BAR; PG8_SCHED;
            PG8_LDA(At, 1, 1); PG8_STAGE(PG8_SB(1, 0), b3, voffB); PG8_STAGE(PG8_SB(1, 1), b3 + hstepB, voffB); PG8_STAGE(PG8_SA(1, 0), a3, voffA);
            PG8_WAIT_V(8); PG8_WAIT_L(0); PG8_BAR; PG8_MMA(1, 0, At, B0); PG8_MMA(1, 1, At, B1); PG8_BAR; PG8_SCHED;
        }
        if constexpr (ALIGN_EPI) { if (wr == 0) PG8_BAR; }
        E(acc, cur, wr, wc, fr, fq);
        if (!has_next) break;
#pragma unroll
        for (int a = 0; a < 2; ++a)
#pragma unroll
            for (int b = 0; b < 2; ++b)
#pragma unroll
                for (int m = 0; m < 4; ++m)
#pragma unroll
                    for (int n = 0; n < 2; ++n) acc[a][b][m][n] = (f32x4){0.f, 0.f, 0.f, 0.f};
        cur = nxt; cA = nA; cB = nB; ++ui;
        if constexpr (ALIGN_EPI) { if (wr == 1) PG8_BAR; }
    }
    PG8_WAIT_V(0);
    if constexpr (!ALIGN_EPI) { if (wr == 0) PG8_BAR; }
    PG8_BAR;
#undef PG8_SA
#undef PG8_SB
#undef PG8_STAGE
#undef PG8_LDA
#undef PG8_LDB
#undef PG8_MMA
#undef PG8_WAIT_V
#undef PG8_WAIT_L
#undef PG8_BAR
#undef PG8_SCHED
}
}

#define XB_TMO      128
#define XB_XCNT(j)  (256  + 64 * (j))
#define XB_XSUB(j)  (1280 + 64 * (j))
#define XB_XGEN(j)  (2304 + 64 * (j))
#define XB_TOP      3328
#define XB_TOPGEN   3392
#define XCD_BAR_WORDS 3456
#define XB_SPIN_CAP (1u << 18)
__device__ __forceinline__ unsigned xb_ld(unsigned* p)              { return __hip_atomic_load(p, __ATOMIC_RELAXED, __HIP_MEMORY_SCOPE_AGENT); }
__device__ __forceinline__ unsigned xb_add(unsigned* p, unsigned v) { return __hip_atomic_fetch_add(p, v, __ATOMIC_RELAXED, __HIP_MEMORY_SCOPE_AGENT); }
__device__ __forceinline__ unsigned xb_xcc_id() { return (unsigned)__builtin_amdgcn_s_getreg((3 << 11) | 20) & 0xFu; }
#define XB_SPIN(cond, bar) do { unsigned _sp = 0; while (cond) { __builtin_amdgcn_s_sleep(1); \
    if ((++_sp & 255u) == 0u) { if (xb_ld(&(bar)[XB_TMO])) break; if (_sp > XB_SPIN_CAP) { atomicAdd(&(bar)[XB_TMO], 1u); break; } } } } while (0)
struct XcdBarrier { unsigned* bar; unsigned x; volatile LAS unsigned* st; };
__device__ __forceinline__ XcdBarrier xcd_barrier_post(unsigned* bar, volatile LAS unsigned* st) {
    XcdBarrier b; b.bar = bar; b.x = xb_xcc_id(); b.st = st;
    if (threadIdx.x == 0) (void)xb_add(&bar[XB_XCNT(b.x)], 1u);
    return b;
}
__device__ __forceinline__ void xcd_barrier_complete(unsigned* bar, unsigned x, unsigned& nloc, unsigned& nx) {
    const unsigned G = gridDim.x * gridDim.y * gridDim.z;
    unsigned sum, cnt, mine, sp = 0u;
    for (;;) {
        sum = 0u; cnt = 0u; mine = 0u;
#pragma unroll
        for (unsigned j = 0; j < 16; ++j) { const unsigned c = xb_ld(&bar[XB_XCNT(j)]); sum += c; cnt += (c > 0u) ? 1u : 0u; mine = (j == x) ? c : mine; }
        if (sum == G) break;
        __builtin_amdgcn_s_sleep(1);
        if ((++sp & 255u) == 0u) { if (xb_ld(&bar[XB_TMO])) break; if (sp > XB_SPIN_CAP) { atomicAdd(&bar[XB_TMO], 1u); break; } }
    }
    nloc = mine > 0u ? mine : 1u; nx = cnt > 0u ? cnt : 1u;
}
__device__ __forceinline__ void xcd_barrier(const XcdBarrier& b) {
    asm volatile("s_waitcnt vmcnt(0)" ::: "memory");
    __syncthreads();
    if (threadIdx.x == 0) {
        unsigned* bar = b.bar;
        __builtin_amdgcn_s_waitcnt(0);
        unsigned nloc = b.st[0], nx = b.st[1];
        if (nloc == 0u) { xcd_barrier_complete(bar, b.x, nloc, nx); b.st[0] = nloc; b.st[1] = nx; }
        const unsigned old = xb_add(&bar[XB_XSUB(b.x)], 1u);
        const unsigned gen = old / nloc;
        if (old + 1u == (gen + 1u) * nloc) {
            __builtin_amdgcn_fence(__ATOMIC_RELEASE, "agent");
            asm volatile("s_waitcnt vmcnt(0)" ::: "memory");
            const unsigned og = xb_add(&bar[XB_TOP], 1u);
            const unsigned tg = og / nx;
            if (og + 1u == (tg + 1u) * nx) xb_add(&bar[XB_TOPGEN], 1u);
            else XB_SPIN(xb_ld(&bar[XB_TOPGEN]) == tg, bar);
            __builtin_amdgcn_fence(__ATOMIC_ACQUIRE, "agent");
            xb_add(&bar[XB_XGEN(b.x)], 1u);
            asm volatile("s_waitcnt vmcnt(0)" ::: "memory");
        } else {
            XB_SPIN(xb_ld(&bar[XB_XGEN(b.x)]) == gen, bar);
            __builtin_amdgcn_fence(__ATOMIC_ACQUIRE, "agent");
            asm volatile("s_waitcnt vmcnt(0)" ::: "memory");
        }
    }
    __syncthreads();
}

__device__ __forceinline__ void subgrid_barrier(unsigned* cnt, unsigned n, unsigned round) {
    asm volatile("s_waitcnt vmcnt(0)" ::: "memory");
    __syncthreads();
    if (threadIdx.x == 0) {
        __builtin_amdgcn_fence(__ATOMIC_RELEASE, "agent");
        asm volatile("s_waitcnt vmcnt(0)" ::: "memory");
        xb_add(cnt, 1u);
        unsigned sp = 0;
        while (xb_ld(cnt) < n * round) { __builtin_amdgcn_s_sleep(2); if (++sp > (1u << 22)) break; }
        __builtin_amdgcn_fence(__ATOMIC_ACQUIRE, "agent");
        asm volatile("s_waitcnt vmcnt(0)" ::: "memory");
    }
    __syncthreads();
}

struct Inputs {
    const float *x, *c, *ctx, *c_ctx, *w_mod, *b_mod, *g_norm1, *g_norm2, *w_in, *b_in, *w_qk_conv, *b_qk_conv, *w_h_conv, *b_h_conv,
        *hf_w1, *hf_b1, *hf_w2, *hf_b2, *hf_w3, *hf_freq, *h_bias, *w_a, *w_b, *w_out, *w_group, *b_group, *w_router, *b_router, *w1_e, *w3_e, *w2_e, *g_final;
};
struct Args { Inputs in; float* out; unsigned char* ws; int ph_lo, ph_hi; };
struct Frame {
    LAS unsigned char* lds;
    int tid, lane, wave, vcu, G;
    unsigned char* ws;
};
#define WSP(T, off) ((T*)(F.ws + (off)))

__device__ __forceinline__ int win_src(int rho) {
    if (rho < 4096) return rho;
    if (rho < ZC_PAIR) return HY0 + (rho - ZC_X0);
    if (rho < ZC_GA) { const int t = rho - ZC_PAIR, p = t >> 8, bj = (t >> 7) & 1, j = t & 127; return HY0 + 1024 + bj * 1024 + 128 * p + j; }
    if (rho < ZC_GB) return GA0 + (rho - ZC_GA);
    if (rho < ZC) return GB0 + (rho - ZC_GB);
    if (rho < ZC + 16) return IG0 + (rho - ZC);
    return -1;
}
template <class SrcCol>
__device__ __forceinline__ void transpose_item(const float* W, int N, int k0, SrcCol scol, bf16_t* WT, int ldt, int drow0, int kdst, LAS float* scr, int lane) {
    const int sc = scol(lane & 31);
#pragma unroll 16
    for (int i = 0; i < 32; ++i) { const int kk = 2 * i + (lane >> 5); scr[kk * 33 + (lane & 31)] = sc >= 0 ? W[(size_t)(k0 + kk) * N + sc] : 0.f; }
    asm volatile("s_waitcnt lgkmcnt(0)" ::: "memory");
    const int c = lane & 7;
#pragma unroll
    for (int j = 0; j < 4; ++j) { const int n = (lane >> 3) + 8 * j; const LAS float* s = scr + (8 * c) * 33 + n;
        u32x4 o; o.x = pk2(s[0 * 33], s[1 * 33]); o.y = pk2(s[2 * 33], s[3 * 33]); o.z = pk2(s[4 * 33], s[5 * 33]); o.w = pk2(s[6 * 33], s[7 * 33]);
        *(u32x4*)(WT + (size_t)(drow0 + n) * ldt + kdst + 8 * c) = o; }
    asm volatile("s_waitcnt lgkmcnt(0)" ::: "memory");
}


__device__ __forceinline__ void weight_transposes(Frame& F, const Inputs& I, int which, int wg, int nwg) {
    LAS float* scr = (LAS float*)(F.lds + F.wave * 16384);
    const int gw = wg * 8 + F.wave, NGW = nwg * 8;
    {
        constexpr int I_IN = (D / 64) * (N_IN / 32), I_SQ = (D / 64) * (D / 32);
        const int lo = which == 0 ? 0 : I_IN, hi = which == 0 ? I_IN : I_IN + 3 * I_SQ;
        for (int it = lo + gw; it < hi; it += NGW) {
            int r = it;
            if (r < I_IN) { const int nblk = N_IN / 32, kb = r / nblk, nb = r % nblk;
                transpose_item(I.w_in, IN_COLS, 64 * kb, [&](int i) { return win_src(32 * nb + i); }, WSP(bf16_t, WS_WIN_T), D, 32 * nb, 64 * kb, scr, F.lane); continue; }
            r -= I_IN;
            const int m = r / I_SQ, rr = r % I_SQ, kb = rr / 32, nb = rr % 32;
            if (m == 0) { transpose_item(I.w_a, D, 64 * kb, [&](int i) { return 32 * nb + i; }, WSP(bf16_t, WS_WA2_T), 2 * D, 32 * nb, 64 * kb, scr, F.lane);
                          transpose_item(I.w_a, D, 64 * kb, [&](int i) { return 32 * nb + i; }, WSP(bf16_t, WS_WA2_T), 2 * D, 32 * nb, D + 64 * kb, scr, F.lane); }
            else if (m == 1) transpose_item(I.w_b, D, 64 * kb, [&](int i) { return 32 * nb + i; }, WSP(bf16_t, WS_WB_T), D, 32 * nb, 64 * kb, scr, F.lane);
            else transpose_item(I.w_out, D, 64 * kb, [&](int i) { return 32 * nb + i; }, WSP(bf16_t, WS_WOUT_T), D, 32 * nb, 64 * kb, scr, F.lane);
        }
    }
    __syncthreads();
}
__device__ __forceinline__ void phase0(Frame& F, const Inputs& I) {
    LAS float* scr = (LAS float*)(F.lds + F.wave * 16384);
    const int gw = F.vcu * 8 + F.wave, NGW = F.G * 8;
    {
        LAS float* red = (LAS float*)F.lds;
        LAS float* sl = red + 8 * 3 * 32;
        float* mods = WSP(float, WS_MODS);
        for (int i = F.tid; i < 3 * 1024; i += 512) { const int v = i >> 10, k = i & 1023; sl[i] = siluf_(v == 0 ? I.c[k] : v == 1 ? I.c[D + k] : I.c_ctx[k]); }
        __syncthreads();
        for (int it = F.vcu; it < 256; it += F.G) {
            const int col = F.lane & 31, kr = F.lane >> 5, n = it * 24 + col; const bool act = col < 24;
            float a0 = 0.f, a1 = 0.f, a2 = 0.f;
#pragma unroll 16
            for (int i = 0; i < 64; ++i) { const int k = F.wave * 128 + 2 * i + kr; const float w = act ? I.w_mod[(size_t)k * 6144 + n] : 0.f;
                a0 += sl[k] * w; a1 += sl[1024 + k] * w; a2 += sl[2048 + k] * w; }
            a0 += __shfl_xor(a0, 32); a1 += __shfl_xor(a1, 32); a2 += __shfl_xor(a2, 32);
            if (F.lane < 32) { red[(F.wave * 3 + 0) * 32 + col] = a0; red[(F.wave * 3 + 1) * 32 + col] = a1; red[(F.wave * 3 + 2) * 32 + col] = a2; }
            __syncthreads();
            if (F.tid < 96) { const int v = F.tid >> 5, l = F.tid & 31; float s = 0.f;
#pragma unroll
                for (int w = 0; w < 8; ++w) s += red[(w * 3 + v) * 32 + l];
                if (l < 24) mods[v * 6144 + it * 24 + l] = s + I.b_mod[it * 24 + l]; }
            __syncthreads();
        }
    }
    __syncthreads();
    for (int i = F.vcu * 512 + F.tid; i < N_IN; i += F.G * 512) { const int s = win_src(i); WSP(float, WS_BIASP)[i] = s >= 0 ? I.b_in[s] : 0.f; }
    for (int i = F.vcu * 512 + F.tid; i < 80 * 2048; i += F.G * 512) { const int col = i >> 11, which = (i >> 10) & 1, k = i & 1023;
        const float v = col < 8 ? I.w_group[k * 8 + col] : col < 72 ? I.w_router[k * 64 + (col - 8)] : 0.f;
        const unsigned hi = f2bf(v); WSP(bf16_t, WS_W72S)[i] = (bf16_t)(which ? f2bf(v - bf2f((unsigned short)hi)) : hi); }
    {
        bf16_t* hids = WSP(bf16_t, WS_HID2);
        const int j = F.lane;
        const float fr = I.hf_freq[j], b1 = I.hf_b1[j], b2 = I.hf_b2[j];
        for (int pos = gw; pos < SEQ; pos += NGW) {
            const float t = (float)pos / (float)(SEQ - 1);
            float a = b1 + t * I.hf_w1[0 * 64 + j];
#pragma unroll 4
            for (int i = 0; i < 16; ++i) { const float band = 1e-4f + (float)i * ((15.0f - 1e-4f) / 15.0f);
                const float rev = ((float)pos * (1.0f / (float)SEQ)) * band;
                const float sn = __builtin_amdgcn_sinf(rev), cs = __builtin_amdgcn_cosf(rev);
                a += cs * I.hf_w1[(1 + i) * 64 + j] - sn * I.hf_w1[(17 + i) * 64 + j]; }
            const float h1 = __builtin_amdgcn_sinf(fr * a * 0.15915494309189535f);
            float a2 = b2;
#pragma unroll 8
            for (int i = 0; i < 64; ++i) a2 += __shfl(h1, i) * I.hf_w2[i * 64 + j];
            const float h2 = __builtin_amdgcn_sinf(fr * a2 * 0.15915494309189535f);
            const unsigned hi = f2bf(h2), lo = f2bf(h2 - bf2f((unsigned short)hi));
            bf16_t* hp = hids + (size_t)pos * 256;
            hp[j] = (bf16_t)hi; hp[64 + j] = (bf16_t)hi; hp[128 + j] = (bf16_t)lo; hp[192 + j] = 0;
        }
        bf16_t* w3s = WSP(bf16_t, WS_W3S);
        for (int i = F.vcu * 512 + F.tid; i < 2048 * 64; i += F.G * 512) { const int h = i >> 11, col = i & 2047;
            const float wv = I.hf_w3[i]; const unsigned hi = f2bf(wv), lo = f2bf(wv - bf2f((unsigned short)hi));
            bf16_t* wp = w3s + (size_t)col * 256;
            wp[h] = (bf16_t)hi; wp[64 + h] = (bf16_t)lo; wp[128 + h] = (bf16_t)hi; wp[192 + h] = 0; }
    }
}

constexpr int FFT_N = 16384;
__device__ __forceinline__ int PADI(int i) { return i + (i >> 5); }
__device__ __forceinline__ constexpr int bitrev(int x, int bits) { int r = 0; for (int i = 0; i < bits; ++i) r = (r << 1) | ((x >> i) & 1); return r; }
template <int R, int LOG2R>
__device__ __forceinline__ void dft_dif(f32x2 (&v)[R]) {
    constexpr float C32[16] = {1.000000000e+00f, 9.807852804e-01f, 9.238795325e-01f, 8.314696123e-01f, 7.071067812e-01f, 5.555702330e-01f, 3.826834324e-01f, 1.950903220e-01f,
                               0.0f, -1.950903220e-01f, -3.826834324e-01f, -5.555702330e-01f, -7.071067812e-01f, -8.314696123e-01f, -9.238795325e-01f, -9.807852804e-01f};
    constexpr float S32[16] = {0.0f, 1.950903220e-01f, 3.826834324e-01f, 5.555702330e-01f, 7.071067812e-01f, 8.314696123e-01f, 9.238795325e-01f, 9.807852804e-01f,
                               1.0f, 9.807852804e-01f, 9.238795325e-01f, 8.314696123e-01f, 7.071067812e-01f, 5.555702330e-01f, 3.826834324e-01f, 1.950903220e-01f};
#pragma unroll
    for (int st = 0; st < LOG2R; ++st) {
        const int half = R >> (st + 1);
#pragma unroll
        for (int blk = 0; blk < R; blk += 2 * half)
#pragma unroll
            for (int i = 0; i < half; ++i) {
                const f32x2 a = v[blk + i], b = v[blk + i + half];
                v[blk + i] = a + b;
                const f32x2 t = a - b;
                const int ti = i * (16 / half);
                if (ti == 0) v[blk + i + half] = t;
                else if (ti == 8) v[blk + i + half] = (f32x2){t.y, -t.x};
                else { const float c = C32[ti], s = S32[ti]; v[blk + i + half] = (f32x2){t.x * c + t.y * s, t.y * c - t.x * s}; }
            }
    }
}
__device__ __forceinline__ f32x2 cmul(f32x2 a, f32x2 b) { return (f32x2){a.x * b.x - a.y * b.y, a.x * b.y + a.y * b.x}; }
__device__ __forceinline__ f32x2 twid(float frac) { return (f32x2){__builtin_amdgcn_cosf(frac), -__builtin_amdgcn_sinf(frac)}; }
__device__ __forceinline__ void fft_pass_a_store(f32x2 (&v)[32], LAS f32x2* X, int j) {
    dft_dif<32, 5>(v);
    int jq = j; asm volatile("" : "+v"(jq));
    LAS f32x2* xb = X + 33 * jq;
#pragma unroll
    for (int p = 0; p < 32; ++p) xb[bitrev(p, 5)] = v[p];
}
__device__ __forceinline__ void fft_load32(f32x2 (&v)[32], const LAS f32x2* X, int j) {
    int jq = j; asm volatile("" : "+v"(jq));
    const LAS f32x2* xb = X + jq + (jq >> 5);
#pragma unroll
    for (int r = 0; r < 32; ++r) v[r] = xb[528 * r];
}
constexpr int TW_OFF = 144 * 1024;
__device__ __forceinline__ void fft_twiddle_init(LAS unsigned char* lds, int tid) {
    LAS f32x2* T = (LAS f32x2*)(lds + TW_OFF);
    for (int m = tid; m < 1024; m += 512) T[m] = twid((float)m * (1.0f / 1024.0f));
}
__device__ __forceinline__ void fft_pass_b(LAS f32x2* X, int j) {
    f32x2 v[32]; fft_load32(v, X, j);
    int jo = j; asm volatile("" : "+v"(jo));
    const int k = jo & 31;
    j = jo;
    const LAS f32x2* T = (const LAS f32x2*)((const LAS unsigned char*)X + TW_OFF) + k;
#pragma unroll
    for (int r = 1; r < 32; ++r) v[r] = cmul(v[r], T[(r - 1) * k]);
    dft_dif<32, 5>(v);
    __syncthreads();
    LAS f32x2* xb = X + (j >> 5) * 1056 + k;
#pragma unroll
    for (int p = 0; p < 32; ++p) xb[33 * bitrev(p, 5)] = v[p];
}
__device__ __forceinline__ void fft_pass_c_compute(f32x2 (&v)[32], const LAS f32x2* X, int tid) {
#pragma unroll
    for (int u = 0; u < 2; ++u) {
        int jj = tid + 512 * u; asm volatile("" : "+v"(jj)); f32x2 w[16];
#pragma unroll
        for (int r = 0; r < 16; ++r) w[r] = X[jj + (jj >> 5) + 1056 * r];
        const float f1 = (float)jj * (1.0f / 16384.0f);
#pragma unroll
        for (int r = 1; r < 16; ++r) w[r] = cmul(w[r], twid((float)r * f1));
        dft_dif<16, 4>(w);
#pragma unroll
        for (int p = 0; p < 16; ++p) v[16 * u + p] = w[p];
    }
}

__device__ __forceinline__ void filter_spec_item(Frame& F, const Inputs& I, int pair) {
    const int c = 2 * pair, tid = F.tid;
    LAS f32x2* X = (LAS f32x2*)F.lds;
    LAS float* red = (LAS float*)(F.lds + 140 * 1024);
    const _Float16* filt = WSP(_Float16, WS_FILT);
    float ss0 = 0.f, ss1 = 0.f;
    for (int i = 0; i < 16; ++i) {
        const int lag = tid + 512 * i;
        const float f0 = (float)filt[(size_t)c * SEQ + lag], f1 = (float)filt[(size_t)(c + 1) * SEQ + lag], g0 = (float)filt[(size_t)(1024 + c) * SEQ + lag], g1 = (float)filt[(size_t)(1025 + c) * SEQ + lag];
        X[PADI(lag)] = (f32x2){f0, f1}; ss0 += f0 * f0; ss1 += f1 * f1;
        if (lag >= 1) { X[PADI(FFT_N - lag)] = (f32x2){g0, g1}; ss0 += g0 * g0; ss1 += g1 * g1; }
    }
    if (tid == 0) X[PADI(8192)] = (f32x2){0.f, 0.f};
    ss0 = wave_sum(ss0); ss1 = wave_sum(ss1);
    if (F.lane == 0) { red[F.wave * 2] = ss0; red[F.wave * 2 + 1] = ss1; }
    __syncthreads();
    float t0 = 0.f, t1 = 0.f;
#pragma unroll
    for (int w = 0; w < 8; ++w) { t0 += red[2 * w]; t1 += red[2 * w + 1]; }
    const float sc0 = (1.0f / sqrtf(t0 + EPS)) * (1.0f / 16384.0f), sc1 = (1.0f / sqrtf(t1 + EPS)) * (1.0f / 16384.0f);
    {   f32x2 v[32]; fft_load32(v, X, tid); __syncthreads(); fft_pass_a_store(v, X, tid); }
    __syncthreads();
    fft_pass_b(X, tid);
    __syncthreads();
    {   f32x2 v[32]; fft_pass_c_compute(v, X, tid); __syncthreads();
#pragma unroll
        for (int u = 0; u < 2; ++u) { int jj = tid + 512 * u; asm volatile("" : "+v"(jj)); LAS f32x2* xb = X + jj + (jj >> 5);
#pragma unroll
            for (int p = 0; p < 16; ++p) xb[1056 * bitrev(p, 4)] = v[16 * u + p]; } }
    __syncthreads();
    f32x2* fs = WSP(f32x2, WS_FSPEC);
    for (int k = tid; k <= 8192; k += 512) {
        const f32x2 zk = X[PADI(k)], zn = X[PADI((FFT_N - k) & (FFT_N - 1))];
        fs[(size_t)c * FS_PITCH + k] = (f32x2){0.5f * (zk.x + zn.x) * sc0, 0.5f * (zk.y - zn.y) * sc0};
        fs[(size_t)(c + 1) * FS_PITCH + k] = (f32x2){0.5f * (zk.y + zn.y) * sc1, -0.5f * (zk.x - zn.x) * sc1};
    }
    __syncthreads();
}
__device__ __forceinline__ void phase0b(Frame& F, const Inputs& I) {
    const int gw = F.vcu * 8 + F.wave, NGW = F.G * 8;
    const float* mods = WSP(float, WS_MODS);
    {
        bf16_t* H = WSP(bf16_t, WS_H);
        for (int row = gw; row < M_ALL; row += NGW) {
            const float* src = row < M_LAT ? I.x + (size_t)row * D : I.ctx + (size_t)(row - M_LAT) * D;
            const float* md = mods + (row < M_LAT ? row / SEQ : 2) * 6144;
            const f32x4* xr = (const f32x4*)src + F.lane;
            f32x4 v[4]; float s = 0.f;
#pragma unroll
            for (int j = 0; j < 4; ++j) { v[j] = xr[64 * j]; s += (v[j].x * v[j].x + v[j].y * v[j].y) + (v[j].z * v[j].z + v[j].w * v[j].w); }
            const float rstd = 1.0f / sqrtf(wave_sum(s) * (1.0f / D) + EPS);
            u32x2* o8 = (u32x2*)(H + (size_t)row * D) + F.lane;
#pragma unroll
            for (int j = 0; j < 4; ++j) { const int k = 4 * F.lane + 256 * j;
                const f32x4 g = *(const f32x4*)(I.g_norm1 + k), sh = *(const f32x4*)(md + k), sc = *(const f32x4*)(md + 1024 + k);
                const f32x4 h = v[j] * rstd * g * (sc + 1.0f) + sh;
                o8[64 * j] = (u32x2){pk2(h.x, h.y), pk2(h.z, h.w)}; }
        }
    }
    for (int it = gw; it < 144; it += NGW) { const int b = it / 72, j = it % 72; const float* sh2 = mods + b * 6144 + 3 * 1024;
        float s = 0.f;
        for (int k = F.lane; k < 1024; k += 64) s += sh2[k] * (j < 8 ? I.w_group[k * 8 + j] : I.w_router[k * 64 + (j - 8)]);
        s = wave_sum(s);
        if (F.lane == 0) WSP(float, WS_CST)[it] = s + (j < 8 ? I.b_group[j] : I.b_router[j - 8]); }
}

using pg8::Unit; using pg8::cvt_pk_bf16;
struct EpiIn {
    static constexpr bool PERM = true;
    bf16_t* Z; const float* bias; float* gates;
    __device__ __forceinline__ void operator()(const f32x4 (&acc)[2][2][4][2], const Unit& u, int wr, int wc, int fr, int fq) const {
        const int row0 = u.pm * 256 + wr * 64 + fr;
        if (u.pn == 36) {
            if (wc == 0 && fq < 2) {
                const f32x4 b0 = *(const f32x4*)(bias + ZC + 8 * fq), b1 = *(const f32x4*)(bias + ZC + 8 * fq + 4);
#pragma unroll
                for (int ai = 0; ai < 2; ++ai)
#pragma unroll
                    for (int m = 0; m < 4; ++m) { float* gp = gates + (size_t)(row0 + ai * 128 + m * 16) * 16 + 8 * fq;
                        *(f32x4*)gp = acc[ai][0][m][0] + b0; *(f32x4*)(gp + 4) = acc[ai][0][m][1] + b1; }
            }
            return;
        }
        const int col0 = u.pn * 256 + wc * 32 + 8 * fq;
        f32x4 bv[2][2];
#pragma unroll
        for (int bj = 0; bj < 2; ++bj)
#pragma unroll
            for (int n = 0; n < 2; ++n) bv[bj][n] = *(const f32x4*)(bias + col0 + bj * 128 + 4 * n);
#pragma unroll
        for (int ai = 0; ai < 2; ++ai)
#pragma unroll
            for (int m = 0; m < 4; ++m) { bf16_t* rowp = Z + (size_t)(row0 + ai * 128 + m * 16) * ZC + col0;
#pragma unroll
                for (int bj = 0; bj < 2; ++bj) { const f32x4 v0 = acc[ai][bj][m][0] + bv[bj][0], v1 = acc[ai][bj][m][1] + bv[bj][1];
                    u32x4 w; w.x = cvt_pk_bf16(v0[0], v0[1]); w.y = cvt_pk_bf16(v0[2], v0[3]); w.z = cvt_pk_bf16(v1[0], v1[1]); w.w = cvt_pk_bf16(v1[2], v1[3]);
                    *(u32x4*)(rowp + bj * 128) = w; } }
    }
};
template <bool STEP_B> struct EpiMerge {
    static constexpr bool PERM = true;
    const bf16_t* Zg; bf16_t* T1; bf16_t* G;
    __device__ __forceinline__ void operator()(const f32x4 (&acc)[2][2][4][2], const Unit& u, int wr, int wc, int fr, int fq) const {
        const int row0 = u.pm * 256 + wr * 64 + fr, col0 = u.pn * 256 + wc * 32 + 8 * fq;
#pragma unroll
        for (int ai = 0; ai < 2; ++ai)
#pragma unroll
            for (int m = 0; m < 4; ++m) { const size_t row = (size_t)(row0 + ai * 128 + m * 16);
#pragma unroll
                for (int bj = 0; bj < 2; ++bj) {
                    const int col = col0 + bj * 128;
                    const u32x4 gw = *(const u32x4*)(Zg + row * ZC + col);
                    f32x4 g0 = {sigmoidf_(bflo(gw.x)), sigmoidf_(bfhi(gw.x)), sigmoidf_(bflo(gw.y)), sigmoidf_(bfhi(gw.y))};
                    f32x4 g1 = {sigmoidf_(bflo(gw.z)), sigmoidf_(bfhi(gw.z)), sigmoidf_(bflo(gw.w)), sigmoidf_(bfhi(gw.w))};
                    f32x4 v0 = g0 * acc[ai][bj][m][0], v1 = g1 * acc[ai][bj][m][1];
                    bf16_t* tp = T1 + row * D + col;
                    if constexpr (!STEP_B) { u32x4 w; w.x = cvt_pk_bf16(v0[0], v0[1]); w.y = cvt_pk_bf16(v0[2], v0[3]); w.z = cvt_pk_bf16(v1[0], v1[1]); w.w = cvt_pk_bf16(v1[2], v1[3]); *(u32x4*)tp = w; }
                    else { const u32x4 t = *(const u32x4*)tp;
                        v0 += (f32x4){bflo(t.x), bfhi(t.x), bflo(t.y), bfhi(t.y)}; v1 += (f32x4){bflo(t.z), bfhi(t.z), bflo(t.w), bfhi(t.w)};
                        u32x4 w; w.x = cvt_pk_bf16(v0[0], v0[1]); w.y = cvt_pk_bf16(v0[2], v0[3]); w.z = cvt_pk_bf16(v1[0], v1[1]); w.w = cvt_pk_bf16(v1[2], v1[3]);
                        *(u32x4*)(G + row * D + col) = w; }
                } }
    }
};
struct EpiRes {
    static constexpr bool PERM = false;
    const float* x; const float* mods; float* out;
    __device__ __forceinline__ void operator()(const f32x4 (&acc)[2][2][4][2], const Unit& u, int wr, int wc, int fr, int fq) const {
        const int row0 = u.pm * 256 + wr * 64 + fr, col0 = u.pn * 256 + wc * 32 + 4 * fq;
        const float* gate = mods + (u.pm * 256 / SEQ) * 6144 + 2 * 1024;
        f32x4 gv[2][2];
#pragma unroll
        for (int bj = 0; bj < 2; ++bj)
#pragma unroll
            for (int n = 0; n < 2; ++n) gv[bj][n] = *(const f32x4*)(gate + col0 + bj * 128 + n * 16);
#pragma unroll
        for (int ai = 0; ai < 2; ++ai)
#pragma unroll
            for (int m = 0; m < 4; ++m) { const size_t off = (size_t)(row0 + ai * 128 + m * 16) * D + col0;
#pragma unroll
                for (int bj = 0; bj < 2; ++bj)
#pragma unroll
                    for (int n = 0; n < 2; ++n) *(f32x4*)(out + off + bj * 128 + n * 16) = *(const f32x4*)(x + off + bj * 128 + n * 16) + gv[bj][n] * acc[ai][bj][m][n]; }
    }
};
struct EpiMoe1 {
    static constexpr bool PERM = true;
    bf16_t* H2;
    __device__ __forceinline__ void operator()(const f32x4 (&acc)[2][2][4][2], const Unit& u, int wr, int wc, int fr, int fq) const {
        const int row0 = u.pm * 256 + wr * 64 + fr, col0 = u.pn * 128 + wc * 32 + 8 * fq;
#pragma unroll
        for (int ai = 0; ai < 2; ++ai)
#pragma unroll
            for (int m = 0; m < 4; ++m) { const size_t row = (size_t)(row0 + ai * 128 + m * 16);
                f32x4 v0, v1;
#pragma unroll
                for (int i = 0; i < 4; ++i) { v0[i] = siluf_(acc[ai][0][m][0][i]) * acc[ai][1][m][0][i]; v1[i] = siluf_(acc[ai][0][m][1][i]) * acc[ai][1][m][1][i]; }
                u32x4 w; w.x = cvt_pk_bf16(v0[0], v0[1]); w.y = cvt_pk_bf16(v0[2], v0[3]); w.z = cvt_pk_bf16(v1[0], v1[1]); w.w = cvt_pk_bf16(v1[2], v1[3]);
                *(u32x4*)(H2 + row * DEXP + col0) = w; }
    }
};
struct EpiBf {
    static constexpr bool PERM = true;
    bf16_t* O; int ldo;
    __device__ __forceinline__ void operator()(const f32x4 (&acc)[2][2][4][2], const Unit& u, int wr, int wc, int fr, int fq) const {
        const int row0 = u.pm * 256 + wr * 64 + fr, col0 = u.pn * 256 + wc * 32 + 8 * fq;
#pragma unroll
        for (int ai = 0; ai < 2; ++ai)
#pragma unroll
            for (int m = 0; m < 4; ++m) { bf16_t* rowp = O + (size_t)(row0 + ai * 128 + m * 16) * ldo + col0;
#pragma unroll
                for (int bj = 0; bj < 2; ++bj) { const f32x4 v0 = acc[ai][bj][m][0], v1 = acc[ai][bj][m][1];
                    u32x4 w; w.x = cvt_pk_bf16(v0[0], v0[1]); w.y = cvt_pk_bf16(v0[2], v0[3]); w.z = cvt_pk_bf16(v1[0], v1[1]); w.w = cvt_pk_bf16(v1[2], v1[3]);
                    *(u32x4*)(rowp + bj * 128) = w; } }
    }
};
struct EpiFilt {
    static constexpr bool PERM = false;
    _Float16* FILT;
    __device__ __forceinline__ void operator()(const f32x4 (&acc)[2][2][4][2], const Unit& u, int wr, int wc, int fr, int fq) const {
        typedef _Float16 h16x4 __attribute__((ext_vector_type(4)));
        const int row0 = u.pm * 256 + wr * 64 + fr, col0 = u.pn * 256 + wc * 32 + 4 * fq;
        const float dmin = -4.605170186f / 1.5f, dmax = -4.605170186f / 0.3f;
#pragma unroll
        for (int ai = 0; ai < 2; ++ai)
#pragma unroll
            for (int m = 0; m < 4; ++m) { const int r = row0 + ai * 128 + m * 16;
                const float dc = fabsf(dmin + (float)(r & 1023) * ((dmax - dmin) / 1023.0f)) * (1.0f / (float)(SEQ - 1));
#pragma unroll
                for (int bj = 0; bj < 2; ++bj)
#pragma unroll
                    for (int n = 0; n < 2; ++n) { const int lag = col0 + bj * 128 + n * 16; h16x4 o;
#pragma unroll
                        for (int i = 0; i < 4; ++i) o[i] = (_Float16)(acc[ai][bj][m][n][i] * __expf(-(float)(lag + i) * dc));
                        *(h16x4*)(FILT + (size_t)r * SEQ + lag) = o; } }
    }
};
struct InOrder {
    pg8::StaticOrder so; int G, c;
    __device__ bool next(int i, Unit& u) const {
        long L = (long)i * G + c;
        if (L < 64 * 37) return so.map(L, u);
        L -= 64 * 37; if (L >= 26) return false;
        const int j = (int)(L % 13); u.pm = 64 + (int)(L / 13); u.pn = j < 12 ? j : 36; u.e = 0; u.pad = 0; u.aoff = u.pm * so.astep; u.boff = u.pn * so.bstep; return true;
    }
};
struct MoeOrder {
    const LAS int* tile_e; int ntiles, G, c; long astep, bstep, estep;
    __device__ bool next(int i, Unit& u) const {
        const long L = (long)i * G + c; if (L >= (long)ntiles * 4) return false;
        u.pm = (int)(L >> 2); u.pn = (int)(L & 3); u.e = tile_e[u.pm]; u.pad = 0; u.aoff = u.pm * astep; u.boff = u.e * estep + u.pn * bstep; return true;
    }
};

__device__ __forceinline__ void qk_item(Frame& F, const Inputs& I, int b, int head, int ci) {
    constexpr int RPITCH = 1040, QP = 528, O_RAW = 0, O_QS = 69632, O_KS = 103424;
    bf16_t* Z = WSP(bf16_t, WS_Z); bf16_t* QKC = WSP(bf16_t, WS_QKC);
    LAS unsigned char* L = F.lds;
    const int tid = F.tid, lane = F.lane, w = F.wave, fr = lane & 15, fq = lane >> 4;
    const bool is_ctx = ci < 4; const int j = is_ctx ? ci : ci - 4;
    const int rbase = is_ctx ? M_LAT + b * CTXL : b * SEQ, t0 = 64 * j;
    const int seg_lo = is_ctx ? 0 : t0, seg_hi = is_ctx ? CTXL : t0 + 64;
    for (int id = tid; id < 66 * 64; id += 512) { const int r = id >> 6, c = id & 63, t = t0 - 1 + r;
        u32x4 v = {0u, 0u, 0u, 0u};
        if (t >= seg_lo && t < seg_hi) v = *(const u32x4*)(Z + (size_t)(rbase + t) * ZC + (c >> 5) * 1024 + head * 256 + 8 * (c & 31));
        *(LAS u32x4*)(L + O_RAW + r * RPITCH + c * 16) = v; }
    const int cc = tid & 63, colabs = (cc >> 5) * 1024 + head * 256 + 8 * (cc & 31);
    float wt[3][8], bs[8];
#pragma unroll
    for (int e = 0; e < 8; ++e) { wt[0][e] = I.w_qk_conv[colabs + e]; wt[1][e] = I.w_qk_conv[2048 + colabs + e]; wt[2][e] = I.w_qk_conv[4096 + colabs + e]; bs[e] = I.b_qk_conv[colabs + e]; }
    const float osc = cc >= 32 ? 0.0625f : 1.0f;
    __syncthreads();
#pragma unroll 2
    for (int i = 0; i < 8; ++i) { const int r = (tid >> 6) + 8 * i;
        const u32x4 c0 = *(const LAS u32x4*)(L + O_RAW + r * RPITCH + cc * 16), c1 = *(const LAS u32x4*)(L + O_RAW + (r + 1) * RPITCH + cc * 16), c2 = *(const LAS u32x4*)(L + O_RAW + (r + 2) * RPITCH + cc * 16);
        float o[8];
#pragma unroll
        for (int h = 0; h < 4; ++h) {
            const float v0 = wt[0][2 * h] * bflo(c0[h]) + wt[1][2 * h] * bflo(c1[h]) + wt[2][2 * h] * bflo(c2[h]) + bs[2 * h];
            const float v1 = wt[0][2 * h + 1] * bfhi(c0[h]) + wt[1][2 * h + 1] * bfhi(c1[h]) + wt[2][2 * h + 1] * bfhi(c2[h]) + bs[2 * h + 1];
            o[2 * h] = siluf_(v0) * osc; o[2 * h + 1] = siluf_(v1) * osc; }
        u32x4 ov; ov.x = pk2(o[0], o[1]); ov.y = pk2(o[2], o[3]); ov.z = pk2(o[4], o[5]); ov.w = pk2(o[6], o[7]);
        *(LAS u32x4*)(L + (cc >= 32 ? O_KS : O_QS) + r * QP + (cc & 31) * 16) = ov;
        if (is_ctx) *(u32x4*)(QKC + (size_t)(b * CTXL + t0 + r) * ZC + colabs) = ov;
        else *(u32x4*)(Z + (size_t)(rbase + t0 + r) * ZC + colabs) = ov; }
    __syncthreads();
    {
        bf16_t* S0T = WSP(bf16_t, WS_S0T) + ((size_t)((b * 4 + head) * 132 + ci)) * 8192;
        const int tb = w >> 1;
#pragma unroll
        for (int sbi = 0; sbi < 2; ++sbi) { const int sb = 2 * (w & 1) + sbi;
            f32x4 acc = {0.f, 0.f, 0.f, 0.f};
#pragma unroll
            for (int kk = 0; kk < 8; ++kk) {
                const bf16x8 ka = *(const LAS bf16x8*)(L + O_KS + (16 * sb + fr) * QP + (32 * kk + 8 * fq) * 2);
                const bf16x8 qb = *(const LAS bf16x8*)(L + O_QS + (16 * tb + fr) * QP + (32 * kk + 8 * fq) * 2);
                acc = __builtin_amdgcn_mfma_f32_16x16x32_bf16(ka, qb, acc, 0, 0, 0); }
            const int t = 16 * tb + fr, s0 = 16 * sb + 4 * fq;
            u32x2 o; o.x = cvt_pk_bf16(s0 <= t ? acc[0] : 0.f, s0 + 1 <= t ? acc[1] : 0.f); o.y = cvt_pk_bf16(s0 + 2 <= t ? acc[2] : 0.f, s0 + 3 <= t ? acc[3] : 0.f);
            *(u32x2*)(S0T + t * 64 + s0) = o;
            o.x = cvt_pk_bf16(s0 + 3 >= t ? acc[3] : 0.f, s0 + 2 >= t ? acc[2] : 0.f); o.y = cvt_pk_bf16(s0 + 1 >= t ? acc[1] : 0.f, s0 >= t ? acc[0] : 0.f);
            *(u32x2*)(S0T + 4096 + (63 - t) * 64 + (60 - s0)) = o; }
    }
    __syncthreads();
}
__device__ __forceinline__ void hyprep_item(Frame& F, const Inputs& I, int tb, int chb) {
    const bf16_t* Z = WSP(bf16_t, WS_Z); bf16_t* SCM = WSP(bf16_t, WS_SCM);
    constexpr int PITCH = 144;
    LAS unsigned char* X1T = F.lds; LAS unsigned char* VT = F.lds + 64 * PITCH;
    const int p = chb >> 1, j0 = (chb & 1) * 64;
    {   const int r = F.tid >> 3, cc = F.tid & 7; const bf16_t* src = Z + (size_t)(tb * 64 + r) * ZC + ZC_PAIR + 256 * p + j0 + 8 * cc;
        *(LAS u32x4*)(X1T + r * PITCH + cc * 16) = *(const u32x4*)src;
        *(LAS u32x4*)(VT + r * PITCH + cc * 16) = *(const u32x4*)(src + 128); }
    __syncthreads();
    {   const int ch = F.tid >> 3, t8 = (F.tid & 7) * 8, c = chb * 64 + ch;
        float wx[3], wv[3];
#pragma unroll
        for (int k = 0; k < 3; ++k) { wx[k] = I.w_h_conv[k * 3072 + 1024 + c]; wv[k] = I.w_h_conv[k * 3072 + 2048 + c]; }
        const float bx = I.b_h_conv[1024 + c], bv = I.b_h_conv[2048 + c];
        float xs[10], vs[10];
#pragma unroll
        for (int i = 0; i < 10; ++i) { const int r = t8 - 1 + i; const bool ok = r >= 0 && r < 64;
            xs[i] = ok ? bf2f(*(const LAS bf16_t*)(X1T + r * PITCH + ch * 2)) : 0.f; vs[i] = ok ? bf2f(*(const LAS bf16_t*)(VT + r * PITCH + ch * 2)) : 0.f; }
        float s[8];
#pragma unroll
        for (int i = 0; i < 8; ++i) s[i] = (wx[0] * xs[i] + wx[1] * xs[i + 1] + wx[2] * xs[i + 2] + bx) * (wv[0] * vs[i] + wv[1] * vs[i + 1] + wv[2] * vs[i + 2] + bv);
        u32x4 o; o.x = pk2(s[0], s[1]); o.y = pk2(s[2], s[3]); o.z = pk2(s[4], s[5]); o.w = pk2(s[6], s[7]);
        const int b = tb >> 7, t0 = (tb & 127) * 64;
        *(u32x4*)(SCM + ((size_t)(b * 1024 + c)) * SEQ + t0 + t8) = o; }
    __syncthreads();
}
__device__ __forceinline__ void gatescan_item(Frame& F, int b, int g) {
    if (F.wave == 0) {
        const int dir = g >> 2, head = g & 3, gi = dir * 4 + head, lane = F.lane;
        const float* gates = WSP(float, WS_GATES);
        float* scg = WSP(float, WS_SCG) + (size_t)((b * 8 + g) * 132) * 384;
        auto gaddr = [&](int st) { const bool ctx = st < 4; const int j = ctx ? st : st - 4, sl = ctx ? CTXL : SEQ, rbase = ctx ? M_LAT + b * CTXL : b * SEQ;
            const int tlo = dir == 0 ? 64 * j : sl - 64 * (j + 1), t = dir == 0 ? tlo + lane : tlo + 63 - lane; return gates + (size_t)(rbase + t) * 16 + gi; };
        float ig[4], fg[4], nig[4], nfg[4];
#pragma unroll
        for (int j = 0; j < 4; ++j) { const float* p = gaddr(j); ig[j] = p[0]; fg[j] = p[8]; }
        float mrun = 0.f;
        for (int s0 = 0; s0 < 132; s0 += 4) {
            if (s0 + 4 < 132) {
#pragma unroll
                for (int j = 0; j < 4; ++j) { const float* p = gaddr(s0 + 4 + j); nig[j] = p[0]; nfg[j] = p[8]; } }
#pragma unroll
            for (int j = 0; j < 4; ++j) {
                const float mprev = mrun;
                const float fc = fminf(fg[j], 0.f) - __logf(1.0f + __expf(-fabsf(fg[j])));
                const float bcum = wave_scan_sum(fc);
                const float aval = ig[j] - bcum;
                const float cm = fmaxf(mprev, wave_scan_max(aval));
                const float cm63 = lane63(cm), b63 = lane63(bcum);
                mrun = b63 + cm63;
                float* sc = scg + (size_t)(s0 + j) * 384 + lane;
                sc[0] = __expf(fminf(cm63 - cm, 80.f)); sc[64] = 0.f; sc[128] = __expf(mprev - cm); sc[192] = __expf(-(bcum + cm)); sc[256] = __expf(aval - cm63);
                sc[320] = lane == 0 ? __expf(mprev - cm63) : 0.f;
            }
#pragma unroll
            for (int j = 0; j < 4; ++j) { ig[j] = nig[j]; fg[j] = nfg[j]; }
        }
    }
    __syncthreads();
}
__device__ __forceinline__ void phase2a(Frame& F, const Inputs& I) {
    unsigned* q1 = WSP(unsigned, WS_CTL) + CW_Q1;
    volatile LAS int* itp = (volatile LAS int*)(F.lds + MISC_OFF + 64);
    for (;;) {
        if (F.tid == 0) *itp = (int)atomicAdd(q1, 1u);
        __syncthreads();
        const int it = *itp;
        __syncthreads();
        if (it >= 16 + 1056 + 4096) break;
        if (it < 16) gatescan_item(F, it >> 3, it & 7);
        else if (it < 16 + 1056) { const int q = it - 16; qk_item(F, I, q / 528, (q / 132) & 3, q % 132); }
        else { const int j = it - 16 - 1056; hyprep_item(F, I, j >> 4, j & 15); }
    }
}

__device__ __forceinline__ bf16x8 tr_frag(const LAS unsigned char* p0, const LAS unsigned char* p1) {
    const s16x4 a = __builtin_amdgcn_ds_read_tr16_b64_v4i16((LAS s16x4*)p0);
    const s16x4 b = __builtin_amdgcn_ds_read_tr16_b64_v4i16((LAS s16x4*)p1);
    return (bf16x8){a[0], a[1], a[2], a[3], b[0], b[1], b[2], b[3]};
}
__device__ __forceinline__ void mlstm_item(Frame& F, const Inputs& I, int item) {
    constexpr int QP = 528, VP = 112, PP = 144;
    constexpr int O_QS = 0, O_KS = 33792, O_VW = 67584, O_PS = 74752, O_CS = 83968, CS_BYTES = 25344, O_DEN = 134656, O_SC = 135168, SC_BYTES = 6 * 64 * 4, O_OS = 138240, OS_BYTES = 5120, O_OUT = 148480, OP = 80;
    const int b = item >> 6, g = (item >> 3) & 7, dir = g >> 2, head = g & 3, eb = item & 7;
    int tid = F.tid; asm volatile("" : "+v"(tid));
    const int lane = tid & 63, w = F.wave, fr = lane & 15, fq = lane >> 4;
    LAS unsigned char* L = F.lds;
    const unsigned char* wsb = F.ws;
    const int qcol = head * 256, vcol = 2048 + head * 256 + eb * 32, ocol = 3072 + head * 256 + eb * 32;
    const int outcol = ZC_PAIR + dir * 1024 + head * 256 + eb * 32;
    const int gi = dir * 4 + head;
    for (int i = tid; i < 64 * 16; i += 512) { const int r = i >> 4, cidx = 32 + (i & 15);
        *(LAS bf16_t*)(L + O_VW + r * VP + cidx * 2) = (bf16_t)0; }
    for (int i = tid; i < 2 * CS_BYTES / 4; i += 512) *(LAS unsigned*)(L + O_CS + 4 * i) = 0u;
    f32x4 Cacc[2][3];
#pragma unroll
    for (int a = 0; a < 2; ++a)
#pragma unroll
        for (int c = 0; c < 3; ++c) Cacc[a][c] = (f32x4){0.f, 0.f, 0.f, 0.f};
    struct Stage { u32x4 q[4], k[4], vo, s; f32x4 sc; };
    Stage R0, R1;
    const int scc = tid & 31, srow0 = tid >> 5;
    const int ppos = tid >> 3, ps8 = (tid & 7) * 8;
    auto geom = [&](int st, int& rbase, int& tlo, int& ci) { const bool ctx = st < 4; const int j = ctx ? st : st - 4, sl = ctx ? CTXL : SEQ;
        rbase = ctx ? M_LAT + b * CTXL : b * SEQ; tlo = dir == 0 ? 64 * j : sl - 64 * (j + 1); ci = (ctx ? 0 : 4) + (tlo >> 6); };
    constexpr unsigned PITCH = (unsigned)(ZC * 2);
    const unsigned vo_g = (unsigned)(tid < 96 ? tid : 95) * 16u;
    unsigned vo_q[4];
#pragma unroll
    for (int i = 0; i < 4; ++i) vo_q[i] = (unsigned)(srow0 + 16 * i) * PITCH + (unsigned)qcol * 2u + (unsigned)scc * 16u;
    const unsigned vo_v = (unsigned)((tid & 255) >> 2) * PITCH + (unsigned)(tid < 256 ? vcol : ocol) * 2u + (unsigned)(tid & 3) * 16u;
    const unsigned vo_s = (unsigned)(ppos * 64 + ps8) * 2u;
    auto prefetch_a = [&](int st, Stage& R) { int rbase, tlo, ci; geom(st, rbase, tlo, ci);
        R.sc = *(const f32x4*)(wsb + ((unsigned)WS_SCG + (unsigned)((b * 8 + g) * 132 + st) * 1536u) + vo_g);
        const unsigned char* uq = wsb + (st < 4 ? (unsigned)WS_QKC + (unsigned)(b * CTXL + tlo) * PITCH : (unsigned)WS_Z + (unsigned)(rbase + tlo) * PITCH);
#pragma unroll
        for (int i = 0; i < 4; ++i) R.q[i] = *(const u32x4*)(uq + vo_q[i]); };
    auto prefetch_b = [&](int st, Stage& R) { int rbase, tlo, ci; geom(st, rbase, tlo, ci);
        const unsigned char* uq = wsb + (st < 4 ? (unsigned)WS_QKC + (unsigned)(b * CTXL + tlo) * PITCH : (unsigned)WS_Z + (unsigned)(rbase + tlo) * PITCH);
#pragma unroll
        for (int i = 0; i < 4; ++i) R.k[i] = *(const u32x4*)(uq + vo_q[i] + 2048u); };
    auto prefetch_c = [&](int st, Stage& R) { int rbase, tlo, ci; geom(st, rbase, tlo, ci);
        R.vo = *(const u32x4*)(wsb + ((unsigned)WS_Z + (unsigned)(rbase + tlo) * PITCH) + vo_v);
        R.s = *(const u32x4*)(wsb + ((unsigned)WS_S0T + (unsigned)(((b * 4 + head) * 132 + ci) * 2 + dir) * 8192u) + vo_s); };
    auto prefetch = [&](int st, Stage& R) { prefetch_a(st, R); prefetch_b(st, R); prefetch_c(st, R); };
    auto commit = [&](int buf, const Stage& R) {
        const LAS float* SCn = (const LAS float*)(L + O_SC + buf * SC_BYTES);
#pragma unroll
        for (int i = 0; i < 4; ++i) { const int mr = srow0 + 16 * i, p = dir ? 63 - mr : mr; *(LAS u32x4*)(L + O_QS + p * QP + scc * 16) = R.q[i]; *(LAS u32x4*)(L + O_KS + p * QP + scc * 16) = R.k[i]; }
        if (tid < 256) { const int mr = tid >> 2, p = dir ? 63 - mr : mr; const u32x4 pv = R.vo;
            const float wg = SCn[256 + p]; u32x4 vo;
            vo.x = cvt_pk_bf16(bflo(pv.x) * wg, bfhi(pv.x) * wg); vo.y = cvt_pk_bf16(bflo(pv.y) * wg, bfhi(pv.y) * wg); vo.z = cvt_pk_bf16(bflo(pv.z) * wg, bfhi(pv.z) * wg); vo.w = cvt_pk_bf16(bflo(pv.w) * wg, bfhi(pv.w) * wg);
            *(LAS u32x4*)(L + O_VW + p * VP + (tid & 3) * 16) = vo; }
        else { const int mr = (tid & 255) >> 2, p = dir ? 63 - mr : mr; *(LAS u32x4*)(L + O_OS + buf * OS_BYTES + p * OP + (tid & 3) * 16) = R.vo;
            if (tid < 320) { const int p1 = tid - 256; *(LAS bf16_t*)(L + O_VW + p1 * VP + 64) = (bf16_t)f2bf(SCn[256 + p1]); } }
        *(LAS u32x4*)(L + O_PS + ppos * PP + ps8 * 2) = R.s; };
#define LDS_BAR() do { asm volatile("s_waitcnt lgkmcnt(0)" ::: "memory"); __builtin_amdgcn_s_barrier(); asm volatile("" ::: "memory"); } while (0)
    auto scalars = [&](const Stage& R, int buf) { if (tid < 96) *(LAS f32x4*)(L + O_SC + buf * SC_BYTES + tid * 16) = R.sc; };
    prefetch(0, R0);
    scalars(R0, 0);
    __syncthreads();
    commit(0, R0);
    prefetch(1, R1);
    __syncthreads();
    int cur = 0;
    auto flush_out = [&](int sp) { int rbase, tlo, ci; geom(sp < 0 ? 0 : sp, rbase, tlo, ci);
        const int p = (tid & 255) >> 2, tok = dir == 0 ? p : 63 - p; const bool real = sp >= 4 && tid < 256;
        const u32x4 o = *(const LAS u32x4*)(L + O_OUT + p * OP + (tid & 3) * 16);
        const unsigned off = real ? (unsigned)WS_Z + (unsigned)(rbase + tlo + tok) * PITCH + (unsigned)outcol * 2u + (unsigned)(tid & 3) * 16u
                                  : (unsigned)WS_Z + (unsigned)(M_LAT + (tid & 255)) * PITCH + (unsigned)ZC_GB * 2u + (unsigned)(tid >> 8) * 16u;
        *(u32x4*)(F.ws + off) = o; };
    auto step = [&](int st, Stage& RA, Stage& RB) {
        const bool has_next = st + 1 < 132, is_ctx = st < 4;
        int rbase_c, tlo_c, ci_c; geom(st, rbase_c, tlo_c, ci_c);
        const int st2 = st + 2 < 132 ? st + 2 : 131;
        flush_out(st - 1);
        prefetch_a(st2, RA);
        const LAS float* SC = (const LAS float*)(L + O_SC + cur * SC_BYTES);
        const float c_decay = SC[320];
        const int tt = w & 3, et = w >> 2;
        const int trg = lane >> 4, trq = (lane & 15) >> 2, trp = lane & 3;
        f32x4 nacc;
        {
            const LAS unsigned char* CSc = L + O_CS + cur * CS_BYTES;
            const f32x4 cs4 = *(const LAS f32x4*)(SC + 128 + 16 * tt + 4 * fq), rs4 = *(const LAS f32x4*)(SC + 16 * tt + 4 * fq);
            f32x4 a = {0.f, 0.f, 0.f, 0.f}, ia = {0.f, 0.f, 0.f, 0.f}, da = {0.f, 0.f, 0.f, 0.f}, dia = {0.f, 0.f, 0.f, 0.f};
#pragma unroll
            for (int kk = 0; kk < 8; ++kk) {
                const bf16x8 qa = *(const LAS bf16x8*)(L + O_QS + (16 * tt + fr) * QP + (32 * kk + 8 * fq) * 2);
                const bf16x8 cb = *(const LAS bf16x8*)(CSc + (16 * et + fr) * QP + (32 * kk + 8 * fq) * 2);
                a = __builtin_amdgcn_mfma_f32_16x16x32_bf16(qa, cb, a, 0, 0, 0);
                if ((kk >> 2) == et) { const bf16x8 cd = *(const LAS bf16x8*)(CSc + (32 + fr) * QP + (32 * kk + 8 * fq) * 2);
                    da = __builtin_amdgcn_mfma_f32_16x16x32_bf16(qa, cd, da, 0, 0, 0); } }
#pragma unroll
            for (int ks = 0; ks < 2; ++ks) {
                const bf16x8 pa = *(const LAS bf16x8*)(L + O_PS + (16 * tt + fr) * PP + (32 * ks + 8 * fq) * 2);
                const LAS unsigned char* vb = L + O_VW + (32 * ks + 8 * trg + trq) * VP + (16 * et + 4 * trp) * 2;
                ia = __builtin_amdgcn_mfma_f32_16x16x32_bf16(pa, tr_frag(vb, vb + 4 * VP), ia, 0, 0, 0);
                if (ks == et) { const LAS unsigned char* vd = L + O_VW + (32 * ks + 8 * trg + trq) * VP + (32 + 4 * trp) * 2;
                    dia = __builtin_amdgcn_mfma_f32_16x16x32_bf16(pa, tr_frag(vd, vd + 4 * VP), dia, 0, 0, 0); } }
            nacc = a * cs4 + ia * rs4;
            const f32x4 dacc = da * cs4 + dia * rs4;
            if (fr == 0) *(LAS f32x4*)(L + O_DEN + et * 256 + (16 * tt + 4 * fq) * 4) = dacc;
        }
        prefetch_b(st2, RA);
        {
            LAS unsigned char* CSn = L + O_CS + (cur ^ 1) * CS_BYTES;
#pragma unroll
            for (int a = 0; a < 2; ++a)
#pragma unroll
                for (int c = 0; c < 3; ++c) Cacc[a][c] = Cacc[a][c] * c_decay;
#pragma unroll
            for (int ks = 0; ks < 2; ++ks) {
                bf16x8 ka[2], vb[3];
#pragma unroll
                for (int a = 0; a < 2; ++a) { const LAS unsigned char* p = L + O_KS + (32 * ks + 8 * trg + trq) * QP + (16 * (2 * w + a) + 4 * trp) * 2; ka[a] = tr_frag(p, p + 4 * QP); }
#pragma unroll
                for (int c = 0; c < 3; ++c) { const LAS unsigned char* p = L + O_VW + (32 * ks + 8 * trg + trq) * VP + (16 * c + 4 * trp) * 2; vb[c] = tr_frag(p, p + 4 * VP); }
#pragma unroll
                for (int a = 0; a < 2; ++a)
#pragma unroll
                    for (int c = 0; c < 3; ++c) Cacc[a][c] = __builtin_amdgcn_mfma_f32_16x16x32_bf16(ka[a], vb[c], Cacc[a][c], 0, 0, 0);
            }
#pragma unroll
            for (int a = 0; a < 2; ++a)
#pragma unroll
                for (int c = 0; c < 3; ++c) { u32x2 o; o.x = cvt_pk_bf16(Cacc[a][c][0], Cacc[a][c][1]); o.y = cvt_pk_bf16(Cacc[a][c][2], Cacc[a][c][3]);
                    *(LAS u32x2*)(CSn + (16 * c + fr) * QP + (16 * (2 * w + a) + 4 * fq) * 2) = o; }
        }
        prefetch_c(st2, RA);
        if (has_next) scalars(RB, cur ^ 1);
        LDS_BAR();
        {
            const f32x4 den4 = *(const LAS f32x4*)(L + O_DEN + (16 * tt + 4 * fq) * 4) + *(const LAS f32x4*)(L + O_DEN + 256 + (16 * tt + 4 * fq) * 4), em4 = *(const LAS f32x4*)(SC + 192 + 16 * tt + 4 * fq);
#pragma unroll
            for (int i = 0; i < 4; ++i) { const int p = 16 * tt + 4 * fq + i;
                const float h = nacc[i] * __builtin_amdgcn_rcpf(fmaxf(fabsf(den4[i]), em4[i]));
                const float og = bf2f(*(const LAS bf16_t*)(L + O_OS + cur * OS_BYTES + p * OP + (16 * et + fr) * 2));
                *(LAS bf16_t*)(L + O_OUT + p * OP + (16 * et + fr) * 2) = (bf16_t)f2bf(sigmoidf_(og) * h); }
        }
        if (has_next) commit(cur ^ 1, RB);
        cur ^= 1;
        LDS_BAR();
    };
    for (int st = 0; st < 132; st += 2) { step(st, R0, R1); step(st + 1, R1, R0); }
    flush_out(131);
    __syncthreads();
#undef LDS_BAR
}

__device__ __forceinline__ void hyena_item(Frame& F, const Inputs& I, int c) {
    LAS f32x2* X = (LAS f32x2*)F.lds;
    int tid = F.tid; asm volatile("" : "+v"(tid));
    const bf16_t* s0 = WSP(bf16_t, WS_SCM) + (size_t)c * SEQ; const bf16_t* s1 = s0 + (size_t)1024 * SEQ;
    const f32x2* fs = WSP(f32x2, WS_FSPEC) + (size_t)c * FS_PITCH;
    bf16_t* y0 = WSP(bf16_t, WS_H) + (size_t)c * SEQ; bf16_t* y1 = y0 + (size_t)1024 * SEQ;
    unsigned skeep[16];
    {
        f32x2 v[32];
#pragma unroll
        for (int r = 0; r < 16; ++r) { const int t = tid + 512 * r; const unsigned a = s0[t], bq = s1[t]; skeep[r] = a | (bq << 16); v[r] = (f32x2){bf2f((unsigned short)a), bf2f((unsigned short)bq)}; }
#pragma unroll
        for (int r = 16; r < 32; ++r) v[r] = (f32x2){0.f, 0.f};
        __syncthreads();
        fft_pass_a_store(v, X, tid);
    }
    __syncthreads();
    fft_pass_b(X, tid);
    __syncthreads();
    {
        f32x2 v[32]; fft_pass_c_compute(v, X, tid);
        asm volatile("" ::: "memory"); __builtin_amdgcn_sched_barrier(0);
#pragma unroll
        for (int u = 0; u < 2; ++u)
#pragma unroll
            for (int p = 0; p < 16; ++p) { const int idx = tid + 512 * u + 1024 * bitrev(p, 4);
                f32x2 f = idx <= 8192 ? fs[idx] : fs[FFT_N - idx]; if (idx > 8192) f.y = -f.y;
                const f32x2 y = cmul(v[16 * u + p], f); v[16 * u + p] = (f32x2){y.x, -y.y}; }
        __syncthreads();
#pragma unroll
        for (int u = 0; u < 2; ++u) { int jj = tid + 512 * u; asm volatile("" : "+v"(jj)); LAS f32x2* xb = X + jj + (jj >> 5);
#pragma unroll
            for (int p = 0; p < 16; ++p) xb[1056 * bitrev(p, 4)] = v[16 * u + p]; }
    }
    __syncthreads();
    {   f32x2 v[32]; fft_load32(v, X, tid); __syncthreads(); fft_pass_a_store(v, X, tid); }
    __syncthreads();
    fft_pass_b(X, tid);
    __syncthreads();
    {   f32x2 v[32]; fft_pass_c_compute(v, X, tid);
        asm volatile("" ::: "memory"); __builtin_amdgcn_sched_barrier(0);
        const float hb = I.h_bias[c];
#pragma unroll
        for (int u = 0; u < 2; ++u)
#pragma unroll
            for (int p = 0; p < 16; ++p) { const int q = bitrev(p, 4);
                if (q < 8) { const int idx = tid + 512 * u + 1024 * q; const unsigned sk = skeep[u + 2 * q];
                    const float o0 = v[16 * u + p].x + hb * bflo(sk), o1 = -v[16 * u + p].y + hb * bfhi(sk);
                    y0[idx] = (bf16_t)f2bf(o0); y1[idx] = (bf16_t)f2bf(o1); } }
    }
    __syncthreads();
}
__device__ __forceinline__ void hy_item(Frame& F, const Inputs& I, int tb, int chb) {
    bf16_t* Z = WSP(bf16_t, WS_Z); const bf16_t* YCM = WSP(bf16_t, WS_H);
    constexpr int PITCH = 144;
    LAS unsigned char* X0T = F.lds; LAS unsigned char* YT = F.lds + 64 * PITCH;
    const int b = tb >> 7, t0 = (tb & 127) * 64;
    {   const int r = F.tid >> 3, cc = F.tid & 7;
        *(LAS u32x4*)(X0T + r * PITCH + cc * 16) = *(const u32x4*)(Z + (size_t)(tb * 64 + r) * ZC + ZC_X0 + chb * 64 + 8 * cc);
        *(LAS u32x4*)(YT + r * PITCH + cc * 16) = *(const u32x4*)(YCM + ((size_t)(b * 1024 + chb * 64 + r)) * SEQ + t0 + 8 * cc); }
    __syncthreads();
    {   const int r = F.tid >> 3, cc = F.tid & 7;
        const u32x4 z = {0u, 0u, 0u, 0u};
        const u32x4 c1 = *(const LAS u32x4*)(X0T + r * PITCH + cc * 16);
        const u32x4 c0 = r > 0 ? *(const LAS u32x4*)(X0T + (r - 1) * PITCH + cc * 16) : z;
        const u32x4 c2 = r < 63 ? *(const LAS u32x4*)(X0T + (r + 1) * PITCH + cc * 16) : z;
        float o[8];
        const int cb8 = chb * 64 + 8 * cc;
        const f32x4 w0a = *(const f32x4*)(I.w_h_conv + cb8), w0b = *(const f32x4*)(I.w_h_conv + cb8 + 4), w1a = *(const f32x4*)(I.w_h_conv + 3072 + cb8), w1b = *(const f32x4*)(I.w_h_conv + 3072 + cb8 + 4);
        const f32x4 w2a = *(const f32x4*)(I.w_h_conv + 6144 + cb8), w2b = *(const f32x4*)(I.w_h_conv + 6144 + cb8 + 4), bba = *(const f32x4*)(I.b_h_conv + cb8), bbb = *(const f32x4*)(I.b_h_conv + cb8 + 4);
#pragma unroll
        for (int e = 0; e < 8; ++e) { const int h = e >> 1;
            const float a0 = (e & 1) ? bfhi(c0[h]) : bflo(c0[h]), a1 = (e & 1) ? bfhi(c1[h]) : bflo(c1[h]), a2 = (e & 1) ? bfhi(c2[h]) : bflo(c2[h]);
            const float k0 = e < 4 ? w0a[e & 3] : w0b[e & 3], k1 = e < 4 ? w1a[e & 3] : w1b[e & 3], k2 = e < 4 ? w2a[e & 3] : w2b[e & 3], kb = e < 4 ? bba[e & 3] : bbb[e & 3];
            const float x0 = k0 * a0 + k1 * a1 + k2 * a2 + kb;
            o[e] = x0 * bf2f(*(const LAS bf16_t*)(YT + (8 * cc + e) * PITCH + r * 2)); }
        u32x4 ov; ov.x = pk2(o[0], o[1]); ov.y = pk2(o[2], o[3]); ov.z = pk2(o[4], o[5]); ov.w = pk2(o[6], o[7]);
        *(u32x4*)(Z + (size_t)(tb * 64 + r) * ZC + ZC_X0 + chb * 64 + 8 * cc) = ov; }
    __syncthreads();
}

__device__ __forceinline__ void phase2b(Frame& F, const Inputs& I) {
    const int GA = F.G >= 2 ? F.G / 2 : 1, GB = F.G - GA;
    unsigned* sub = WSP(unsigned, WS_CTL) + CW_SUB;
    if (F.vcu < GA) { for (int it = F.vcu; it < 128; it += GA) mlstm_item(F, I, it); __syncthreads(); }
    if (GB == 0 || F.vcu >= GA) {
        const int c0 = GB ? F.vcu - GA : 0, cs = GB ? GB : 1;
        const int cpw = (1024 / 2 + cs - 1) / cs * 2, cb = c0 * cpw, ce = cb + cpw < 1024 ? cb + cpw : 1024;
        fft_twiddle_init(F.lds, F.tid);
        __syncthreads();
        for (int c = cb; c < ce; c += 2) filter_spec_item(F, I, c >> 1);
        for (int c = cb; c < ce; ++c) hyena_item(F, I, c);
        subgrid_barrier(sub, (unsigned)cs, 1u);
        for (int it = c0; it < 4096; it += cs) hy_item(F, I, it >> 4, it & 15);
        subgrid_barrier(sub, (unsigned)cs, 2u);
    } else {
        if (F.tid == 0) { unsigned sp = 0; while (xb_ld(sub) < 2u * (unsigned)GB) { __builtin_amdgcn_s_sleep(4); if (++sp > (1u << 22)) break; }
            __builtin_amdgcn_fence(__ATOMIC_ACQUIRE, "agent"); asm volatile("s_waitcnt vmcnt(0)" ::: "memory"); }
        __syncthreads();
    }
    {
        bf16_t* Z = WSP(bf16_t, WS_Z);
        pg8::Gemm g{Z + ZC_X0, WSP(bf16_t, WS_WB_T), ZC, D, D};
        pg8::StaticOrder S; S.init(64, 4, F.G, (int)blockIdx.x, 256L * ZC * 2, 256L * D * 2);
        EpiMerge<false> E{Z + ZC_GB, WSP(bf16_t, WS_FSPEC), nullptr};
        pg8::gemm_phase<EpiMerge<false>, pg8::StaticOrder, false>(F.lds, g, S, E);
    }
}
struct XtItem { const float* W; int N, k0, n0; bf16_t* WT; int ldt, drow0; };
__device__ __forceinline__ XtItem xt_decode(const Inputs& I, bf16_t* W13T, bf16_t* W2T, int it) {
    constexpr int PER_E = 3 * 256;
    const int e = it / PER_E, r = it % PER_E, m = r >> 8, rr = r & 255; XtItem x;
    if (m < 2) { const int kb = rr >> 4, nb = rr & 15, n0 = 32 * nb;
        x.W = (m == 0 ? I.w1_e : I.w3_e) + (size_t)e * D * DEXP; x.N = DEXP; x.k0 = 64 * kb; x.n0 = n0; x.WT = W13T + (size_t)e * 1024 * 1024; x.ldt = D; x.drow0 = (n0 >> 7) * 256 + m * 128 + (n0 & 127); }
    else { const int kb = rr >> 5, nb = rr & 31;
        x.W = I.w2_e + (size_t)e * DEXP * D; x.N = D; x.k0 = 64 * kb; x.n0 = 32 * nb; x.WT = W2T + (size_t)e * 1024 * DEXP; x.ldt = DEXP; x.drow0 = 32 * nb; }
    return x;
}
__device__ __forceinline__ void xt_load(const XtItem& x, float (&v)[32], int lane) {
    const float* p = x.W + (size_t)(x.k0 + (lane >> 5)) * x.N + x.n0 + (lane & 31);
#pragma unroll
    for (int i = 0; i < 32; ++i) v[i] = p[(size_t)(2 * i) * x.N];
}
__device__ __forceinline__ void xt_finish(const XtItem& x, const float (&v)[32], LAS float* scr, int lane) {
#pragma unroll
    for (int i = 0; i < 32; ++i) scr[(2 * i + (lane >> 5)) * 33 + (lane & 31)] = v[i];
    asm volatile("s_waitcnt lgkmcnt(0)" ::: "memory");
    const int c = lane & 7;
#pragma unroll
    for (int j = 0; j < 4; ++j) { const int n = (lane >> 3) + 8 * j; const LAS float* s = scr + (8 * c) * 33 + n;
        u32x4 o; o.x = pk2(s[0 * 33], s[1 * 33]); o.y = pk2(s[2 * 33], s[3 * 33]); o.z = pk2(s[4 * 33], s[5 * 33]); o.w = pk2(s[6 * 33], s[7 * 33]);
        *(u32x4*)(x.WT + (size_t)(x.drow0 + n) * x.ldt + x.k0 + 8 * c) = o; }
    asm volatile("s_waitcnt lgkmcnt(0)" ::: "memory");
}
__device__ __forceinline__ void expert_transposes(Frame& F, const Inputs& I, int part, int nparts, int wg, int nwg) {
    LAS float* scr = (LAS float*)(F.lds + F.wave * 16384);
    const int gw = wg * 8 + F.wave, NGW = nwg * 8;
    constexpr int NIT = NEXP * 3 * 256;
    const int lo = (int)((long)NIT * part / nparts), hi = (int)((long)NIT * (part + 1) / nparts);
    bf16_t* W13T = WSP(bf16_t, WS_W13T); bf16_t* W2T = WSP(bf16_t, WS_W2T);
    int it = lo + gw; if (it >= hi) return;
    float va[32], vb[32];
    XtItem xa = xt_decode(I, W13T, W2T, it), xb = xa;
    xt_load(xa, va, F.lane);
    for (;;) {
        const bool nb = it + NGW < hi;
        if (nb) { xb = xt_decode(I, W13T, W2T, it + NGW); xt_load(xb, vb, F.lane); }
        xt_finish(xa, va, scr, F.lane);
        if (!nb) break;
        it += NGW;
        const bool na = it + NGW < hi;
        if (na) { xa = xt_decode(I, W13T, W2T, it + NGW); xt_load(xa, va, F.lane); }
        xt_finish(xb, vb, scr, F.lane);
        if (!na) break;
        it += NGW;
    }
}

struct Route { int e0, e1; float w0, w1; };
__device__ __forceinline__ void route_item(Frame& F, const Inputs& I, const float* x1, int blk) {
    constexpr int RP = 528;
    constexpr int O_AH = 0, O_AL = 33792, O_BH = 67584, O_BL = 109824, O_SSQ = 152064, O_LC = 152320;
    LAS unsigned char* L = F.lds;
    const int tid = F.tid, lane = F.lane, w = F.wave, fr = lane & 15, fq = lane >> 4;
    const int row0 = blk * 64, b = row0 / SEQ;
    const float* mods = WSP(float, WS_MODS) + b * 6144;
    const bf16_t* w72s = WSP(bf16_t, WS_W72S);
    f32x4 acc[3];
#pragma unroll
    for (int t = 0; t < 3; ++t) acc[t] = (f32x4){0.f, 0.f, 0.f, 0.f};
    const int sr = tid >> 3, seg = tid & 7;
    float ssq = 0.f;
    if (tid < 64) *(LAS int*)(L + O_LC + 4 * tid) = 0;
    for (int kt = 0; kt < 4; ++kt) {
#pragma unroll
        for (int i = 0; i < 8; ++i) { const int kk = 32 * i + 4 * seg, k = kt * 256 + kk;
            const f32x4 xv = *(const f32x4*)(x1 + (size_t)(row0 + sr) * D + k);
            ssq += (xv.x * xv.x + xv.y * xv.y) + (xv.z * xv.z + xv.w * xv.w);
            const f32x4 g = *(const f32x4*)(I.g_norm2 + k), sc = *(const f32x4*)(mods + 4 * 1024 + k);
            const f32x4 hv = xv * g * (sc + 1.0f);
            const unsigned h0 = f2bf(hv.x), h1 = f2bf(hv.y), h2 = f2bf(hv.z), h3 = f2bf(hv.w);
            const u32x2 hi = {h0 | (h1 << 16), h2 | (h3 << 16)};
            const u32x2 lo = {pk2(hv.x - bf2f((unsigned short)h0), hv.y - bf2f((unsigned short)h1)), pk2(hv.z - bf2f((unsigned short)h2), hv.w - bf2f((unsigned short)h3))};
            *(LAS u32x2*)(L + O_AH + sr * RP + kk * 2) = hi; *(LAS u32x2*)(L + O_AL + sr * RP + kk * 2) = lo; }
#pragma unroll
        for (int j = 0; j < 10; ++j) { const int id = tid + 512 * j, which = id / 2560, rem = id % 2560, col = rem >> 5, c16 = rem & 31;
            *(LAS u32x4*)(L + (which ? O_BL : O_BH) + col * RP + c16 * 16) = *(const u32x4*)(w72s + (size_t)(col * 2 + which) * 1024 + kt * 256 + c16 * 8); }
        __syncthreads();
#pragma unroll
        for (int ti = 0; ti < 3; ++ti) { const int T = w + 8 * ti;
            if (T < 20) { const int rt = T & 3, ct = T >> 2;
#pragma unroll
                for (int k8 = 0; k8 < 8; ++k8) {
                    const bf16x8 ah = *(const LAS bf16x8*)(L + O_AH + (16 * rt + fr) * RP + (32 * k8 + 8 * fq) * 2), al = *(const LAS bf16x8*)(L + O_AL + (16 * rt + fr) * RP + (32 * k8 + 8 * fq) * 2);
                    const bf16x8 bh = *(const LAS bf16x8*)(L + O_BH + (16 * ct + fr) * RP + (32 * k8 + 8 * fq) * 2), bl = *(const LAS bf16x8*)(L + O_BL + (16 * ct + fr) * RP + (32 * k8 + 8 * fq) * 2);
                    acc[ti] = __builtin_amdgcn_mfma_f32_16x16x32_bf16(ah, bh, acc[ti], 0, 0, 0);
                    acc[ti] = __builtin_amdgcn_mfma_f32_16x16x32_bf16(al, bh, acc[ti], 0, 0, 0);
                    acc[ti] = __builtin_amdgcn_mfma_f32_16x16x32_bf16(ah, bl, acc[ti], 0, 0, 0);
                } } }
        __syncthreads();
    }
    ssq += __shfl_xor(ssq, 1); ssq += __shfl_xor(ssq, 2); ssq += __shfl_xor(ssq, 4);
    if (seg == 0) *(LAS float*)(L + O_SSQ + 4 * sr) = ssq;
    LAS float* LOG = (LAS float*)L;
#pragma unroll
    for (int ti = 0; ti < 3; ++ti) { const int T = w + 8 * ti;
        if (T < 20) { const int rt = T & 3, ct = T >> 2;
#pragma unroll
            for (int i = 0; i < 4; ++i) LOG[(16 * rt + 4 * fq + i) * 81 + 16 * ct + fr] = acc[ti][i]; } }
    __syncthreads();
    if (w == 0) {
        const float rstd = 1.0f / sqrtf(*(const LAS float*)(L + O_SSQ + 4 * lane) * (1.0f / D) + EPS);
        const float* cst = WSP(float, WS_CST) + b * 72;
        float lg[72];
#pragma unroll
        for (int j = 0; j < 72; ++j) lg[j] = rstd * LOG[lane * 81 + j] + cst[j];
        int gsel = 0; float gmax = lg[0];
#pragma unroll
        for (int j = 1; j < 8; ++j) if (lg[j] > gmax) { gmax = lg[j]; gsel = j; }
        float gs = 0.f;
#pragma unroll
        for (int j = 0; j < 8; ++j) gs += __expf(lg[j] - gmax);
        const float gwt = 1.0f / gs;
        float el[8];
#pragma unroll
        for (int j = 0; j < 8; ++j) { float v = lg[8 + j];
#pragma unroll
            for (int gI = 1; gI < 8; ++gI) v = gsel == gI ? lg[8 + 8 * gI + j] : v;
            el[j] = v; }
        int i0 = 0; float v0 = el[0];
#pragma unroll
        for (int j = 1; j < 8; ++j) if (el[j] > v0) { v0 = el[j]; i0 = j; }
        int i1 = -1; float v1 = -3.0e38f;
#pragma unroll
        for (int j = 0; j < 8; ++j) if (j != i0 && el[j] > v1) { v1 = el[j]; i1 = j; }
        const float p1 = __expf(v1 - v0), inv = 1.0f / (1.0f + p1);
        const int e0 = gsel * 8 + i0, e1 = gsel * 8 + i1;
        const int r0 = __hip_atomic_fetch_add((LAS int*)(L + O_LC) + e0, 1, __ATOMIC_RELAXED, __HIP_MEMORY_SCOPE_WORKGROUP);
        const int r1 = __hip_atomic_fetch_add((LAS int*)(L + O_LC) + e1, 1, __ATOMIC_RELAXED, __HIP_MEMORY_SCOPE_WORKGROUP);
        Route r; r.e0 = e0 | (r0 << 8); r.e1 = e1 | (r1 << 8); r.w0 = gwt * inv; r.w1 = gwt * p1 * inv;
        WSP(Route, WS_ROUTE)[row0 + lane] = r;
        WSP(float, WS_RSTD2)[row0 + lane] = rstd;
    }
    __syncthreads();
    if (tid < 64) WSP(int, WS_BLKCNT)[blk * 64 + tid] = *(const LAS int*)(L + O_LC + 4 * tid);
    __syncthreads();
}
__device__ __forceinline__ int moe_tables(Frame& F, LAS int* seg_start, LAS int* tile_e) {
    const unsigned* cnt = WSP(unsigned, WS_CTL) + CW_CNT;
    if (F.tid < 64) seg_start[96 + F.tid] = (int)__hip_atomic_load(cnt + F.tid, RLX_AGENT);
    __syncthreads();
    if (F.tid < 64) { int s = 0; for (int e = 0; e < F.tid; ++e) s += (seg_start[96 + e] + 255) >> 8; seg_start[F.tid] = s * 256; }
    __syncthreads();
    if (F.tid < 64) { const int t0 = seg_start[F.tid] >> 8, nt = (seg_start[96 + F.tid] + 255) >> 8; for (int t = 0; t < nt; ++t) tile_e[t0 + t] = F.tid; if (F.tid == 63) seg_start[64] = (t0 + nt) * 256; }
    __syncthreads();
    return seg_start[64] >> 8;
}
__device__ __forceinline__ void phase4b(Frame& F, const Inputs& I, const float* x1) {
    LAS int* PART = (LAS int*)F.lds;
    LAS int* TOT = PART + 1024;
    LAS int* BEF = TOT + 64;
    LAS int* SEG = BEF + 64;
    const int* blkcnt = WSP(int, WS_BLKCNT);
    bf16_t* XS = WSP(bf16_t, WS_XS);
    for (int blk = F.vcu; blk < M_LAT / 64; blk += F.G) {
        {   const int e = F.tid & 63, part = F.tid >> 6; int sa = 0, sb = 0;
#pragma unroll 8
            for (int i = 0; i < 32; ++i) { const int bb = 32 * part + i; const int c = blkcnt[bb * 64 + e]; sa += c; sb += bb < blk ? c : 0; }
            PART[(part * 64 + e) * 2] = sa; PART[(part * 64 + e) * 2 + 1] = sb; }
        __syncthreads();
        if (F.tid < 64) { int ta = 0, tb = 0;
#pragma unroll
            for (int p = 0; p < 8; ++p) { ta += PART[(p * 64 + F.tid) * 2]; tb += PART[(p * 64 + F.tid) * 2 + 1]; }
            TOT[F.tid] = ta; BEF[F.tid] = tb;
            if (blk == 0) WSP(unsigned, WS_CTL)[CW_CNT + F.tid] = (unsigned)ta; }
        __syncthreads();
        if (F.tid == 0) { int run = 0; for (int e = 0; e < 64; ++e) { SEG[e] = run * 256; run += (TOT[e] + 255) >> 8; } SEG[64] = run * 256; }
        __syncthreads();
#pragma unroll 1
        for (int i = 0; i < 8; ++i) {
            const int row = blk * 64 + F.wave * 8 + i;
            const Route r = WSP(Route, WS_ROUTE)[row];
            const int e0 = r.e0 & 255, e1 = r.e1 & 255;
            const int sl0 = SEG[e0] + BEF[e0] + (r.e0 >> 8), sl1 = SEG[e1] + BEF[e1] + (r.e1 >> 8);
            if (F.lane == 0) { WSP(int, WS_TOKSLOT)[2 * row] = sl0; WSP(int, WS_TOKSLOT)[2 * row + 1] = sl1; }
            const float rstd = WSP(float, WS_RSTD2)[row];
            const float* md = WSP(float, WS_MODS) + (row / SEQ) * 6144;
            const f32x4* xr = (const f32x4*)(x1 + (size_t)row * D) + F.lane;
            u32x2* o0 = (u32x2*)(XS + (size_t)sl0 * D) + F.lane; u32x2* o1 = (u32x2*)(XS + (size_t)sl1 * D) + F.lane;
#pragma unroll
            for (int j = 0; j < 4; ++j) { const int k = 4 * F.lane + 256 * j; const f32x4 xv = xr[64 * j];
                const f32x4 g = *(const f32x4*)(I.g_norm2 + k), sh = *(const f32x4*)(md + 3 * 1024 + k), sc = *(const f32x4*)(md + 4 * 1024 + k);
                const f32x4 h = xv * rstd * g * (sc + 1.0f) + sh;
                const u32x2 o = {pk2(h.x, h.y), pk2(h.z, h.w)}; o0[64 * j] = o; o1[64 * j] = o; }
        }
        __syncthreads();
    }
}
__device__ __forceinline__ void phase6(Frame& F, const Inputs& I, float* out) {
    const int gw = F.vcu * 8 + F.wave, NGW = F.G * 8;
    const bf16_t* Y = WSP(bf16_t, WS_XS);
    for (int row = gw; row < M_LAT; row += NGW) {
        const Route r = WSP(Route, WS_ROUTE)[row];
        const int sl0 = WSP(int, WS_TOKSLOT)[2 * row], sl1 = WSP(int, WS_TOKSLOT)[2 * row + 1];
        const float* md = WSP(float, WS_MODS) + (row / SEQ) * 6144 + 5 * 1024;
        f32x4* xr = (f32x4*)(out + (size_t)row * D) + F.lane;
        const u32x2* y0 = (const u32x2*)(Y + (size_t)sl0 * D) + F.lane; const u32x2* y1 = (const u32x2*)(Y + (size_t)sl1 * D) + F.lane;
        f32x4 v[4]; float s = 0.f;
#pragma unroll
        for (int j = 0; j < 4; ++j) { const int k = 4 * F.lane + 256 * j; const u32x2 a = y0[64 * j], bq = y1[64 * j];
            const f32x4 ya = {bflo(a.x), bfhi(a.x), bflo(a.y), bfhi(a.y)}, yb = {bflo(bq.x), bfhi(bq.x), bflo(bq.y), bfhi(bq.y)};
            const f32x4 moe = ya * r.w0 + yb * r.w1;
            v[j] = xr[64 * j] + *(const f32x4*)(md + k) * moe;
            s += (v[j].x * v[j].x + v[j].y * v[j].y) + (v[j].z * v[j].z + v[j].w * v[j].w); }
        const float rstd = 1.0f / sqrtf(wave_sum(s) * (1.0f / D) + EPS);
#pragma unroll
        for (int j = 0; j < 4; ++j) { const int k = 4 * F.lane + 256 * j; xr[64 * j] = v[j] * rstd * *(const f32x4*)(I.g_final + k); }
    }
}

#ifndef MK_PER_PHASE
#define MK_PER_PHASE 0
#endif
constexpr int N_PHASES = 12;
constexpr int TAB_OFF = 150 * 1024;

__global__ void __launch_bounds__(512, 2) fwd_kernel(Args args) {
    extern __shared__ __attribute__((aligned(16))) unsigned char lds_raw[];
    Frame F;
    F.lds = (LAS unsigned char*)lds_raw;
    F.tid = threadIdx.x; F.lane = F.tid & 63; F.wave = __builtin_amdgcn_readfirstlane(F.tid >> 6);
    F.G = gridDim.x; { const int bx = blockIdx.x; F.vcu = (F.G % 8 == 0) ? (bx % 8) * (F.G / 8) + bx / 8 : bx; }
    F.ws = args.ws;
    const Inputs& I = args.in;
    volatile LAS unsigned* MISC = (volatile LAS unsigned*)(F.lds + MISC_OFF);
    if (F.tid < 32) MISC[F.tid] = 0u;
    __syncthreads();
    XcdBarrier bar; bar.bar = WSP(unsigned, WS_CTL) + CW_BAR; bar.x = 0; bar.st = nullptr;
#if !MK_PER_PHASE
    bar = xcd_barrier_post(WSP(unsigned, WS_CTL) + CW_BAR, MISC + 8);
#define GRID_BAR() xcd_barrier(bar)
#else
#define GRID_BAR() do {} while (0)
#endif
    const int lo = args.ph_lo, hi = args.ph_hi;
#ifndef PH_MASK
#define PH_MASK 0xffff
#endif
#define IN(k) (((PH_MASK >> (k)) & 1) && lo <= (k) && (k) < hi)
#define SEAM(k) do { if (IN(k) && IN((k) + 1)) GRID_BAR(); } while (0)
    bf16_t* Z = WSP(bf16_t, WS_Z);
    float* x1 = args.out;

    if (IN(0)) { phase0(F, I); } SEAM(0);
    if (IN(1)) {
        phase0b(F, I);
        __syncthreads();
        pg8::Gemm g{WSP(bf16_t, WS_W3S), WSP(bf16_t, WS_HID2), 256, 256, 256};
        pg8::StaticOrder S; S.init(8, 32, F.G, (int)blockIdx.x, 256L * 256 * 2, 256L * 256 * 2);
        EpiFilt E{WSP(_Float16, WS_FILT)};
        pg8::gemm_phase<EpiFilt, pg8::StaticOrder, false>(F.lds, g, S, E);
        __syncthreads();
        weight_transposes(F, I, 0, F.vcu, F.G);
    } SEAM(1);
    if (IN(2)) {
        pg8::Gemm g{WSP(bf16_t, WS_H), WSP(bf16_t, WS_WIN_T), D, D, D};
        InOrder S; S.so.init(64, 37, F.G, (int)blockIdx.x, 256L * D * 2, 256L * D * 2); S.G = F.G; S.c = (int)blockIdx.x;
        EpiIn E{Z, WSP(float, WS_BIASP), WSP(float, WS_GATES)};
        pg8::gemm_phase<EpiIn, InOrder, true>(F.lds, g, S, E);
        const int nfull = (64 * 37 + 26) % F.G, nlight = F.G - nfull;
        __syncthreads();
        if (nfull == 0) weight_transposes(F, I, 1, (int)blockIdx.x, F.G);
        else if ((int)blockIdx.x >= nfull) weight_transposes(F, I, 1, (int)blockIdx.x - nfull, nlight);
    } SEAM(2);
    if (IN(3)) { phase2a(F, I); } SEAM(3);
    if (IN(4)) { phase2b(F, I); } SEAM(4);
    if (IN(5)) {
        pg8::Gemm g{Z + ZC_PAIR, WSP(bf16_t, WS_WA2_T), ZC, 2 * D, 2 * D};
        pg8::StaticOrder S; S.init(64, 4, F.G, (int)blockIdx.x, 256L * ZC * 2, 256L * 2 * D * 2);
        EpiMerge<true> E{Z + ZC_GA, WSP(bf16_t, WS_FSPEC), WSP(bf16_t, WS_H)};
        pg8::gemm_phase<EpiMerge<true>, pg8::StaticOrder, false>(F.lds, g, S, E);
    } SEAM(5);
    if (IN(6)) {
        pg8::Gemm g{WSP(bf16_t, WS_H), WSP(bf16_t, WS_WOUT_T), D, D, D};
        pg8::StaticOrder S; S.init(64, 4, F.G, (int)blockIdx.x, 256L * D * 2, 256L * D * 2);
        EpiRes E{I.x, WSP(float, WS_MODS), x1};
        pg8::gemm_phase<EpiRes, pg8::StaticOrder, false>(F.lds, g, S, E);
        __syncthreads();
        expert_transposes(F, I, 0, 2, F.vcu, F.G);
    } SEAM(6);
    if (IN(7)) {
        for (int blk = F.vcu; blk < M_LAT / 64; blk += F.G) route_item(F, I, x1, blk);
        __syncthreads();
        expert_transposes(F, I, 1, 2, F.vcu, F.G);
    } SEAM(7);
    if (IN(8)) { phase4b(F, I, x1); } SEAM(8);
    if (IN(9)) {
        LAS int* seg_start = (LAS int*)(F.lds + TAB_OFF); LAS int* tile_e = seg_start + 192;
        const int ntiles = moe_tables(F, seg_start, tile_e);
        pg8::Gemm g{WSP(bf16_t, WS_XS), WSP(bf16_t, WS_W13T), D, D, D};
        MoeOrder S{tile_e, ntiles, F.G, F.vcu, 256L * D * 2, 256L * D * 2, 1024L * D * 2};
        EpiMoe1 E{WSP(bf16_t, WS_FSPEC)};
        pg8::gemm_phase<EpiMoe1, MoeOrder, true>(F.lds, g, S, E);
    } SEAM(9);
    if (IN(10)) {
        LAS int* seg_start = (LAS int*)(F.lds + TAB_OFF); LAS int* tile_e = seg_start + 192;
        const int ntiles = moe_tables(F, seg_start, tile_e);
        pg8::Gemm g{WSP(bf16_t, WS_FSPEC), WSP(bf16_t, WS_W2T), DEXP, DEXP, DEXP};
        MoeOrder S{tile_e, ntiles, F.G, F.vcu, 256L * DEXP * 2, 256L * DEXP * 2, 1024L * DEXP * 2};
        EpiBf E{WSP(bf16_t, WS_XS), D};
        pg8::gemm_phase<EpiBf, MoeOrder, true>(F.lds, g, S, E);
    } SEAM(10);
    if (IN(11)) { phase6(F, I, x1); }
#undef IN
#undef SEAM
}

extern "C" void kernel_launch(void* const* d_in, const int* in_sizes, int n_in, void* d_out, int out_size, void* d_ws, size_t ws_size, hipStream_t stream) {
    static int grid = 0;
    if (grid == 0) {
        if (n_in != 32 || in_sizes[0] != M_LAT * D || out_size != M_LAT * D || ws_size < WS_END) {
            fprintf(stderr, "kernel_launch: unexpected problem (n_in %d, in0 %d, out %d, ws %zu < %zu?)\n", n_in, n_in > 0 ? in_sizes[0] : -1, out_size, ws_size, (size_t)WS_END); grid = -1; return; }
        int dev = 0, cus = 0, per_cu = 0;
        if (hipGetDevice(&dev) != hipSuccess || hipDeviceGetAttribute(&cus, hipDeviceAttributeMultiprocessorCount, dev) != hipSuccess) { grid = -1; return; }
        if (hipFuncSetAttribute((const void*)fwd_kernel, hipFuncAttributeMaxDynamicSharedMemorySize, LDS_BYTES) != hipSuccess) { fprintf(stderr, "kernel_launch: hipFuncSetAttribute failed\n"); grid = -1; return; }
        if (hipOccupancyMaxActiveBlocksPerMultiprocessor(&per_cu, (const void*)fwd_kernel, 512, LDS_BYTES) != hipSuccess || per_cu < 1) { fprintf(stderr, "kernel_launch: occupancy query says %d\n", per_cu); per_cu = 1; }
        (void)hipGetLastError();
        grid = cus;
    }
    if (grid < 0) return;
    (void)hipMemsetAsync((char*)d_ws + WS_CTL, 0, CTL_ZERO_BYTES, stream);
    Args a{};
    const float** ip = (const float**)&a.in;
    for (int i = 0; i < 32; ++i) ip[i] = (const float*)d_in[i];
    a.out = (float*)d_out; a.ws = (unsigned char*)d_ws;
#if MK_PER_PHASE
    for (int p = 0; p < N_PHASES; ++p) { a.ph_lo = p; a.ph_hi = p + 1; hipLaunchKernelGGL(fwd_kernel, dim3(grid), dim3(512), LDS_BYTES, stream, a); }
#else
    a.ph_lo = 0; a.ph_hi = N_PHASES;
    hipLaunchKernelGGL(fwd_kernel, dim3(grid), dim3(512), LDS_BYTES, stream, a);
#endif
}
```

```cpp
#include <hip/hip_runtime.h>
#include <cstdio>
#include <cstdint>

#define LAS __attribute__((address_space(3)))
#define GAS __attribute__((address_space(1)))
typedef unsigned short bf16_t;
typedef short bf16x8 __attribute__((ext_vector_type(8)));
typedef short s16x4 __attribute__((ext_vector_type(4)));
typedef float f32x4 __attribute__((ext_vector_type(4)));
typedef float f32x2 __attribute__((ext_vector_type(2)));
typedef unsigned u32x4 __attribute__((ext_vector_type(4)));
typedef unsigned u32x2 __attribute__((ext_vector_type(2)));
typedef GAS unsigned gu32;

constexpr int D = 1024, BATCH = 2, SEQ = 8192, CTXL = 256;
constexpr int M_LAT = BATCH * SEQ, M_CTX = BATCH * CTXL, M_ALL = M_LAT + M_CTX;
constexpr int IN_COLS = 9232, IG0 = 4096, HY0 = 4112, GA0 = 7184, GB0 = 8208;
constexpr int ZC = 9216;
constexpr int ZC_X0 = 4096, ZC_PAIR = 5120, ZC_GA = 7168, ZC_GB = 8192;
constexpr int N_IN = 9472;
constexpr int NEXP = 64, DEXP = 512;
constexpr float EPS = 1e-6f;
constexpr int MAX_TILES = 192, MAX_SLOTS = MAX_TILES * 256;

constexpr size_t MiB = 1u << 20;
constexpr size_t WS_CTL = 0, CTL_ZERO_BYTES = 1 * MiB;
constexpr size_t WS_MODS = 1 * MiB;
constexpr size_t WS_BIASP = WS_MODS + 81920;
constexpr size_t WS_CST = WS_MODS + 122880;
constexpr size_t WS_RSTD2 = WS_MODS + 131072;
constexpr size_t WS_ROUTE = WS_MODS + 262144;
constexpr size_t WS_TOKSLOT = WS_MODS + 524288;
constexpr size_t WS_BLKCNT = WS_MODS + 196608;
constexpr size_t WS_W72S = WS_MODS + 720896;
constexpr size_t WS_GATES = 2 * MiB;
constexpr size_t WS_SCG = 4 * MiB;
constexpr size_t WS_HID2 = 4 * MiB;
constexpr size_t WS_WIN_T = 8 * MiB;
constexpr size_t WS_WA2_T = 27 * MiB;
constexpr size_t WS_WB_T = 31 * MiB;
constexpr size_t WS_WOUT_T = 33 * MiB;
constexpr size_t WS_W3S = 35 * MiB;
constexpr size_t WS_H = 36 * MiB;
constexpr size_t WS_FSPEC = 70 * MiB;
constexpr int FS_PITCH = 8200;
constexpr size_t WS_SCM = 136 * MiB;
constexpr size_t WS_Z = 168 * MiB;
constexpr size_t WS_W13T = 168 * MiB;
constexpr size_t WS_W2T = 296 * MiB;
constexpr size_t WS_XS = 360 * MiB;
constexpr size_t WS_S0T = 466 * MiB;
constexpr size_t WS_QKC = WS_WIN_T;
constexpr size_t WS_FILT = 486 * MiB;
constexpr size_t WS_END = 518 * MiB;
static_assert(WS_Z + (size_t)M_ALL * ZC * 2 <= WS_END && WS_XS + (size_t)MAX_SLOTS * 1024 * 2 <= WS_END, "ws map");
static_assert(WS_FSPEC + (size_t)1024 * FS_PITCH * 8 <= WS_SCM && WS_H + (size_t)M_ALL * D * 2 <= WS_FSPEC, "ws map");
constexpr int CW_BAR = 4096;
constexpr int CW_CNT = 16384, CW_CUR = 16384 + 64;
constexpr int CW_Q0 = 16384 + 256, CW_Q1 = 16384 + 320;
constexpr int CW_SUB = 20480;

constexpr int LDS_BYTES = 160 * 1024;
constexpr int MISC_OFF = 159 * 1024;

#define RLX_AGENT __ATOMIC_RELAXED, __HIP_MEMORY_SCOPE_AGENT
__device__ __forceinline__ unsigned f2bf(float f) { unsigned u = __builtin_bit_cast(unsigned, f); return (u + 0x7fffu + ((u >> 16) & 1u)) >> 16; }
__device__ __forceinline__ unsigned pk2(float lo, float hi) { return f2bf(lo) | (f2bf(hi) << 16); }
__device__ __forceinline__ float bf2f(unsigned short u) { return __builtin_bit_cast(float, (unsigned)u << 16); }
__device__ __forceinline__ float bflo(unsigned w) { return __builtin_bit_cast(float, w << 16); }
__device__ __forceinline__ float bfhi(unsigned w) { return __builtin_bit_cast(float, w & 0xffff0000u); }
__device__ __forceinline__ float sigmoidf_(float x) { return __builtin_amdgcn_rcpf(1.0f + __expf(-x)); }
__device__ __forceinline__ float siluf_(float x) { return x * __builtin_amdgcn_rcpf(1.0f + __expf(-x)); }
__device__ __forceinline__ float wave_sum(float v) {
#pragma unroll
    for (int o = 1; o < 64; o <<= 1) v += __shfl_xor(v, o);
    return v;
}

template <int CTRL, int RM, bool BC> __device__ __forceinline__ float dppf(float old, float x) {
    return __builtin_bit_cast(float, __builtin_amdgcn_update_dpp(__builtin_bit_cast(int, old), __builtin_bit_cast(int, x), CTRL, RM, 0xf, BC)); }
__device__ __forceinline__ float wave_scan_sum(float x) {
    x += dppf<0x111, 0xf, true>(0.f, x); x += dppf<0x112, 0xf, true>(0.f, x); x += dppf<0x114, 0xf, true>(0.f, x); x += dppf<0x118, 0xf, true>(0.f, x);
    x += dppf<0x142, 0xa, false>(0.f, x); x += dppf<0x143, 0xc, false>(0.f, x); return x; }
__device__ __forceinline__ float wave_scan_max(float x) {
    const float ninf = -__builtin_inff();
    x = fmaxf(x, dppf<0x111, 0xf, false>(ninf, x)); x = fmaxf(x, dppf<0x112, 0xf, false>(ninf, x)); x = fmaxf(x, dppf<0x114, 0xf, false>(ninf, x)); x = fmaxf(x, dppf<0x118, 0xf, false>(ninf, x));
    x = fmaxf(x, dppf<0x142, 0xa, false>(ninf, x)); x = fmaxf(x, dppf<0x143, 0xc, false>(ninf, x)); return x; }
__device__ __forceinline__ float lane63(float x) { return __builtin_bit_cast(float, __builtin_amdgcn_readlane(__builtin_bit_cast(int, x), 63)); }

namespace pg8 {
#define PG8_LAS __attribute__((address_space(3)))
constexpr int BM = 256, BK = 64, HALF = 128, HTB = HALF * BK * 2, STAGE_BYTES = 8 * HTB, NXCD = 8, WGM = 8;
__host__ __device__ __forceinline__ int lds_byte(int r, int c) { const int st = (r >> 4) * 2 + (c >> 5), rr = r & 15, cc = c & 31, ob = rr * 64 + cc * 2; return st * 1024 + (ob ^ (((ob >> 9) & 1) << 5)); }
__host__ __device__ __forceinline__ void stage_rc(int b, int& R, int& C) { const int st = b / 1024, sb = b % 1024, swz = sb ^ (((sb >> 9) & 1) << 5); R = (st >> 1) * 16 + swz / 64; C = (st & 1) * 32 + (swz % 64) / 2; }
__host__ __device__ __forceinline__ int perm32(int rho) { const int n = rho >> 4, i = rho & 15; return 8 * (i >> 2) + 4 * n + (i & 3); }

struct Unit { long aoff, boff; int pm, pn, e, pad; };
struct Gemm { const bf16_t* A; const bf16_t* Bt; int lda, ldb, K; };

struct StaticOrder {
    int nM, nN, nwg, G, c; long astep, bstep;
    __device__ void init(int nM_, int nN_, int G_, int c_, long astep_, long bstep_) { nM = nM_; nN = nN_; nwg = nM * nN; G = G_; c = c_; astep = astep_; bstep = bstep_; }
    __device__ bool map(long L, Unit& u) const {
        if (L >= nwg) return false;
        int wgid = (int)L; { const int q = nwg / NXCD, r = nwg % NXCD, xcd = wgid % NXCD, off = wgid / NXCD; wgid = (xcd < r ? xcd * (q + 1) : r * (q + 1) + (xcd - r) * q) + off; }
        const int nig = WGM * nN, gid = wgid / nig, fm = gid * WGM, gsz = (nM - fm) < WGM ? (nM - fm) : WGM;
        u.pm = fm + ((wgid % nig) % gsz); u.pn = (wgid % nig) / gsz; u.e = 0; u.pad = 0; u.aoff = u.pm * astep; u.boff = u.pn * bstep; return true;
    }
    __device__ bool next(int i, Unit& u) const { return map((long)i * G + c, u); }
};

typedef __bf16 bf16v2_t __attribute__((ext_vector_type(2)));
__device__ __forceinline__ unsigned cvt_pk_bf16(float lo, float hi) { const bf16v2_t v = __builtin_convertvector((f32x2){lo, hi}, bf16v2_t); return __builtin_bit_cast(unsigned, v); }

template <class Epi, class Sched, bool ALIGN_EPI>
__device__ __forceinline__ void gemm_phase(PG8_LAS unsigned char* lds, const Gemm g, const Sched& S, const Epi& E) {
    const int tid = threadIdx.x, wid = __builtin_amdgcn_readfirstlane(tid >> 6), lane = tid & 63, wr = wid >> 2, wc = wid & 3, fr = lane & 15, fq = lane >> 4;
    const int K = g.K, nt = K / BK;
    unsigned voffA[2], voffB[2];
#pragma unroll
    for (int i = 0; i < 2; ++i) { int R, C; stage_rc(tid * 16 + i * 8192, R, C); const int Rb = Epi::PERM ? ((R & ~31) + perm32(R & 31)) : R;
        voffA[i] = (unsigned)(R * g.lda + C) * 2u; voffB[i] = (unsigned)(Rb * g.ldb + C) * 2u; }
    const size_t kstep = (size_t)(BK * 2);
    const size_t hstepA = (size_t)HALF * g.lda * 2, hstepB = (size_t)HALF * g.ldb * 2;
    const unsigned ldsw = (unsigned)wid * 1024u;
    const int aoff = lds_byte(wr * 64 + fr, fq * 8), boff = lds_byte(wc * 32 + fr, fq * 8);
#define PG8_SA(b, h) (((b) * 2 + (h)) * HTB)
#define PG8_SB(b, h) ((4 + (b) * 2 + (h)) * HTB)
#define PG8_STAGE(bufoff, gbase, voff) do { _Pragma("unroll") for (int _i = 0; _i < 2; ++_i) \
        __builtin_amdgcn_global_load_lds((const unsigned*)((const char*)(gbase) + (voff)[_i]), (PG8_LAS unsigned*)(lds + (bufoff) + ldsw + _i * 8192), 16, 0, 0); } while (0)
#define PG8_LDA(dst, b, h) do { _Pragma("unroll") for (int m = 0; m < 4; ++m) _Pragma("unroll") for (int k = 0; k < 2; ++k) dst[m][k] = *(const PG8_LAS bf16x8*)(lds + PG8_SA(b, h) + aoff + m * 2048 + k * 1024); } while (0)
#define PG8_LDB(dst, b, h) do { _Pragma("unroll") for (int n = 0; n < 2; ++n) _Pragma("unroll") for (int k = 0; k < 2; ++k) dst[n][k] = *(const PG8_LAS bf16x8*)(lds + PG8_SB(b, h) + boff + n * 2048 + k * 1024); } while (0)
#define PG8_MMA(ai, bj, At, Bt) do { __builtin_amdgcn_s_setprio(1); _Pragma("unroll") for (int m = 0; m < 4; ++m) _Pragma("unroll") for (int n = 0; n < 2; ++n) _Pragma("unroll") for (int k = 0; k < 2; ++k) \
        acc[ai][bj][m][n] = __builtin_amdgcn_mfma_f32_16x16x32_bf16(Bt[n][k], At[m][k], acc[ai][bj][m][n], 0, 0, 0); __builtin_amdgcn_s_setprio(0); } while (0)
#define PG8_WAIT_V(n) asm volatile("s_waitcnt vmcnt(" #n ")" ::: "memory")
#define PG8_WAIT_L(n) asm volatile("s_waitcnt lgkmcnt(" #n ")" ::: "memory")
#define PG8_BAR __builtin_amdgcn_s_barrier()
#define PG8_SCHED __builtin_amdgcn_sched_barrier(0)
    Unit cur, nxt; int ui = 0;
    if (!S.next(0, cur)) return;
    f32x4 acc[2][2][4][2];
#pragma unroll
    for (int a = 0; a < 2; ++a)
#pragma unroll
        for (int b = 0; b < 2; ++b)
#pragma unroll
            for (int m = 0; m < 4; ++m)
#pragma unroll
                for (int n = 0; n < 2; ++n) acc[a][b][m][n] = (f32x4){0.f, 0.f, 0.f, 0.f};
    bf16x8 At[4][2], B0[2][2], B1[2][2];
    const char* cA = (const char*)g.A + cur.aoff; const char* cB = (const char*)g.Bt + cur.boff;
    PG8_STAGE(PG8_SB(0, 0), cB, voffB); PG8_STAGE(PG8_SB(0, 1), cB + hstepB, voffB); PG8_STAGE(PG8_SA(0, 0), cA, voffA); PG8_STAGE(PG8_SA(0, 1), cA + hstepA, voffA);
    if (wr == 1) PG8_BAR;
    PG8_WAIT_V(2); PG8_BAR;
    PG8_STAGE(PG8_SB(1, 0), cB + kstep, voffB); PG8_STAGE(PG8_SA(1, 0), cA + kstep, voffA); PG8_STAGE(PG8_SB(1, 1), cB + hstepB + kstep, voffB);
    PG8_WAIT_V(6); PG8_BAR;
    for (;;) {
        const bool has_next = S.next(ui + 1, nxt);
        const char* nA = has_next ? (const char*)g.A + nxt.aoff : cA; const char* nB = has_next ? (const char*)g.Bt + nxt.boff : cB;
        for (int t = 0; t < nt; t += 2) {
            const bool last = (t == nt - 2);
            const char* a1 = cA + (size_t)(t + 1) * kstep;
            const char* a2 = last ? nA : cA + (size_t)(t + 2) * kstep; const char* b2 = last ? nB : cB + (size_t)(t + 2) * kstep;
            const char* a3 = a2 + kstep; const char* b3 = b2 + kstep;
            PG8_LDB(B0, 0, 0); PG8_LDB(B1, 0, 1); PG8_SCHED; PG8_LDA(At, 0, 0); PG8_STAGE(PG8_SA(1, 1), a1 + hstepA, voffA);
            PG8_WAIT_V(8); PG8_WAIT_L(0); PG8_BAR; PG8_MMA(0, 0, At, B0); PG8_MMA(0, 1, At, B1); PG8_BAR; PG8_SCHED;
            PG8_LDA(At, 0, 1); PG8_STAGE(PG8_SB(0, 0), b2, voffB); PG8_STAGE(PG8_SB(0, 1), b2 + hstepB, voffB); PG8_STAGE(PG8_SA(0, 0), a2, voffA);
            PG8_WAIT_V(8); PG8_WAIT_L(0); PG8_BAR; PG8_MMA(1, 0, At, B0); PG8_MMA(1, 1, At, B1); PG8_BAR; PG8_SCHED;
            PG8_LDB(B0, 1, 0); PG8_LDB(B1, 1, 1); PG8_SCHED; PG8_LDA(At, 1, 0); PG8_STAGE(PG8_SA(0, 1), a2 + hstepA, voffA);
            PG8_WAIT_V(8); PG8_WAIT_L(0); PG8_BAR; PG8_MMA(0, 0, At, B0); PG8_MMA(0, 1, At, B1); PG8_BAR; PG8_SCHED;
            PG8_LDA(At, 1, 1); PG8_STAGE(PG8_SB(1, 0), b3, voffB); PG8_STAGE(PG8_SB(1, 1), b3 + hstepB, voffB); PG8_STAGE(PG8_SA(1, 0), a3, voffA);
            PG8_WAIT_V(8); PG8_WAIT_L(0); PG8_BAR; PG8_MMA(1, 0, At, B0); PG8_MMA(1, 1, At, B1); PG8_BAR; PG8_SCHED;
        }
        if constexpr (ALIGN_EPI) { if (wr == 0) PG8_BAR; }
        E(acc, cur, wr, wc, fr, fq);
        if (!has_next) break;
#pragma unroll
        for (int a = 0; a < 2; ++a)
#pragma unroll
            for (int b = 0; b < 2; ++b)
#pragma unroll
                for (int m = 0; m < 4; ++m)
#pragma unroll
                    for (int n = 0; n < 2; ++n) acc[a][b][m][n] = (f32x4){0.f, 0.f, 0.f, 0.f};
        cur = nxt; cA = nA; cB = nB; ++ui;
        if constexpr (ALIGN_EPI) { if (wr == 1) PG8_BAR; }
    }
    PG8_WAIT_V(0);
    if constexpr (!ALIGN_EPI) { if (wr == 0) PG8_BAR; }
    PG8_BAR;
#undef PG8_SA
#undef PG8_SB
#undef PG8_STAGE
#undef PG8_LDA
#undef PG8_LDB
#undef PG8_MMA
#undef PG8_WAIT_V
#undef PG8_WAIT_L
#undef PG8_BAR
#undef PG8_SCHED
}
}

#define XB_TMO      128
#define XB_XCNT(j)  (256  + 64 * (j))
#define XB_XSUB(j)  (1280 + 64 * (j))
#define XB_XGEN(j)  (2304 + 64 * (j))
#define XB_TOP      3328
#define XB_TOPGEN   3392
#define XCD_BAR_WORDS 3456
#define XB_SPIN_CAP (1u << 18)
__device__ __forceinline__ unsigned xb_ld(unsigned* p)              { return __hip_atomic_load(p, __ATOMIC_RELAXED, __HIP_MEMORY_SCOPE_AGENT); }
__device__ __forceinline__ unsigned xb_add(unsigned* p, unsigned v) { return __hip_atomic_fetch_add(p, v, __ATOMIC_RELAXED, __HIP_MEMORY_SCOPE_AGENT); }
__device__ __forceinline__ unsigned xb_xcc_id() { return (unsigned)__builtin_amdgcn_s_getreg((3 << 11) | 20) & 0xFu; }
#define XB_SPIN(cond, bar) do { unsigned _sp = 0; while (cond) { __builtin_amdgcn_s_sleep(1); \
    if ((++_sp & 255u) == 0u) { if (xb_ld(&(bar)[XB_TMO])) break; if (_sp > XB_SPIN_CAP) { atomicAdd(&(bar)[XB_TMO], 1u); break; } } } } while (0)
struct XcdBarrier { unsigned* bar; unsigned x; volatile LAS unsigned* st; };
__device__ __forceinline__ XcdBarrier xcd_barrier_post(unsigned* bar, volatile LAS unsigned* st) {
    XcdBarrier b; b.bar = bar; b.x = xb_xcc_id(); b.st = st;
    if (threadIdx.x == 0) (void)xb_add(&bar[XB_XCNT(b.x)], 1u);
    return b;
}
__device__ __forceinline__ void xcd_barrier_complete(unsigned* bar, unsigned x, unsigned& nloc, unsigned& nx) {
    const unsigned G = gridDim.x * gridDim.y * gridDim.z;
    unsigned sum, cnt, mine, sp = 0u;
    for (;;) {
        sum = 0u; cnt = 0u; mine = 0u;
#pragma unroll
        for (unsigned j = 0; j < 16; ++j) { const unsigned c = xb_ld(&bar[XB_XCNT(j)]); sum += c; cnt += (c > 0u) ? 1u : 0u; mine = (j == x) ? c : mine; }
        if (sum == G) break;
        __builtin_amdgcn_s_sleep(1);
        if ((++sp & 255u) == 0u) { if (xb_ld(&bar[XB_TMO])) break; if (sp > XB_SPIN_CAP) { atomicAdd(&bar[XB_TMO], 1u); break; } }
    }
    nloc = mine > 0u ? mine : 1u; nx = cnt > 0u ? cnt : 1u;
}
__device__ __forceinline__ void xcd_barrier(const XcdBarrier& b) {
    asm volatile("s_waitcnt vmcnt(0)" ::: "memory");
    __syncthreads();
    if (threadIdx.x == 0) {
        unsigned* bar = b.bar;
        __builtin_amdgcn_s_waitcnt(0);
        unsigned nloc = b.st[0], nx = b.st[1];
        if (nloc == 0u) { xcd_barrier_complete(bar, b.x, nloc, nx); b.st[0] = nloc; b.st[1] = nx; }
        const unsigned old = xb_add(&bar[XB_XSUB(b.x)], 1u);
        const unsigned gen = old / nloc;
        if (old + 1u == (gen + 1u) * nloc) {
            __builtin_amdgcn_fence(__ATOMIC_RELEASE, "agent");
            asm volatile("s_waitcnt vmcnt(0)" ::: "memory");
            const unsigned og = xb_add(&bar[XB_TOP], 1u);
            const unsigned tg = og / nx;
            if (og + 1u == (tg + 1u) * nx) xb_add(&bar[XB_TOPGEN], 1u);
            else XB_SPIN(xb_ld(&bar[XB_TOPGEN]) == tg, bar);
            __builtin_amdgcn_fence(__ATOMIC_ACQUIRE, "agent");
            xb_add(&bar[XB_XGEN(b.x)], 1u);
            asm volatile("s_waitcnt vmcnt(0)" ::: "memory");
        } else {
            XB_SPIN(xb_ld(&bar[XB_XGEN(b.x)]) == gen, bar);
            __builtin_amdgcn_fence(__ATOMIC_ACQUIRE, "agent");
            asm volatile("s_waitcnt vmcnt(0)" ::: "memory");
        }
    }
    __syncthreads();
}

__device__ __forceinline__ void subgrid_barrier(unsigned* cnt, unsigned n, unsigned round) {
    asm volatile("s_waitcnt vmcnt(0)" ::: "memory");
    __syncthreads();
    if (threadIdx.x == 0) {
        __builtin_amdgcn_fence(__ATOMIC_RELEASE, "agent");
        asm volatile("s_waitcnt vmcnt(0)" ::: "memory");
        xb_add(cnt, 1u);
        unsigned sp = 0;
        while (xb_ld(cnt) < n * round) { __builtin_amdgcn_s_sleep(2); if (++sp > (1u << 22)) break; }
        __builtin_amdgcn_fence(__ATOMIC_ACQUIRE, "agent");
        asm volatile("s_waitcnt vmcnt(0)" ::: "memory");
    }
    __syncthreads();
}

struct Inputs {
    const float *x, *c, *ctx, *c_ctx, *w_mod, *b_mod, *g_norm1, *g_norm2, *w_in, *b_in, *w_qk_conv, *b_qk_conv, *w_h_conv, *b_h_conv,
        *hf_w1, *hf_b1, *hf_w2, *hf_b2, *hf_w3, *hf_freq, *h_bias, *w_a, *w_b, *w_out, *w_group, *b_group, *w_router, *b_router, *w1_e, *w3_e, *w2_e, *g_final;
};
struct Args { Inputs in; float* out; unsigned char* ws; int ph_lo, ph_hi; };
struct Frame {
    LAS unsigned char* lds;
    int tid, lane, wave, vcu, G;
    unsigned char* ws;
};
#define WSP(T, off) ((T*)(F.ws + (off)))

__device__ __forceinline__ int win_src(int rho) {
    if (rho < 4096) return rho;
    if (rho < ZC_PAIR) return HY0 + (rho - ZC_X0);
    if (rho < ZC_GA) { const int t = rho - ZC_PAIR, p = t >> 8, bj = (t >> 7) & 1, j = t & 127; return HY0 + 1024 + bj * 1024 + 128 * p + j; }
    if (rho < ZC_GB) return GA0 + (rho - ZC_GA);
    if (rho < ZC) return GB0 + (rho - ZC_GB);
    if (rho < ZC + 16) return IG0 + (rho - ZC);
    return -1;
}
template <class SrcCol>
__device__ __forceinline__ void transpose_item(const float* W, int N, int k0, SrcCol scol, bf16_t* WT, int ldt, int drow0, int kdst, LAS float* scr, int lane) {
    const int sc = scol(lane & 31);
#pragma unroll 16
    for (int i = 0; i < 32; ++i) { const int kk = 2 * i + (lane >> 5); scr[kk * 33 + (lane & 31)] = sc >= 0 ? W[(size_t)(k0 + kk) * N + sc] : 0.f; }
    asm volatile("s_waitcnt lgkmcnt(0)" ::: "memory");
    const int c = lane & 7;
#pragma unroll
    for (int j = 0; j < 4; ++j) { const int n = (lane >> 3) + 8 * j; const LAS float* s = scr + (8 * c) * 33 + n;
        u32x4 o; o.x = pk2(s[0 * 33], s[1 * 33]); o.y = pk2(s[2 * 33], s[3 * 33]); o.z = pk2(s[4 * 33], s[5 * 33]); o.w = pk2(s[6 * 33], s[7 * 33]);
        *(u32x4*)(WT + (size_t)(drow0 + n) * ldt + kdst + 8 * c) = o; }
    asm volatile("s_waitcnt lgkmcnt(0)" ::: "memory");
}


__device__ __forceinline__ void weight_transposes(Frame& F, const Inputs& I, int which, int wg, int nwg) {
    LAS float* scr = (LAS float*)(F.lds + F.wave * 16384);
    const int gw = wg * 8 + F.wave, NGW = nwg * 8;
    {
        constexpr int I_IN = (D / 64) * (N_IN / 32), I_SQ = (D / 64) * (D / 32);
        const int lo = which == 0 ? 0 : I_IN, hi = which == 0 ? I_IN : I_IN + 3 * I_SQ;
        for (int it = lo + gw; it < hi; it += NGW) {
            int r = it;
            if (r < I_IN) { const int nblk = N_IN / 32, kb = r / nblk, nb = r % nblk;
                transpose_item(I.w_in, IN_COLS, 64 * kb, [&](int i) { return win_src(32 * nb + i); }, WSP(bf16_t, WS_WIN_T), D, 32 * nb, 64 * kb, scr, F.lane); continue; }
            r -= I_IN;
            const int m = r / I_SQ, rr = r % I_SQ, kb = rr / 32, nb = rr % 32;
            if (m == 0) { transpose_item(I.w_a, D, 64 * kb, [&](int i) { return 32 * nb + i; }, WSP(bf16_t, WS_WA2_T), 2 * D, 32 * nb, 64 * kb, scr, F.lane);
                          transpose_item(I.w_a, D, 64 * kb, [&](int i) { return 32 * nb + i; }, WSP(bf16_t, WS_WA2_T), 2 * D, 32 * nb, D + 64 * kb, scr, F.lane); }
            else if (m == 1) transpose_item(I.w_b, D, 64 * kb, [&](int i) { return 32 * nb + i; }, WSP(bf16_t, WS_WB_T), D, 32 * nb, 64 * kb, scr, F.lane);
            else transpose_item(I.w_out, D, 64 * kb, [&](int i) { return 32 * nb + i; }, WSP(bf16_t, WS_WOUT_T), D, 32 * nb, 64 * kb, scr, F.lane);
        }
    }
    __syncthreads();
}
__device__ __forceinline__ void phase0(Frame& F, const Inputs& I) {
    LAS float* scr = (LAS float*)(F.lds + F.wave * 16384);
    const int gw = F.vcu * 8 + F.wave, NGW = F.G * 8;
    {
        LAS float* red = (LAS float*)F.lds;
        LAS float* sl = red + 8 * 3 * 32;
        float* mods = WSP(float, WS_MODS);
        for (int i = F.tid; i < 3 * 1024; i += 512) { const int v = i >> 10, k = i & 1023; sl[i] = siluf_(v == 0 ? I.c[k] : v == 1 ? I.c[D + k] : I.c_ctx[k]); }
        __syncthreads();
        for (int it = F.vcu; it < 256; it += F.G) {
            const int col = F.lane & 31, kr = F.lane >> 5, n = it * 24 + col; const bool act = col < 24;
            float a0 = 0.f, a1 = 0.f, a2 = 0.f;
#pragma unroll 16
            for (int i = 0; i < 64; ++i) { const int k = F.wave * 128 + 2 * i + kr; const float w = act ? I.w_mod[(size_t)k * 6144 + n] : 0.f;
                a0 += sl[k] * w; a1 += sl[1024 + k] * w; a2 += sl[2048 + k] * w; }
            a0 += __shfl_xor(a0, 32); a1 += __shfl_xor(a1, 32); a2 += __shfl_xor(a2, 32);
            if (F.lane < 32) { red[(F.wave * 3 + 0) * 32 + col] = a0; red[(F.wave * 3 + 1) * 32 + col] = a1; red[(F.wave * 3 + 2) * 32 + col] = a2; }
            __syncthreads();
            if (F.tid < 96) { const int v = F.tid >> 5, l = F.tid & 31; float s = 0.f;
#pragma unroll
                for (int w = 0; w < 8; ++w) s += red[(w * 3 + v) * 32 + l];
                if (l < 24) mods[v * 6144 + it * 24 + l] = s + I.b_mod[it * 24 + l]; }
            __syncthreads();
        }
    }
    __syncthreads();
    for (int i = F.vcu * 512 + F.tid; i < N_IN; i += F.G * 512) { const int s = win_src(i); WSP(float, WS_BIASP)[i] = s >= 0 ? I.b_in[s] : 0.f; }
    for (int i = F.vcu * 512 + F.tid; i < 80 * 2048; i += F.G * 512) { const int col = i >> 11, which = (i >> 10) & 1, k = i & 1023;
        const float v = col < 8 ? I.w_group[k * 8 + col] : col < 72 ? I.w_router[k * 64 + (col - 8)] : 0.f;
        const unsigned hi = f2bf(v); WSP(bf16_t, WS_W72S)[i] = (bf16_t)(which ? f2bf(v - bf2f((unsigned short)hi)) : hi); }
    {
        bf16_t* hids = WSP(bf16_t, WS_HID2);
        const int j = F.lane;
        const float fr = I.hf_freq[j], b1 = I.hf_b1[j], b2 = I.hf_b2[j];
        for (int pos = gw; pos < SEQ; pos += NGW) {
            const float t = (float)pos / (float)(SEQ - 1);
            float a = b1 + t * I.hf_w1[0 * 64 + j];
#pragma unroll 4
            for (int i = 0; i < 16; ++i) { const float band = 1e-4f + (float)i * ((15.0f - 1e-4f) / 15.0f);
                const float rev = ((float)pos * (1.0f / (float)SEQ)) * band;
                const float sn = __builtin_amdgcn_sinf(rev), cs = __builtin_amdgcn_cosf(rev);
                a += cs * I.hf_w1[(1 + i) * 64 + j] - sn * I.hf_w1[(17 + i) * 64 + j]; }
            const float h1 = __builtin_amdgcn_sinf(fr * a * 0.15915494309189535f);
            float a2 = b2;
#pragma unroll 8
            for (int i = 0; i < 64; ++i) a2 += __shfl(h1, i) * I.hf_w2[i * 64 + j];
            const float h2 = __builtin_amdgcn_sinf(fr * a2 * 0.15915494309189535f);
            const unsigned hi = f2bf(h2), lo = f2bf(h2 - bf2f((unsigned short)hi));
            bf16_t* hp = hids + (size_t)pos * 256;
            hp[j] = (bf16_t)hi; hp[64 + j] = (bf16_t)hi; hp[128 + j] = (bf16_t)lo; hp[192 + j] = 0;
        }
        bf16_t* w3s = WSP(bf16_t, WS_W3S);
        for (int i = F.vcu * 512 + F.tid; i < 2048 * 64; i += F.G * 512) { const int h = i >> 11, col = i & 2047;
            const float wv = I.hf_w3[i]; const unsigned hi = f2bf(wv), lo = f2bf(wv - bf2f((unsigned short)hi));
            bf16_t* wp = w3s + (size_t)col * 256;
            wp[h] = (bf16_t)hi; wp[64 + h] = (bf16_t)lo; wp[128 + h] = (bf16_t)hi; wp[192 + h] = 0; }
    }
}

constexpr int FFT_N = 16384;
__device__ __forceinline__ int PADI(int i) { return i + (i >> 5); }
__device__ __forceinline__ constexpr int bitrev(int x, int bits) { int r = 0; for (int i = 0; i < bits; ++i) r = (r << 1) | ((x >> i) & 1); return r; }
template <int R, int LOG2R>
__device__ __forceinline__ void dft_dif(f32x2 (&v)[R]) {
    constexpr float C32[16] = {1.000000000e+00f, 9.807852804e-01f, 9.238795325e-01f, 8.314696123e-01f, 7.071067812e-01f, 5.555702330e-01f, 3.826834324e-01f, 1.950903220e-01f,
                               0.0f, -1.950903220e-01f, -3.826834324e-01f, -5.555702330e-01f, -7.071067812e-01f, -8.314696123e-01f, -9.238795325e-01f, -9.807852804e-01f};
    constexpr float S32[16] = {0.0f, 1.950903220e-01f, 3.826834324e-01f, 5.555702330e-01f, 7.071067812e-01f, 8.314696123e-01f, 9.238795325e-01f, 9.807852804e-01f,
                               1.0f, 9.807852804e-01f, 9.238795325e-01f, 8.314696123e-01f, 7.071067812e-01f, 5.555702330e-01f, 3.826834324e-01f, 1.950903220e-01f};
#pragma unroll
    for (int st = 0; st < LOG2R; ++st) {
        const int half = R >> (st + 1);
#pragma unroll
        for (int blk = 0; blk < R; blk += 2 * half)
#pragma unroll
            for (int i = 0; i < half; ++i) {
                const f32x2 a = v[blk + i], b = v[blk + i + half];
                v[blk + i] = a + b;
                const f32x2 t = a - b;
                const int ti = i * (16 / half);
                if (ti == 0) v[blk + i + half] = t;
                else if (ti == 8) v[blk + i + half] = (f32x2){t.y, -t.x};
                else { const float c = C32[ti], s = S32[ti]; v[blk + i + half] = (f32x2){t.x * c + t.y * s, t.y * c - t.x * s}; }
            }
    }
}
__device__ __forceinline__ f32x2 cmul(f32x2 a, f32x2 b) { return (f32x2){a.x * b.x - a.y * b.y, a.x * b.y + a.y * b.x}; }
__device__ __forceinline__ f32x2 twid(float frac) { return (f32x2){__builtin_amdgcn_cosf(frac), -__builtin_amdgcn_sinf(frac)}; }
__device__ __forceinline__ void fft_pass_a_store(f32x2 (&v)[32], LAS f32x2* X, int j) {
    dft_dif<32, 5>(v);
    int jq = j; asm volatile("" : "+v"(jq));
    LAS f32x2* xb = X + 33 * jq;
#pragma unroll
    for (int p = 0; p < 32; ++p) xb[bitrev(p, 5)] = v[p];
}
__device__ __forceinline__ void fft_load32(f32x2 (&v)[32], const LAS f32x2* X, int j) {
    int jq = j; asm volatile("" : "+v"(jq));
    const LAS f32x2* xb = X + jq + (jq >> 5);
#pragma unroll
    for (int r = 0; r < 32; ++r) v[r] = xb[528 * r];
}
constexpr int TW_OFF = 144 * 1024;
__device__ __forceinline__ void fft_twiddle_init(LAS unsigned char* lds, int tid) {
    LAS f32x2* T = (LAS f32x2*)(lds + TW_OFF);
    for (int m = tid; m < 1024; m += 512) T[m] = twid((float)m * (1.0f / 1024.0f));
}
__device__ __forceinline__ void fft_pass_b(LAS f32x2* X, int j) {
    f32x2 v[32]; fft_load32(v, X, j);
    int jo = j; asm volatile("" : "+v"(jo));
    const int k = jo & 31;
    j = jo;
    const LAS f32x2* T = (const LAS f32x2*)((const LAS unsigned char*)X + TW_OFF) + k;
#pragma unroll
    for (int r = 1; r < 32; ++r) v[r] = cmul(v[r], T[(r - 1) * k]);
    dft_dif<32, 5>(v);
    __syncthreads();
    LAS f32x2* xb = X + (j >> 5) * 1056 + k;
#pragma unroll
    for (int p = 0; p < 32; ++p) xb[33 * bitrev(p, 5)] = v[p];
}
__device__ __forceinline__ void fft_pass_c_compute(f32x2 (&v)[32], const LAS f32x2* X, int tid) {
#pragma unroll
    for (int u = 0; u < 2; ++u) {
        int jj = tid + 512 * u; asm volatile("" : "+v"(jj)); f32x2 w[16];
#pragma unroll
        for (int r = 0; r < 16; ++r) w[r] = X[jj + (jj >> 5) + 1056 * r];
        const float f1 = (float)jj * (1.0f / 16384.0f);
#pragma unroll
        for (int r = 1; r < 16; ++r) w[r] = cmul(w[r], twid((float)r * f1));
        dft_dif<16, 4>(w);
#pragma unroll
        for (int p = 0; p < 16; ++p) v[16 * u + p] = w[p];
    }
}

__device__ __forceinline__ void filter_spec_item(Frame& F, const Inputs& I, int pair) {
    const int c = 2 * pair, tid = F.tid;
    LAS f32x2* X = (LAS f32x2*)F.lds;
    LAS float* red = (LAS float*)(F.lds + 140 * 1024);
    const _Float16* filt = WSP(_Float16, WS_FILT);
    float ss0 = 0.f, ss1 = 0.f;
    for (int i = 0; i < 16; ++i) {
        const int lag = tid + 512 * i;
        const float f0 = (float)filt[(size_t)c * SEQ + lag], f1 = (float)filt[(size_t)(c + 1) * SEQ + lag], g0 = (float)filt[(size_t)(1024 + c) * SEQ + lag], g1 = (float)filt[(size_t)(1025 + c) * SEQ + lag];
        X[PADI(lag)] = (f32x2){f0, f1}; ss0 += f0 * f0; ss1 += f1 * f1;
        if (lag >= 1) { X[PADI(FFT_N - lag)] = (f32x2){g0, g1}; ss0 += g0 * g0; ss1 += g1 * g1; }
    }
    if (tid == 0) X[PADI(8192)] = (f32x2){0.f, 0.f};
    ss0 = wave_sum(ss0); ss1 = wave_sum(ss1);
    if (F.lane == 0) { red[F.wave * 2] = ss0; red[F.wave * 2 + 1] = ss1; }
    __syncthreads();
    float t0 = 0.f, t1 = 0.f;
#pragma unroll
    for (int w = 0; w < 8; ++w) { t0 += red[2 * w]; t1 += red[2 * w + 1]; }
    const float sc0 = (1.0f / sqrtf(t0 + EPS)) * (1.0f / 16384.0f), sc1 = (1.0f / sqrtf(t1 + EPS)) * (1.0f / 16384.0f);
    {   f32x2 v[32]; fft_load32(v, X, tid); __syncthreads(); fft_pass_a_store(v, X, tid); }
    __syncthreads();
    fft_pass_b(X, tid);
    __syncthreads();
    {   f32x2 v[32]; fft_pass_c_compute(v, X, tid); __syncthreads();
#pragma unroll
        for (int u = 0; u < 2; ++u) { int jj = tid + 512 * u; asm volatile("" : "+v"(jj)); LAS f32x2* xb = X + jj + (jj >> 5);
#pragma unroll
            for (int p = 0; p < 16; ++p) xb[1056 * bitrev(p, 4)] = v[16 * u + p]; } }
    __syncthreads();
    f32x2* fs = WSP(f32x2, WS_FSPEC);
    for (int k = tid; k <= 8192; k += 512) {
        const f32x2 zk = X[PADI(k)], zn = X[PADI((FFT_N - k) & (FFT_N - 1))];
        fs[(size_t)c * FS_PITCH + k] = (f32x2){0.5f * (zk.x + zn.x) * sc0, 0.5f * (zk.y - zn.y) * sc0};
        fs[(size_t)(c + 1) * FS_PITCH + k] = (f32x2){0.5f * (zk.y + zn.y) * sc1, -0.5f * (zk.x - zn.x) * sc1};
    }
    __syncthreads();
}
__device__ __forceinline__ void phase0b(Frame& F, const Inputs& I) {
    const int gw = F.vcu * 8 + F.wave, NGW = F.G * 8;
    const float* mods = WSP(float, WS_MODS);
    {
        bf16_t* H = WSP(bf16_t, WS_H);
        for (int row = gw; row < M_ALL; row += NGW) {
            const float* src = row < M_LAT ? I.x + (size_t)row * D : I.ctx + (size_t)(row - M_LAT) * D;
            const float* md = mods + (row < M_LAT ? row / SEQ : 2) * 6144;
            const f32x4* xr = (const f32x4*)src + F.lane;
            f32x4 v[4]; float s = 0.f;
#pragma unroll
            for (int j = 0; j < 4; ++j) { v[j] = xr[64 * j]; s += (v[j].x * v[j].x + v[j].y * v[j].y) + (v[j].z * v[j].z + v[j].w * v[j].w); }
            const float rstd = 1.0f / sqrtf(wave_sum(s) * (1.0f / D) + EPS);
            u32x2* o8 = (u32x2*)(H + (size_t)row * D) + F.lane;
#pragma unroll
            for (int j = 0; j < 4; ++j) { const int k = 4 * F.lane + 256 * j;
                const f32x4 g = *(const f32x4*)(I.g_norm1 + k), sh = *(const f32x4*)(md + k), sc = *(const f32x4*)(md + 1024 + k);
                const f32x4 h = v[j] * rstd * g * (sc + 1.0f) + sh;
                o8[64 * j] = (u32x2){pk2(h.x, h.y), pk2(h.z, h.w)}; }
        }
    }
    for (int it = gw; it < 144; it += NGW) { const int b = it / 72, j = it % 72; const float* sh2 = mods + b * 6144 + 3 * 1024;
        float s = 0.f;
        for (int k = F.lane; k < 1024; k += 64) s += sh2[k] * (j < 8 ? I.w_group[k * 8 + j] : I.w_router[k * 64 + (j - 8)]);
        s = wave_sum(s);
        if (F.lane == 0) WSP(float, WS_CST)[it] = s + (j < 8 ? I.b_group[j] : I.b_router[j - 8]); }
}

using pg8::Unit; using pg8::cvt_pk_bf16;
struct EpiIn {
    static constexpr bool PERM = true;
    bf16_t* Z; const float* bias; float* gates;
    __device__ __forceinline__ void operator()(const f32x4 (&acc)[2][2][4][2], const Unit& u, int wr, int wc, int fr, int fq) const {
        const int row0 = u.pm * 256 + wr * 64 + fr;
        if (u.pn == 36) {
            if (wc == 0 && fq < 2) {
                const f32x4 b0 = *(const f32x4*)(bias + ZC + 8 * fq), b1 = *(const f32x4*)(bias + ZC + 8 * fq + 4);
#pragma unroll
                for (int ai = 0; ai < 2; ++ai)
#pragma unroll
                    for (int m = 0; m < 4; ++m) { float* gp = gates + (size_t)(row0 + ai * 128 + m * 16) * 16 + 8 * fq;
                        *(f32x4*)gp = acc[ai][0][m][0] + b0; *(f32x4*)(gp + 4) = acc[ai][0][m][1] + b1; }
            }
            return;
        }
        const int col0 = u.pn * 256 + wc * 32 + 8 * fq;
        f32x4 bv[2][2];
#pragma unroll
        for (int bj = 0; bj < 2; ++bj)
#pragma unroll
            for (int n = 0; n < 2; ++n) bv[bj][n] = *(const f32x4*)(bias + col0 + bj * 128 + 4 * n);
#pragma unroll
        for (int ai = 0; ai < 2; ++ai)
#pragma unroll
            for (int m = 0; m < 4; ++m) { bf16_t* rowp = Z + (size_t)(row0 + ai * 128 + m * 16) * ZC + col0;
#pragma unroll
                for (int bj = 0; bj < 2; ++bj) { const f32x4 v0 = acc[ai][bj][m][0] + bv[bj][0], v1 = acc[ai][bj][m][1] + bv[bj][1];
                    u32x4 w; w.x = cvt_pk_bf16(v0[0], v0[1]); w.y = cvt_pk_bf16(v0[2], v0[3]); w.z = cvt_pk_bf16(v1[0], v1[1]); w.w = cvt_pk_bf16(v1[2], v1[3]);
                    *(u32x4*)(rowp + bj * 128) = w; } }
    }
};
template <bool STEP_B> struct EpiMerge {
    static constexpr bool PERM = true;
    const bf16_t* Zg; bf16_t* T1; bf16_t* G;
    __device__ __forceinline__ void operator()(const f32x4 (&acc)[2][2][4][2], const Unit& u, int wr, int wc, int fr, int fq) const {
        const int row0 = u.pm * 256 + wr * 64 + fr, col0 = u.pn * 256 + wc * 32 + 8 * fq;
#pragma unroll
        for (int ai = 0; ai < 2; ++ai)
#pragma unroll
            for (int m = 0; m < 4; ++m) { const size_t row = (size_t)(row0 + ai * 128 + m * 16);
#pragma unroll
                for (int bj = 0; bj < 2; ++bj) {
                    const int col = col0 + bj * 128;
                    const u32x4 gw = *(const u32x4*)(Zg + row * ZC + col);
                    f32x4 g0 = {sigmoidf_(bflo(gw.x)), sigmoidf_(bfhi(gw.x)), sigmoidf_(bflo(gw.y)), sigmoidf_(bfhi(gw.y))};
                    f32x4 g1 = {sigmoidf_(bflo(gw.z)), sigmoidf_(bfhi(gw.z)), sigmoidf_(bflo(gw.w)), sigmoidf_(bfhi(gw.w))};
                    f32x4 v0 = g0 * acc[ai][bj][m][0], v1 = g1 * acc[ai][bj][m][1];
                    bf16_t* tp = T1 + row * D + col;
                    if constexpr (!STEP_B) { u32x4 w; w.x = cvt_pk_bf16(v0[0], v0[1]); w.y = cvt_pk_bf16(v0[2], v0[3]); w.z = cvt_pk_bf16(v1[0], v1[1]); w.w = cvt_pk_bf16(v1[2], v1[3]); *(u32x4*)tp = w; }
                    else { const u32x4 t = *(const u32x4*)tp;
                        v0 += (f32x4){bflo(t.x), bfhi(t.x), bflo(t.y), bfhi(t.y)}; v1 += (f32x4){bflo(t.z), bfhi(t.z), bflo(t.w), bfhi(t.w)};
                        u32x4 w; w.x = cvt_pk_bf16(v0[0], v0[1]); w.y = cvt_pk_bf16(v0[2], v0[3]); w.z = cvt_pk_bf16(v1[0], v1[1]); w.w = cvt_pk_bf16(v1[2], v1[3]);
                        *(u32x4*)(G + row * D + col) = w; }
                } }
    }
};
struct EpiRes {
    static constexpr bool PERM = false;
    const float* x; const float* mods; float* out;
    __device__ __forceinline__ void operator()(const f32x4 (&acc)[2][2][4][2], const Unit& u, int wr, int wc, int fr, int fq) const {
        const int row0 = u.pm * 256 + wr * 64 + fr, col0 = u.pn * 256 + wc * 32 + 4 * fq;
        const float* gate = mods + (u.pm * 256 / SEQ) * 6144 + 2 * 1024;
        f32x4 gv[2][2];
#pragma unroll
        for (int bj = 0; bj < 2; ++bj)
#pragma unroll
            for (int n = 0; n < 2; ++n) gv[bj][n] = *(const f32x4*)(gate + col0 + bj * 128 + n * 16);
#pragma unroll
        for (int ai = 0; ai < 2; ++ai)
#pragma unroll
            for (int m = 0; m < 4; ++m) { const size_t off = (size_t)(row0 + ai * 128 + m * 16) * D + col0;
#pragma unroll
                for (int bj = 0; bj < 2; ++bj)
#pragma unroll
                    for (int n = 0; n < 2; ++n) *(f32x4*)(out + off + bj * 128 + n * 16) = *(const f32x4*)(x + off + bj * 128 + n * 16) + gv[bj][n] * acc[ai][bj][m][n]; }
    }
};
struct EpiMoe1 {
    static constexpr bool PERM = true;
    bf16_t* H2;
    __device__ __forceinline__ void operator()(const f32x4 (&acc)[2][2][4][2], const Unit& u, int wr, int wc, int fr, int fq) const {
        const int row0 = u.pm * 256 + wr * 64 + fr, col0 = u.pn * 128 + wc * 32 + 8 * fq;
#pragma unroll
        for (int ai = 0; ai < 2; ++ai)
#pragma unroll
            for (int m = 0; m < 4; ++m) { const size_t row = (size_t)(row0 + ai * 128 + m * 16);
                f32x4 v0, v1;
#pragma unroll
                for (int i = 0; i < 4; ++i) { v0[i] = siluf_(acc[ai][0][m][0][i]) * acc[ai][1][m][0][i]; v1[i] = siluf_(acc[ai][0][m][1][i]) * acc[ai][1][m][1][i]; }
                u32x4 w; w.x = cvt_pk_bf16(v0[0], v0[1]); w.y = cvt_pk_bf16(v0[2], v0[3]); w.z = cvt_pk_bf16(v1[0], v1[1]); w.w = cvt_pk_bf16(v1[2], v1[3]);
                *(u32x4*)(H2 + row * DEXP + col0) = w; }
    }
};
struct EpiBf {
    static constexpr bool PERM = true;
    bf16_t* O; int ldo;
    __device__ __forceinline__ void operator()(const f32x4 (&acc)[2][2][4][2], const Unit& u, int wr, int wc, int fr, int fq) const {
        const int row0 = u.pm * 256 + wr * 64 + fr, col0 = u.pn * 256 + wc * 32 + 8 * fq;
#pragma unroll
        for (int ai = 0; ai < 2; ++ai)
#pragma unroll
            for (int m = 0; m < 4; ++m) { bf16_t* rowp = O + (size_t)(row0 + ai * 128 + m * 16) * ldo + col0;
#pragma unroll
                for (int bj = 0; bj < 2; ++bj) { const f32x4 v0 = acc[ai][bj][m][0], v1 = acc[ai][bj][m][1];
                    u32x4 w; w.x = cvt_pk_bf16(v0[0], v0[1]); w.y = cvt_pk_bf16(v0[2], v0[3]); w.z = cvt_pk_bf16(v1[0], v1[1]); w.w = cvt_pk_bf16(v1[2], v1[3]);
                    *(u32x4*)(rowp + bj * 128) = w; } }
    }
};
struct EpiFilt {
    static constexpr bool PERM = false;
    _Float16* FILT;
    __device__ __forceinline__ void operator()(const f32x4 (&acc)[2][2][4][2], const Unit& u, int wr, int wc, int fr, int fq) const {
        typedef _Float16 h16x4 __attribute__((ext_vector_type(4)));
        const int row0 = u.pm * 256 + wr * 64 + fr, col0 = u.pn * 256 + wc * 32 + 4 * fq;
        const float dmin = -4.605170186f / 1.5f, dmax = -4.605170186f / 0.3f;
#pragma unroll
        for (int ai = 0; ai < 2; ++ai)
#pragma unroll
            for (int m = 0; m < 4; ++m) { const int r = row0 + ai * 128 + m * 16;
                const float dc = fabsf(dmin + (float)(r & 1023) * ((dmax - dmin) / 1023.0f)) * (1.0f / (float)(SEQ - 1));
#pragma unroll
                for (int bj = 0; bj < 2; ++bj)
#pragma unroll
                    for (int n = 0; n < 2; ++n) { const int lag = col0 + bj * 128 + n * 16; h16x4 o;
#pragma unroll
                        for (int i = 0; i < 4; ++i) o[i] = (_Float16)(acc[ai][bj][m][n][i] * __expf(-(float)(lag + i) * dc));
                        *(h16x4*)(FILT + (size_t)r * SEQ + lag) = o; } }
    }
};
struct InOrder {
    pg8::StaticOrder so; int G, c;
    __device__ bool next(int i, Unit& u) const {
        long L = (long)i * G + c;
        if (L < 64 * 37) return so.map(L, u);
        L -= 64 * 37; if (L >= 26) return false;
        const int j = (int)(L % 13); u.pm = 64 + (int)(L / 13); u.pn = j < 12 ? j : 36; u.e = 0; u.pad = 0; u.aoff = u.pm * so.astep; u.boff = u.pn * so.bstep; return true;
    }
};
struct MoeOrder {
    const LAS int* tile_e; int ntiles, G, c; long astep, bstep, estep;
    __device__ bool next(int i, Unit& u) const {
        const long L = (long)i * G + c; if (L >= (long)ntiles * 4) return false;
        u.pm = (int)(L >> 2); u.pn = (int)(L & 3); u.e = tile_e[u.pm]; u.pad = 0; u.aoff = u.pm * astep; u.boff = u.e * estep + u.pn * bstep; return true;
    }
};

__device__ __forceinline__ void qk_item(Frame& F, const Inputs& I, int b, int head, int ci) {
    constexpr int RPITCH = 1040, QP = 528, O_RAW = 0, O_QS = 69632, O_KS = 103424;
    bf16_t* Z = WSP(bf16_t, WS_Z); bf16_t* QKC = WSP(bf16_t, WS_QKC);
    LAS unsigned char* L = F.lds;
    const int tid = F.tid, lane = F.lane, w = F.wave, fr = lane & 15, fq = lane >> 4;
    const bool is_ctx = ci < 4; const int j = is_ctx ? ci : ci - 4;
    const int rbase = is_ctx ? M_LAT + b * CTXL : b * SEQ, t0 = 64 * j;
    const int seg_lo = is_ctx ? 0 : t0, seg_hi = is_ctx ? CTXL : t0 + 64;
    for (int id = tid; id < 66 * 64; id += 512) { const int r = id >> 6, c = id & 63, t = t0 - 1 + r;
        u32x4 v = {0u, 0u, 0u, 0u};
        if (t >= seg_lo && t < seg_hi) v = *(const u32x4*)(Z + (size_t)(rbase + t) * ZC + (c >> 5) * 1024 + head * 256 + 8 * (c & 31));
        *(LAS u32x4*)(L + O_RAW + r * RPITCH + c * 16) = v; }
    const int cc = tid & 63, colabs = (cc >> 5) * 1024 + head * 256 + 8 * (cc & 31);
    float wt[3][8], bs[8];
#pragma unroll
    for (int k = 0; k < 4; ++k) { const float* wp = k < 3 ? I.w_qk_conv + k * 2048 + colabs : I.b_qk_conv + colabs; const f32x4 lo = *(const f32x4*)wp, hi = *(const f32x4*)(wp + 4);
#pragma unroll
        for (int e = 0; e < 4; ++e) { if (k < 3) { wt[k][e] = lo[e]; wt[k][4 + e] = hi[e]; } else { bs[e] = lo[e]; bs[4 + e] = hi[e]; } } }
    const float osc = cc >= 32 ? 0.0625f : 1.0f;
    __syncthreads();
#pragma unroll 2
    for (int i = 0; i < 8; ++i) { const int r = (tid >> 6) + 8 * i;
        const u32x4 c0 = *(const LAS u32x4*)(L + O_RAW + r * RPITCH + cc * 16), c1 = *(const LAS u32x4*)(L + O_RAW + (r + 1) * RPITCH + cc * 16), c2 = *(const LAS u32x4*)(L + O_RAW + (r + 2) * RPITCH + cc * 16);
        float o[8];
#pragma unroll
        for (int h = 0; h < 4; ++h) {
            const float v0 = wt[0][2 * h] * bflo(c0[h]) + wt[1][2 * h] * bflo(c1[h]) + wt[2][2 * h] * bflo(c2[h]) + bs[2 * h];
            const float v1 = wt[0][2 * h + 1] * bfhi(c0[h]) + wt[1][2 * h + 1] * bfhi(c1[h]) + wt[2][2 * h + 1] * bfhi(c2[h]) + bs[2 * h + 1];
            o[2 * h] = siluf_(v0) * osc; o[2 * h + 1] = siluf_(v1) * osc; }
        u32x4 ov; ov.x = pk2(o[0], o[1]); ov.y = pk2(o[2], o[3]); ov.z = pk2(o[4], o[5]); ov.w = pk2(o[6], o[7]);
        *(LAS u32x4*)(L + (cc >= 32 ? O_KS : O_QS) + r * QP + (cc & 31) * 16) = ov;
        if (is_ctx) *(u32x4*)(QKC + (size_t)(b * CTXL + t0 + r) * ZC + colabs) = ov;
        else *(u32x4*)(Z + (size_t)(rbase + t0 + r) * ZC + colabs) = ov; }
    __syncthreads();
    {
        bf16_t* S0T = WSP(bf16_t, WS_S0T) + ((size_t)((b * 4 + head) * 132 + ci)) * 8192;
        const int tb = w >> 1;
#pragma unroll
        for (int sbi = 0; sbi < 2; ++sbi) { const int sb = 2 * (w & 1) + sbi;
            f32x4 acc = {0.f, 0.f, 0.f, 0.f};
#pragma unroll
            for (int kk = 0; kk < 8; ++kk) {
                const bf16x8 ka = *(const LAS bf16x8*)(L + O_KS + (16 * sb + fr) * QP + (32 * kk + 8 * fq) * 2);
                const bf16x8 qb = *(const LAS bf16x8*)(L + O_QS + (16 * tb + fr) * QP + (32 * kk + 8 * fq) * 2);
                acc = __builtin_amdgcn_mfma_f32_16x16x32_bf16(ka, qb, acc, 0, 0, 0); }
            const int t = 16 * tb + fr, s0 = 16 * sb + 4 * fq;
            u32x2 o; o.x = cvt_pk_bf16(s0 <= t ? acc[0] : 0.f, s0 + 1 <= t ? acc[1] : 0.f); o.y = cvt_pk_bf16(s0 + 2 <= t ? acc[2] : 0.f, s0 + 3 <= t ? acc[3] : 0.f);
            *(u32x2*)(S0T + t * 64 + s0) = o;
            o.x = cvt_pk_bf16(s0 + 3 >= t ? acc[3] : 0.f, s0 + 2 >= t ? acc[2] : 0.f); o.y = cvt_pk_bf16(s0 + 1 >= t ? acc[1] : 0.f, s0 >= t ? acc[0] : 0.f);
            *(u32x2*)(S0T + 4096 + (63 - t) * 64 + (60 - s0)) = o; }
    }
    __syncthreads();
}
__device__ __forceinline__ void hyprep_item(Frame& F, const Inputs& I, int tb, int chb) {
    const bf16_t* Z = WSP(bf16_t, WS_Z); bf16_t* SCM = WSP(bf16_t, WS_SCM);
    constexpr int PITCH = 144;
    LAS unsigned char* X1T = F.lds; LAS unsigned char* VT = F.lds + 64 * PITCH;
    const int p = chb >> 1, j0 = (chb & 1) * 64;
    LAS float* HP = (LAS float*)(F.lds + 2 * 64 * PITCH);
    {   const int r = F.tid >> 3, cc = F.tid & 7; const bf16_t* src = Z + (size_t)(tb * 64 + r) * ZC + ZC_PAIR + 256 * p + j0 + 8 * cc;
        *(LAS u32x4*)(X1T + r * PITCH + cc * 16) = *(const u32x4*)src;
        *(LAS u32x4*)(VT + r * PITCH + cc * 16) = *(const u32x4*)(src + 128);
        const int pp = F.tid >> 6, pc = chb * 64 + (F.tid & 63);
        HP[F.tid] = pp < 3 ? I.w_h_conv[pp * 3072 + 1024 + pc] : pp < 6 ? I.w_h_conv[(pp - 3) * 3072 + 2048 + pc] : pp == 6 ? I.b_h_conv[1024 + pc] : I.b_h_conv[2048 + pc]; }
    __syncthreads();
    {   const int ch = F.tid >> 3, t8 = (F.tid & 7) * 8, c = chb * 64 + ch;
        float wx[3], wv[3];
#pragma unroll
        for (int k = 0; k < 3; ++k) { wx[k] = HP[k * 64 + ch]; wv[k] = HP[(3 + k) * 64 + ch]; }
        const float bx = HP[6 * 64 + ch], bv = HP[7 * 64 + ch];
        float xs[10], vs[10];
#pragma unroll
        for (int i = 0; i < 10; ++i) { const int r = t8 - 1 + i; const bool ok = r >= 0 && r < 64;
            xs[i] = ok ? bf2f(*(const LAS bf16_t*)(X1T + r * PITCH + ch * 2)) : 0.f; vs[i] = ok ? bf2f(*(const LAS bf16_t*)(VT + r * PITCH + ch * 2)) : 0.f; }
        float s[8];
#pragma unroll
        for (int i = 0; i < 8; ++i) s[i] = (wx[0] * xs[i] + wx[1] * xs[i + 1] + wx[2] * xs[i + 2] + bx) * (wv[0] * vs[i] + wv[1] * vs[i + 1] + wv[2] * vs[i + 2] + bv);
        u32x4 o; o.x = pk2(s[0], s[1]); o.y = pk2(s[2], s[3]); o.z = pk2(s[4], s[5]); o.w = pk2(s[6], s[7]);
        const int b = tb >> 7, t0 = (tb & 127) * 64;
        *(u32x4*)(SCM + ((size_t)(b * 1024 + c)) * SEQ + t0 + t8) = o; }
    __syncthreads();
}
__device__ __forceinline__ void gatescan_item(Frame& F, int b, int g) {
    if (F.wave == 0) {
        const int dir = g >> 2, head = g & 3, gi = dir * 4 + head, lane = F.lane;
        const float* gates = WSP(float, WS_GATES);
        float* scg = WSP(float, WS_SCG) + (size_t)((b * 8 + g) * 132) * 384;
        auto gaddr = [&](int st) { const bool ctx = st < 4; const int j = ctx ? st : st - 4, sl = ctx ? CTXL : SEQ, rbase = ctx ? M_LAT + b * CTXL : b * SEQ;
            const int tlo = dir == 0 ? 64 * j : sl - 64 * (j + 1), t = dir == 0 ? tlo + lane : tlo + 63 - lane; return gates + (size_t)(rbase + t) * 16 + gi; };
        float ig[4], fg[4], nig[4], nfg[4];
#pragma unroll
        for (int j = 0; j < 4; ++j) { const float* p = gaddr(j); ig[j] = p[0]; fg[j] = p[8]; }
        float mrun = 0.f;
        for (int s0 = 0; s0 < 132; s0 += 4) {
            if (s0 + 4 < 132) {
#pragma unroll
                for (int j = 0; j < 4; ++j) { const float* p = gaddr(s0 + 4 + j); nig[j] = p[0]; nfg[j] = p[8]; } }
#pragma unroll
            for (int j = 0; j < 4; ++j) {
                const float mprev = mrun;
                const float fc = fminf(fg[j], 0.f) - __logf(1.0f + __expf(-fabsf(fg[j])));
                const float bcum = wave_scan_sum(fc);
                const float aval = ig[j] - bcum;
                const float cm = fmaxf(mprev, wave_scan_max(aval));
                const float cm63 = lane63(cm), b63 = lane63(bcum);
                mrun = b63 + cm63;
                float* sc = scg + (size_t)(s0 + j) * 384 + lane;
                sc[0] = __expf(fminf(cm63 - cm, 80.f)); sc[64] = 0.f; sc[128] = __expf(mprev - cm); sc[192] = __expf(-(bcum + cm)); sc[256] = __expf(aval - cm63);
                sc[320] = lane == 0 ? __expf(mprev - cm63) : 0.f;
            }
#pragma unroll
            for (int j = 0; j < 4; ++j) { ig[j] = nig[j]; fg[j] = nfg[j]; }
        }
    }
    __syncthreads();
}
__device__ __forceinline__ void phase2a(Frame& F, const Inputs& I) {
    unsigned* q1 = WSP(unsigned, WS_CTL) + CW_Q1;
    volatile LAS int* itp = (volatile LAS int*)(F.lds + MISC_OFF + 64);
    if (F.tid == 0) *itp = (int)atomicAdd(q1, 1u);
    __syncthreads();
    int it = *itp;
    __syncthreads();
    while (it < 16 + 1056 + 4096) {
        int nxt = 0;
        if (F.tid == 0) nxt = (int)atomicAdd(q1, 1u);
        if (it < 16) gatescan_item(F, it >> 3, it & 7);
        else if (it < 16 + 1056) { const int q = it - 16; qk_item(F, I, q / 528, (q / 132) & 3, q % 132); }
        else { const int j = it - 16 - 1056; hyprep_item(F, I, j >> 4, j & 15); }
        if (F.tid == 0) *itp = nxt;
        __syncthreads();
        it = *itp;
        __syncthreads();
    }
}

__device__ __forceinline__ bf16x8 tr_frag(const LAS unsigned char* p0, const LAS unsigned char* p1) {
    const s16x4 a = __builtin_amdgcn_ds_read_tr16_b64_v4i16((LAS s16x4*)p0);
    const s16x4 b = __builtin_amdgcn_ds_read_tr16_b64_v4i16((LAS s16x4*)p1);
    return (bf16x8){a[0], a[1], a[2], a[3], b[0], b[1], b[2], b[3]};
}
__device__ __forceinline__ void mlstm_item(Frame& F, const Inputs& I, int item) {
    constexpr int QP = 528, VP = 112, PP = 144;
    constexpr int O_QS = 0, O_KS = 33792, O_VW = 67584, O_PS = 74752, O_CS = 83968, CS_BYTES = 25344, O_DEN = 134656, O_SC = 135168, SC_BYTES = 6 * 64 * 4, O_OS = 138240, OS_BYTES = 5120, O_OUT = 148480, OP = 80;
    const int b = item >> 6, g = (item >> 3) & 7, dir = g >> 2, head = g & 3, eb = item & 7;
    int tid = F.tid; asm volatile("" : "+v"(tid));
    const int lane = tid & 63, w = F.wave, fr = lane & 15, fq = lane >> 4;
    LAS unsigned char* L = F.lds;
    const unsigned char* wsb = F.ws;
    const int qcol = head * 256, vcol = 2048 + head * 256 + eb * 32, ocol = 3072 + head * 256 + eb * 32;
    const int outcol = ZC_PAIR + dir * 1024 + head * 256 + eb * 32;
    const int gi = dir * 4 + head;
    for (int i = tid; i < 64 * 16; i += 512) { const int r = i >> 4, cidx = 32 + (i & 15);
        *(LAS bf16_t*)(L + O_VW + r * VP + cidx * 2) = (bf16_t)0; }
    for (int i = tid; i < 2 * CS_BYTES / 4; i += 512) *(LAS unsigned*)(L + O_CS + 4 * i) = 0u;
    f32x4 Cacc[2][3];
#pragma unroll
    for (int a = 0; a < 2; ++a)
#pragma unroll
        for (int c = 0; c < 3; ++c) Cacc[a][c] = (f32x4){0.f, 0.f, 0.f, 0.f};
    struct Stage { u32x4 q[4], k[4], vo, s; f32x4 sc; };
    Stage R0, R1;
    const int scc = tid & 31, srow0 = tid >> 5;
    const int ppos = tid >> 3, ps8 = (tid & 7) * 8;
    auto geom = [&](int st, int& rbase, int& tlo, int& ci) { const bool ctx = st < 4; const int j = ctx ? st : st - 4, sl = ctx ? CTXL : SEQ;
        rbase = ctx ? M_LAT + b * CTXL : b * SEQ; tlo = dir == 0 ? 64 * j : sl - 64 * (j + 1); ci = (ctx ? 0 : 4) + (tlo >> 6); };
    constexpr unsigned PITCH = (unsigned)(ZC * 2);
    const unsigned vo_g = (unsigned)(tid < 96 ? tid : 95) * 16u;
    unsigned vo_q[4];
#pragma unroll
    for (int i = 0; i < 4; ++i) vo_q[i] = (unsigned)(srow0 + 16 * i) * PITCH + (unsigned)qcol * 2u + (unsigned)scc * 16u;
    const unsigned vo_v = (unsigned)((tid & 255) >> 2) * PITCH + (unsigned)(tid < 256 ? vcol : ocol) * 2u + (unsigned)(tid & 3) * 16u;
    const unsigned vo_s = (unsigned)(ppos * 64 + ps8) * 2u;
    auto prefetch_a = [&](int st, Stage& R) { int rbase, tlo, ci; geom(st, rbase, tlo, ci);
        R.sc = *(const f32x4*)(wsb + ((unsigned)WS_SCG + (unsigned)((b * 8 + g) * 132 + st) * 1536u) + vo_g);
        const unsigned char* uq = wsb + (st < 4 ? (unsigned)WS_QKC + (unsigned)(b * CTXL + tlo) * PITCH : (unsigned)WS_Z + (unsigned)(rbase + tlo) * PITCH);
#pragma unroll
        for (int i = 0; i < 4; ++i) R.q[i] = *(const u32x4*)(uq + vo_q[i]); };
    auto prefetch_b = [&](int st, Stage& R) { int rbase, tlo, ci; geom(st, rbase, tlo, ci);
        const unsigned char* uq = wsb + (st < 4 ? (unsigned)WS_QKC + (unsigned)(b * CTXL + tlo) * PITCH : (unsigned)WS_Z + (unsigned)(rbase + tlo) * PITCH);
#pragma unroll
        for (int i = 0; i < 4; ++i) R.k[i] = *(const u32x4*)(uq + vo_q[i] + 2048u); };
    auto prefetch_c = [&](int st, Stage& R) { int rbase, tlo, ci; geom(st, rbase, tlo, ci);
        R.vo = *(const u32x4*)(wsb + ((unsigned)WS_Z + (unsigned)(rbase + tlo) * PITCH) + vo_v);
        R.s = *(const u32x4*)(wsb + ((unsigned)WS_S0T + (unsigned)(((b * 4 + head) * 132 + ci) * 2 + dir) * 8192u) + vo_s); };
    auto prefetch = [&](int st, Stage& R) { prefetch_a(st, R); prefetch_b(st, R); prefetch_c(st, R); };
    auto commit = [&](int buf, const Stage& R) {
        const LAS float* SCn = (const LAS float*)(L + O_SC + buf * SC_BYTES);
#pragma unroll
        for (int i = 0; i < 4; ++i) { const int mr = srow0 + 16 * i, p = dir ? 63 - mr : mr; *(LAS u32x4*)(L + O_QS + p * QP + scc * 16) = R.q[i]; *(LAS u32x4*)(L + O_KS + p * QP + scc * 16) = R.k[i]; }
        if (tid < 256) { const int mr = tid >> 2, p = dir ? 63 - mr : mr; const u32x4 pv = R.vo;
            const float wg = SCn[256 + p]; u32x4 vo;
            vo.x = cvt_pk_bf16(bflo(pv.x) * wg, bfhi(pv.x) * wg); vo.y = cvt_pk_bf16(bflo(pv.y) * wg, bfhi(pv.y) * wg); vo.z = cvt_pk_bf16(bflo(pv.z) * wg, bfhi(pv.z) * wg); vo.w = cvt_pk_bf16(bflo(pv.w) * wg, bfhi(pv.w) * wg);
            *(LAS u32x4*)(L + O_VW + p * VP + (tid & 3) * 16) = vo; }
        else { const int mr = (tid & 255) >> 2, p = dir ? 63 - mr : mr; *(LAS u32x4*)(L + O_OS + buf * OS_BYTES + p * OP + (tid & 3) * 16) = R.vo;
            if (tid < 320) { const int p1 = tid - 256; *(LAS bf16_t*)(L + O_VW + p1 * VP + 64) = (bf16_t)f2bf(SCn[256 + p1]); } }
        *(LAS u32x4*)(L + O_PS + ppos * PP + ps8 * 2) = R.s; };
#define LDS_BAR() do { asm volatile("s_waitcnt lgkmcnt(0)" ::: "memory"); __builtin_amdgcn_s_barrier(); asm volatile("" ::: "memory"); } while (0)
    auto scalars = [&](const Stage& R, int buf) { if (tid < 96) *(LAS f32x4*)(L + O_SC + buf * SC_BYTES + tid * 16) = R.sc; };
    prefetch(0, R0);
    scalars(R0, 0);
    __syncthreads();
    commit(0, R0);
    prefetch(1, R1);
    __syncthreads();
    int cur = 0;
    auto flush_out = [&](int sp) { int rbase, tlo, ci; geom(sp < 0 ? 0 : sp, rbase, tlo, ci);
        const int p = (tid & 255) >> 2, tok = dir == 0 ? p : 63 - p; const bool real = sp >= 4 && tid < 256;
        const u32x4 o = *(const LAS u32x4*)(L + O_OUT + p * OP + (tid & 3) * 16);
        const unsigned off = real ? (unsigned)WS_Z + (unsigned)(rbase + tlo + tok) * PITCH + (unsigned)outcol * 2u + (unsigned)(tid & 3) * 16u
                                  : (unsigned)WS_Z + (unsigned)(M_LAT + (tid & 255)) * PITCH + (unsigned)ZC_GB * 2u + (unsigned)(tid >> 8) * 16u;
        *(u32x4*)(F.ws + off) = o; };
    auto step = [&](int st, Stage& RA, Stage& RB) {
        const bool has_next = st + 1 < 132, is_ctx = st < 4;
        int rbase_c, tlo_c, ci_c; geom(st, rbase_c, tlo_c, ci_c);
        const int st2 = st + 2 < 132 ? st + 2 : 131;
        flush_out(st - 1);
        prefetch_a(st2, RA);
        const LAS float* SC = (const LAS float*)(L + O_SC + cur * SC_BYTES);
        const float c_decay = SC[320];
        const int tt = w & 3, et = w >> 2;
        const int trg = lane >> 4, trq = (lane & 15) >> 2, trp = lane & 3;
        f32x4 nacc;
        {
            const LAS unsigned char* CSc = L + O_CS + cur * CS_BYTES;
            const f32x4 cs4 = *(const LAS f32x4*)(SC + 128 + 16 * tt + 4 * fq), rs4 = *(const LAS f32x4*)(SC + 16 * tt + 4 * fq);
            const f32x4 z4 = {0.f, 0.f, 0.f, 0.f};
            const LAS unsigned char* qrow = L + O_QS + (16 * tt + fr) * QP + 16 * fq;
            const LAS unsigned char* crow = CSc + (16 * et + fr) * QP + 16 * fq;
            const LAS unsigned char* drow = CSc + (32 + fr) * QP + 16 * fq + 256 * et;
            const LAS unsigned char* qrow2 = qrow + 256 * et;
            bf16x8 qa[8], cb[8], qd[4], cd[4];
#pragma unroll
            for (int kk = 0; kk < 8; ++kk) { qa[kk] = *(const LAS bf16x8*)(qrow + 64 * kk); cb[kk] = *(const LAS bf16x8*)(crow + 64 * kk); }
#pragma unroll
            for (int j = 0; j < 4; ++j) { qd[j] = *(const LAS bf16x8*)(qrow2 + 64 * j); cd[j] = *(const LAS bf16x8*)(drow + 64 * j); }
            bf16x8 pa[2], vb[2];
#pragma unroll
            for (int ks = 0; ks < 2; ++ks) { pa[ks] = *(const LAS bf16x8*)(L + O_PS + (16 * tt + fr) * PP + (32 * ks + 8 * fq) * 2);
                const LAS unsigned char* vp = L + O_VW + (32 * ks + 8 * trg + trq) * VP + (16 * et + 4 * trp) * 2; vb[ks] = tr_frag(vp, vp + 4 * VP); }
            const bf16x8 pd = *(const LAS bf16x8*)(L + O_PS + (16 * tt + fr) * PP + (32 * et + 8 * fq) * 2);
            const LAS unsigned char* vdp = L + O_VW + (32 * et + 8 * trg + trq) * VP + (32 + 4 * trp) * 2;
            const bf16x8 vd = tr_frag(vdp, vdp + 4 * VP);
            f32x4 a0 = __builtin_amdgcn_mfma_f32_16x16x32_bf16(qa[0], cb[0], z4, 0, 0, 0);
            f32x4 a1 = __builtin_amdgcn_mfma_f32_16x16x32_bf16(qa[1], cb[1], z4, 0, 0, 0);
            f32x4 da = __builtin_amdgcn_mfma_f32_16x16x32_bf16(qd[0], cd[0], z4, 0, 0, 0);
            f32x4 ia = __builtin_amdgcn_mfma_f32_16x16x32_bf16(pa[0], vb[0], z4, 0, 0, 0);
            const f32x4 dia = __builtin_amdgcn_mfma_f32_16x16x32_bf16(pd, vd, z4, 0, 0, 0);
#pragma unroll
            for (int j = 1; j < 4; ++j) {
                a0 = __builtin_amdgcn_mfma_f32_16x16x32_bf16(qa[2 * j], cb[2 * j], a0, 0, 0, 0);
                a1 = __builtin_amdgcn_mfma_f32_16x16x32_bf16(qa[2 * j + 1], cb[2 * j + 1], a1, 0, 0, 0);
                da = __builtin_amdgcn_mfma_f32_16x16x32_bf16(qd[j], cd[j], da, 0, 0, 0); }
            ia = __builtin_amdgcn_mfma_f32_16x16x32_bf16(pa[1], vb[1], ia, 0, 0, 0);
            const f32x4 a = a0 + a1;
            nacc = a * cs4 + ia * rs4;
            const f32x4 dacc = da * cs4 + dia * rs4;
            if (fr == 0) *(LAS f32x4*)(L + O_DEN + et * 256 + (16 * tt + 4 * fq) * 4) = dacc;
        }
        prefetch_b(st2, RA);
        {
            LAS unsigned char* CSn = L + O_CS + (cur ^ 1) * CS_BYTES;
#pragma unroll
            for (int a = 0; a < 2; ++a)
#pragma unroll
                for (int c = 0; c < 3; ++c) Cacc[a][c] = Cacc[a][c] * c_decay;
#pragma unroll
            for (int ks = 0; ks < 2; ++ks) {
                bf16x8 ka[2], vb[3];
#pragma unroll
                for (int a = 0; a < 2; ++a) { const LAS unsigned char* p = L + O_KS + (32 * ks + 8 * trg + trq) * QP + (16 * (2 * w + a) + 4 * trp) * 2; ka[a] = tr_frag(p, p + 4 * QP); }
#pragma unroll
                for (int c = 0; c < 3; ++c) { const LAS unsigned char* p = L + O_VW + (32 * ks + 8 * trg + trq) * VP + (16 * c + 4 * trp) * 2; vb[c] = tr_frag(p, p + 4 * VP); }
#pragma unroll
                for (int a = 0; a < 2; ++a)
#pragma unroll
                    for (int c = 0; c < 3; ++c) Cacc[a][c] = __builtin_amdgcn_mfma_f32_16x16x32_bf16(ka[a], vb[c], Cacc[a][c], 0, 0, 0);
            }
#pragma unroll
            for (int a = 0; a < 2; ++a)
#pragma unroll
                for (int c = 0; c < 3; ++c) { u32x2 o; o.x = cvt_pk_bf16(Cacc[a][c][0], Cacc[a][c][1]); o.y = cvt_pk_bf16(Cacc[a][c][2], Cacc[a][c][3]);
                    *(LAS u32x2*)(CSn + (16 * c + fr) * QP + (16 * (2 * w + a) + 4 * fq) * 2) = o; }
        }
        prefetch_c(st2, RA);
        if (has_next) scalars(RB, cur ^ 1);
        LDS_BAR();
        {
            const f32x4 den4 = *(const LAS f32x4*)(L + O_DEN + (16 * tt + 4 * fq) * 4) + *(const LAS f32x4*)(L + O_DEN + 256 + (16 * tt + 4 * fq) * 4), em4 = *(const LAS f32x4*)(SC + 192 + 16 * tt + 4 * fq);
#pragma unroll
            for (int i = 0; i < 4; ++i) { const int p = 16 * tt + 4 * fq + i;
                const float h = nacc[i] * __builtin_amdgcn_rcpf(fmaxf(fabsf(den4[i]), em4[i]));
                const float og = bf2f(*(const LAS bf16_t*)(L + O_OS + cur * OS_BYTES + p * OP + (16 * et + fr) * 2));
                *(LAS bf16_t*)(L + O_OUT + p * OP + (16 * et + fr) * 2) = (bf16_t)f2bf(sigmoidf_(og) * h); }
        }
        if (has_next) commit(cur ^ 1, RB);
        cur ^= 1;
        LDS_BAR();
    };
    for (int st = 0; st < 132; st += 2) { step(st, R0, R1); step(st + 1, R1, R0); }
    flush_out(131);
    __syncthreads();
#undef LDS_BAR
}

__device__ __forceinline__ void hyena_item(Frame& F, const Inputs& I, int c) {
    LAS f32x2* X = (LAS f32x2*)F.lds;
    int tid = F.tid; asm volatile("" : "+v"(tid));
    const bf16_t* s0 = WSP(bf16_t, WS_SCM) + (size_t)c * SEQ; const bf16_t* s1 = s0 + (size_t)1024 * SEQ;
    const f32x2* fs = WSP(f32x2, WS_FSPEC) + (size_t)c * FS_PITCH;
    bf16_t* y0 = WSP(bf16_t, WS_H) + (size_t)c * SEQ; bf16_t* y1 = y0 + (size_t)1024 * SEQ;
    unsigned skeep[16];
    {
        f32x2 v[32];
#pragma unroll
        for (int r = 0; r < 16; ++r) { const int t = tid + 512 * r; const unsigned a = s0[t], bq = s1[t]; skeep[r] = a | (bq << 16); v[r] = (f32x2){bf2f((unsigned short)a), bf2f((unsigned short)bq)}; }
#pragma unroll
        for (int r = 16; r < 32; ++r) v[r] = (f32x2){0.f, 0.f};
        __syncthreads();
        fft_pass_a_store(v, X, tid);
    }
    __syncthreads();
    fft_pass_b(X, tid);
    __syncthreads();
    {
        f32x2 v[32]; fft_pass_c_compute(v, X, tid);
        asm volatile("" ::: "memory"); __builtin_amdgcn_sched_barrier(0);
#pragma unroll
        for (int u = 0; u < 2; ++u)
#pragma unroll
            for (int p = 0; p < 16; ++p) { const int idx = tid + 512 * u + 1024 * bitrev(p, 4);
                f32x2 f = idx <= 8192 ? fs[idx] : fs[FFT_N - idx]; if (idx > 8192) f.y = -f.y;
                const f32x2 y = cmul(v[16 * u + p], f); v[16 * u + p] = (f32x2){y.x, -y.y}; }
        __syncthreads();
#pragma unroll
        for (int u = 0; u < 2; ++u) { int jj = tid + 512 * u; asm volatile("" : "+v"(jj)); LAS f32x2* xb = X + jj + (jj >> 5);
#pragma unroll
            for (int p = 0; p < 16; ++p) xb[1056 * bitrev(p, 4)] = v[16 * u + p]; }
    }
    __syncthreads();
    {   f32x2 v[32]; fft_load32(v, X, tid); __syncthreads(); fft_pass_a_store(v, X, tid); }
    __syncthreads();
    fft_pass_b(X, tid);
    __syncthreads();
    {   f32x2 v[32]; fft_pass_c_compute(v, X, tid);
        asm volatile("" ::: "memory"); __builtin_amdgcn_sched_barrier(0);
        const float hb = I.h_bias[c];
#pragma unroll
        for (int u = 0; u < 2; ++u)
#pragma unroll
            for (int p = 0; p < 16; ++p) { const int q = bitrev(p, 4);
                if (q < 8) { const int idx = tid + 512 * u + 1024 * q; const unsigned sk = skeep[u + 2 * q];
                    const float o0 = v[16 * u + p].x + hb * bflo(sk), o1 = -v[16 * u + p].y + hb * bfhi(sk);
                    y0[idx] = (bf16_t)f2bf(o0); y1[idx] = (bf16_t)f2bf(o1); } }
    }
    __syncthreads();
}
__device__ __forceinline__ void hy_item(Frame& F, const Inputs& I, int tb, int chb) {
    bf16_t* Z = WSP(bf16_t, WS_Z); const bf16_t* YCM = WSP(bf16_t, WS_H);
    constexpr int PITCH = 144;
    LAS unsigned char* X0T = F.lds; LAS unsigned char* YT = F.lds + 64 * PITCH;
    const int b = tb >> 7, t0 = (tb & 127) * 64;
    LAS float* HW = (LAS float*)(F.lds + 2 * 64 * PITCH);
    {   const int r = F.tid >> 3, cc = F.tid & 7;
        *(LAS u32x4*)(X0T + r * PITCH + cc * 16) = *(const u32x4*)(Z + (size_t)(tb * 64 + r) * ZC + ZC_X0 + chb * 64 + 8 * cc);
        *(LAS u32x4*)(YT + r * PITCH + cc * 16) = *(const u32x4*)(YCM + ((size_t)(b * 1024 + chb * 64 + r)) * SEQ + t0 + 8 * cc);
        if (F.tid < 256) { const int pp = F.tid >> 6, pc = chb * 64 + (F.tid & 63); HW[F.tid] = pp < 3 ? I.w_h_conv[pp * 3072 + pc] : I.b_h_conv[pc]; } }
    __syncthreads();
    {   const int r = F.tid >> 3, cc = F.tid & 7;
        const u32x4 z = {0u, 0u, 0u, 0u};
        const u32x4 c1 = *(const LAS u32x4*)(X0T + r * PITCH + cc * 16);
        const u32x4 c0 = r > 0 ? *(const LAS u32x4*)(X0T + (r - 1) * PITCH + cc * 16) : z;
        const u32x4 c2 = r < 63 ? *(const LAS u32x4*)(X0T + (r + 1) * PITCH + cc * 16) : z;
        float o[8];
        const LAS f32x4* hw = (const LAS f32x4*)(HW + 8 * cc);
        const f32x4 w0a = hw[0], w0b = hw[1], w1a = hw[16], w1b = hw[17], w2a = hw[32], w2b = hw[33], bba = hw[48], bbb = hw[49];
#pragma unroll
        for (int e = 0; e < 8; ++e) { const int h = e >> 1;
            const float a0 = (e & 1) ? bfhi(c0[h]) : bflo(c0[h]), a1 = (e & 1) ? bfhi(c1[h]) : bflo(c1[h]), a2 = (e & 1) ? bfhi(c2[h]) : bflo(c2[h]);
            const float k0 = e < 4 ? w0a[e & 3] : w0b[e & 3], k1 = e < 4 ? w1a[e & 3] : w1b[e & 3], k2 = e < 4 ? w2a[e & 3] : w2b[e & 3], kb = e < 4 ? bba[e & 3] : bbb[e & 3];
            const float x0 = k0 * a0 + k1 * a1 + k2 * a2 + kb;
            o[e] = x0 * bf2f(*(const LAS bf16_t*)(YT + (8 * cc + e) * PITCH + r * 2)); }
        u32x4 ov; ov.x = pk2(o[0], o[1]); ov.y = pk2(o[2], o[3]); ov.z = pk2(o[4], o[5]); ov.w = pk2(o[6], o[7]);
        *(u32x4*)(Z + (size_t)(tb * 64 + r) * ZC + ZC_X0 + chb * 64 + 8 * cc) = ov; }
    __syncthreads();
}

__device__ __forceinline__ void phase2b(Frame& F, const Inputs& I) {
    const int GA = F.G >= 2 ? F.G / 2 : 1, GB = F.G - GA;
    unsigned* sub = WSP(unsigned, WS_CTL) + CW_SUB;
    if (F.vcu < GA) { for (int it = F.vcu; it < 128; it += GA) mlstm_item(F, I, it); __syncthreads(); }
    if (GB == 0 || F.vcu >= GA) {
        const int c0 = GB ? F.vcu - GA : 0, cs = GB ? GB : 1;
        const int cpw = (1024 / 2 + cs - 1) / cs * 2, cb = c0 * cpw, ce = cb + cpw < 1024 ? cb + cpw : 1024;
        fft_twiddle_init(F.lds, F.tid);
        __syncthreads();
        for (int c = cb; c < ce; c += 2) filter_spec_item(F, I, c >> 1);
        for (int c = cb; c < ce; ++c) hyena_item(F, I, c);
        subgrid_barrier(sub, (unsigned)cs, 1u);
        for (int it = c0; it < 4096; it += cs) hy_item(F, I, it >> 4, it & 15);
        subgrid_barrier(sub, (unsigned)cs, 2u);
    } else {
        if (F.tid == 0) { unsigned sp = 0; while (xb_ld(sub) < 2u * (unsigned)GB) { __builtin_amdgcn_s_sleep(4); if (++sp > (1u << 22)) break; }
            __builtin_amdgcn_fence(__ATOMIC_ACQUIRE, "agent"); asm volatile("s_waitcnt vmcnt(0)" ::: "memory"); }
        __syncthreads();
    }
    {
        bf16_t* Z = WSP(bf16_t, WS_Z);
        pg8::Gemm g{Z + ZC_X0, WSP(bf16_t, WS_WB_T), ZC, D, D};
        pg8::StaticOrder S; S.init(64, 4, F.G, (int)blockIdx.x, 256L * ZC * 2, 256L * D * 2);
        EpiMerge<false> E{Z + ZC_GB, WSP(bf16_t, WS_FSPEC), nullptr};
        pg8::gemm_phase<EpiMerge<false>, pg8::StaticOrder, false>(F.lds, g, S, E);
    }
}
struct XtItem { const float* W; int N, k0, n0; bf16_t* WT; int ldt, drow0; };
__device__ __forceinline__ XtItem xt_decode(const Inputs& I, bf16_t* W13T, bf16_t* W2T, int it) {
    constexpr int PER_E = 3 * 256;
    const int e = it / PER_E, r = it % PER_E, m = r >> 8, rr = r & 255; XtItem x;
    if (m < 2) { const int kb = rr >> 4, nb = rr & 15, n0 = 32 * nb;
        x.W = (m == 0 ? I.w1_e : I.w3_e) + (size_t)e * D * DEXP; x.N = DEXP; x.k0 = 64 * kb; x.n0 = n0; x.WT = W13T + (size_t)e * 1024 * 1024; x.ldt = D; x.drow0 = (n0 >> 7) * 256 + m * 128 + (n0 & 127); }
    else { const int kb = rr >> 5, nb = rr & 31;
        x.W = I.w2_e + (size_t)e * DEXP * D; x.N = D; x.k0 = 64 * kb; x.n0 = 32 * nb; x.WT = W2T + (size_t)e * 1024 * DEXP; x.ldt = DEXP; x.drow0 = 32 * nb; }
    return x;
}
__device__ __forceinline__ void xt_load(const XtItem& x, float (&v)[32], int lane) {
    const float* p = x.W + (size_t)(x.k0 + (lane >> 5)) * x.N + x.n0 + (lane & 31);
#pragma unroll
    for (int i = 0; i < 32; ++i) v[i] = p[(size_t)(2 * i) * x.N];
}
__device__ __forceinline__ void xt_finish(const XtItem& x, const float (&v)[32], LAS float* scr, int lane) {
#pragma unroll
    for (int i = 0; i < 32; ++i) scr[(2 * i + (lane >> 5)) * 33 + (lane & 31)] = v[i];
    asm volatile("s_waitcnt lgkmcnt(0)" ::: "memory");
    const int c = lane & 7;
#pragma unroll
    for (int j = 0; j < 4; ++j) { const int n = (lane >> 3) + 8 * j; const LAS float* s = scr + (8 * c) * 33 + n;
        u32x4 o; o.x = pk2(s[0 * 33], s[1 * 33]); o.y = pk2(s[2 * 33], s[3 * 33]); o.z = pk2(s[4 * 33], s[5 * 33]); o.w = pk2(s[6 * 33], s[7 * 33]);
        *(u32x4*)(x.WT + (size_t)(x.drow0 + n) * x.ldt + x.k0 + 8 * c) = o; }
    asm volatile("s_waitcnt lgkmcnt(0)" ::: "memory");
}
__device__ __forceinline__ void expert_transposes(Frame& F, const Inputs& I, int part, int nparts, int wg, int nwg) {
    LAS float* scr = (LAS float*)(F.lds + F.wave * 16384);
    const int gw = wg * 8 + F.wave, NGW = nwg * 8;
    constexpr int NIT = NEXP * 3 * 256;
    const int lo = (int)((long)NIT * part / nparts), hi = (int)((long)NIT * (part + 1) / nparts);
    bf16_t* W13T = WSP(bf16_t, WS_W13T); bf16_t* W2T = WSP(bf16_t, WS_W2T);
    int it = lo + gw; if (it >= hi) return;
    float va[32], vb[32];
    XtItem xa = xt_decode(I, W13T, W2T, it), xb = xa;
    xt_load(xa, va, F.lane);
    for (;;) {
        const bool nb = it + NGW < hi;
        if (nb) { xb = xt_decode(I, W13T, W2T, it + NGW); xt_load(xb, vb, F.lane); }
        xt_finish(xa, va, scr, F.lane);
        if (!nb) break;
        it += NGW;
        const bool na = it + NGW < hi;
        if (na) { xa = xt_decode(I, W13T, W2T, it + NGW); xt_load(xa, va, F.lane); }
        xt_finish(xb, vb, scr, F.lane);
        if (!na) break;
        it += NGW;
    }
}

struct Route { int e0, e1; float w0, w1; };
__device__ __forceinline__ void route_item(Frame& F, const Inputs& I, const float* x1, int blk) {
    constexpr int RP = 528;
    constexpr int O_AH = 0, O_AL = 33792, O_BH = 67584, O_BL = 109824, O_SSQ = 152064, O_LC = 152320;
    LAS unsigned char* L = F.lds;
    const int tid = F.tid, lane = F.lane, w = F.wave, fr = lane & 15, fq = lane >> 4;
    const int row0 = blk * 64, b = row0 / SEQ;
    const float* mods = WSP(float, WS_MODS) + b * 6144;
    const bf16_t* w72s = WSP(bf16_t, WS_W72S);
    f32x4 acc[3];
#pragma unroll
    for (int t = 0; t < 3; ++t) acc[t] = (f32x4){0.f, 0.f, 0.f, 0.f};
    const int sr = tid >> 3, seg = tid & 7;
    float ssq = 0.f;
    if (tid < 64) *(LAS int*)(L + O_LC + 4 * tid) = 0;
    for (int kt = 0; kt < 4; ++kt) {
#pragma unroll
        for (int i = 0; i < 8; ++i) { const int kk = 32 * i + 4 * seg, k = kt * 256 + kk;
            const f32x4 xv = *(const f32x4*)(x1 + (size_t)(row0 + sr) * D + k);
            ssq += (xv.x * xv.x + xv.y * xv.y) + (xv.z * xv.z + xv.w * xv.w);
            const f32x4 g = *(const f32x4*)(I.g_norm2 + k), sc = *(const f32x4*)(mods + 4 * 1024 + k);
            const f32x4 hv = xv * g * (sc + 1.0f);
            const unsigned h0 = f2bf(hv.x), h1 = f2bf(hv.y), h2 = f2bf(hv.z), h3 = f2bf(hv.w);
            const u32x2 hi = {h0 | (h1 << 16), h2 | (h3 << 16)};
            const u32x2 lo = {pk2(hv.x - bf2f((unsigned short)h0), hv.y - bf2f((unsigned short)h1)), pk2(hv.z - bf2f((unsigned short)h2), hv.w - bf2f((unsigned short)h3))};
            *(LAS u32x2*)(L + O_AH + sr * RP + kk * 2) = hi; *(LAS u32x2*)(L + O_AL + sr * RP + kk * 2) = lo; }
#pragma unroll
        for (int j = 0; j < 10; ++j) { const int id = tid + 512 * j, which = id / 2560, rem = id % 2560, col = rem >> 5, c16 = rem & 31;
            *(LAS u32x4*)(L + (which ? O_BL : O_BH) + col * RP + c16 * 16) = *(const u32x4*)(w72s + (size_t)(col * 2 + which) * 1024 + kt * 256 + c16 * 8); }
        __syncthreads();
#pragma unroll
        for (int ti = 0; ti < 3; ++ti) { const int T = w + 8 * ti;
            if (T < 20) { const int rt = T & 3, ct = T >> 2;
#pragma unroll
                for (int k8 = 0; k8 < 8; ++k8) {
                    const bf16x8 ah = *(const LAS bf16x8*)(L + O_AH + (16 * rt + fr) * RP + (32 * k8 + 8 * fq) * 2), al = *(const LAS bf16x8*)(L + O_AL + (16 * rt + fr) * RP + (32 * k8 + 8 * fq) * 2);
                    const bf16x8 bh = *(const LAS bf16x8*)(L + O_BH + (16 * ct + fr) * RP + (32 * k8 + 8 * fq) * 2), bl = *(const LAS bf16x8*)(L + O_BL + (16 * ct + fr) * RP + (32 * k8 + 8 * fq) * 2);
                    acc[ti] = __builtin_amdgcn_mfma_f32_16x16x32_bf16(ah, bh, acc[ti], 0, 0, 0);
                    acc[ti] = __builtin_amdgcn_mfma_f32_16x16x32_bf16(al, bh, acc[ti], 0, 0, 0);
                    acc[ti] = __builtin_amdgcn_mfma_f32_16x16x32_bf16(ah, bl, acc[ti], 0, 0, 0);
                } } }
        __syncthreads();
    }
    ssq += __shfl_xor(ssq, 1); ssq += __shfl_xor(ssq, 2); ssq += __shfl_xor(ssq, 4);
    if (seg == 0) *(LAS float*)(L + O_SSQ + 4 * sr) = ssq;
    LAS float* LOG = (LAS float*)L;
#pragma unroll
    for (int ti = 0; ti < 3; ++ti) { const int T = w + 8 * ti;
        if (T < 20) { const int rt = T & 3, ct = T >> 2;
#pragma unroll
            for (int i = 0; i < 4; ++i) LOG[(16 * rt + 4 * fq + i) * 81 + 16 * ct + fr] = acc[ti][i]; } }
    __syncthreads();
    if (w == 0) {
        const float rstd = 1.0f / sqrtf(*(const LAS float*)(L + O_SSQ + 4 * lane) * (1.0f / D) + EPS);
        const float* cst = WSP(float, WS_CST) + b * 72;
        float lg[72];
#pragma unroll
        for (int j = 0; j < 72; ++j) lg[j] = rstd * LOG[lane * 81 + j] + cst[j];
        int gsel = 0; float gmax = lg[0];
#pragma unroll
        for (int j = 1; j < 8; ++j) if (lg[j] > gmax) { gmax = lg[j]; gsel = j; }
        float gs = 0.f;
#pragma unroll
        for (int j = 0; j < 8; ++j) gs += __expf(lg[j] - gmax);
        const float gwt = 1.0f / gs;
        float el[8];
#pragma unroll
        for (int j = 0; j < 8; ++j) { float v = lg[8 + j];
#pragma unroll
            for (int gI = 1; gI < 8; ++gI) v = gsel == gI ? lg[8 + 8 * gI + j] : v;
            el[j] = v; }
        int i0 = 0; float v0 = el[0];
#pragma unroll
        for (int j = 1; j < 8; ++j) if (el[j] > v0) { v0 = el[j]; i0 = j; }
        int i1 = -1; float v1 = -3.0e38f;
#pragma unroll
        for (int j = 0; j < 8; ++j) if (j != i0 && el[j] > v1) { v1 = el[j]; i1 = j; }
        const float p1 = __expf(v1 - v0), inv = 1.0f / (1.0f + p1);
        const int e0 = gsel * 8 + i0, e1 = gsel * 8 + i1;
        const int r0 = __hip_atomic_fetch_add((LAS int*)(L + O_LC) + e0, 1, __ATOMIC_RELAXED, __HIP_MEMORY_SCOPE_WORKGROUP);
        const int r1 = __hip_atomic_fetch_add((LAS int*)(L + O_LC) + e1, 1, __ATOMIC_RELAXED, __HIP_MEMORY_SCOPE_WORKGROUP);
        Route r; r.e0 = e0 | (r0 << 8); r.e1 = e1 | (r1 << 8); r.w0 = gwt * inv; r.w1 = gwt * p1 * inv;
        WSP(Route, WS_ROUTE)[row0 + lane] = r;
        WSP(float, WS_RSTD2)[row0 + lane] = rstd;
    }
    __syncthreads();
    if (tid < 64) WSP(int, WS_BLKCNT)[blk * 64 + tid] = *(const LAS int*)(L + O_LC + 4 * tid);
    __syncthreads();
}
__device__ __forceinline__ int moe_tables(Frame& F, LAS int* seg_start, LAS int* tile_e) {
    const unsigned* cnt = WSP(unsigned, WS_CTL) + CW_CNT;
    if (F.tid < 64) seg_start[96 + F.tid] = (int)__hip_atomic_load(cnt + F.tid, RLX_AGENT);
    __syncthreads();
    if (F.tid < 64) { int s = 0; for (int e = 0; e < F.tid; ++e) s += (seg_start[96 + e] + 255) >> 8; seg_start[F.tid] = s * 256; }
    __syncthreads();
    if (F.tid < 64) { const int t0 = seg_start[F.tid] >> 8, nt = (seg_start[96 + F.tid] + 255) >> 8; for (int t = 0; t < nt; ++t) tile_e[t0 + t] = F.tid; if (F.tid == 63) seg_start[64] = (t0 + nt) * 256; }
    __syncthreads();
    return seg_start[64] >> 8;
}
__device__ __forceinline__ void phase4b(Frame& F, const Inputs& I, const float* x1) {
    LAS int* PART = (LAS int*)F.lds;
    LAS int* TOT = PART + 1024;
    LAS int* BEF = TOT + 64;
    LAS int* SEG = BEF + 64;
    const int* blkcnt = WSP(int, WS_BLKCNT);
    bf16_t* XS = WSP(bf16_t, WS_XS);
    for (int blk = F.vcu; blk < M_LAT / 64; blk += F.G) {
        {   const int e = F.tid & 63, part = F.tid >> 6; int sa = 0, sb = 0;
#pragma unroll 8
            for (int i = 0; i < 32; ++i) { const int bb = 32 * part + i; const int c = blkcnt[bb * 64 + e]; sa += c; sb += bb < blk ? c : 0; }
            PART[(part * 64 + e) * 2] = sa; PART[(part * 64 + e) * 2 + 1] = sb; }
        __syncthreads();
        if (F.tid < 64) { int ta = 0, tb = 0;
#pragma unroll
            for (int p = 0; p < 8; ++p) { ta += PART[(p * 64 + F.tid) * 2]; tb += PART[(p * 64 + F.tid) * 2 + 1]; }
            TOT[F.tid] = ta; BEF[F.tid] = tb;
            if (blk == 0) WSP(unsigned, WS_CTL)[CW_CNT + F.tid] = (unsigned)ta; }
        __syncthreads();
        if (F.tid == 0) { int run = 0; for (int e = 0; e < 64; ++e) { SEG[e] = run * 256; run += (TOT[e] + 255) >> 8; } SEG[64] = run * 256; }
        __syncthreads();
#pragma unroll 1
        for (int i = 0; i < 8; ++i) {
            const int row = blk * 64 + F.wave * 8 + i;
            const Route r = WSP(Route, WS_ROUTE)[row];
            const int e0 = r.e0 & 255, e1 = r.e1 & 255;
            const int sl0 = SEG[e0] + BEF[e0] + (r.e0 >> 8), sl1 = SEG[e1] + BEF[e1] + (r.e1 >> 8);
            if (F.lane == 0) { WSP(int, WS_TOKSLOT)[2 * row] = sl0; WSP(int, WS_TOKSLOT)[2 * row + 1] = sl1; }
            const float rstd = WSP(float, WS_RSTD2)[row];
            const float* md = WSP(float, WS_MODS) + (row / SEQ) * 6144;
            const f32x4* xr = (const f32x4*)(x1 + (size_t)row * D) + F.lane;
            u32x2* o0 = (u32x2*)(XS + (size_t)sl0 * D) + F.lane; u32x2* o1 = (u32x2*)(XS + (size_t)sl1 * D) + F.lane;
#pragma unroll
            for (int j = 0; j < 4; ++j) { const int k = 4 * F.lane + 256 * j; const f32x4 xv = xr[64 * j];
                const f32x4 g = *(const f32x4*)(I.g_norm2 + k), sh = *(const f32x4*)(md + 3 * 1024 + k), sc = *(const f32x4*)(md + 4 * 1024 + k);
                const f32x4 h = xv * rstd * g * (sc + 1.0f) + sh;
                const u32x2 o = {pk2(h.x, h.y), pk2(h.z, h.w)}; o0[64 * j] = o; o1[64 * j] = o; }
        }
        __syncthreads();
    }
}
__device__ __forceinline__ void phase6(Frame& F, const Inputs& I, float* out) {
    const int gw = F.vcu * 8 + F.wave, NGW = F.G * 8;
    const bf16_t* Y = WSP(bf16_t, WS_XS);
    for (int row = gw; row < M_LAT; row += NGW) {
        const Route r = WSP(Route, WS_ROUTE)[row];
        const int sl0 = WSP(int, WS_TOKSLOT)[2 * row], sl1 = WSP(int, WS_TOKSLOT)[2 * row + 1];
        const float* md = WSP(float, WS_MODS) + (row / SEQ) * 6144 + 5 * 1024;
        f32x4* xr = (f32x4*)(out + (size_t)row * D) + F.lane;
        const u32x2* y0 = (const u32x2*)(Y + (size_t)sl0 * D) + F.lane; const u32x2* y1 = (const u32x2*)(Y + (size_t)sl1 * D) + F.lane;
        f32x4 v[4]; float s = 0.f;
#pragma unroll
        for (int j = 0; j < 4; ++j) { const int k = 4 * F.lane + 256 * j; const u32x2 a = y0[64 * j], bq = y1[64 * j];
            const f32x4 ya = {bflo(a.x), bfhi(a.x), bflo(a.y), bfhi(a.y)}, yb = {bflo(bq.x), bfhi(bq.x), bflo(bq.y), bfhi(bq.y)};
            const f32x4 moe = ya * r.w0 + yb * r.w1;
            v[j] = xr[64 * j] + *(const f32x4*)(md + k) * moe;
            s += (v[j].x * v[j].x + v[j].y * v[j].y) + (v[j].z * v[j].z + v[j].w * v[j].w); }
        const float rstd = 1.0f / sqrtf(wave_sum(s) * (1.0f / D) + EPS);
#pragma unroll
        for (int j = 0; j < 4; ++j) { const int k = 4 * F.lane + 256 * j; xr[64 * j] = v[j] * rstd * *(const f32x4*)(I.g_final + k); }
    }
}

#ifndef MK_PER_PHASE
#define MK_PER_PHASE 0
#endif
constexpr int N_PHASES = 12;
constexpr int TAB_OFF = 150 * 1024;

__global__ void __launch_bounds__(512, 2) fwd_kernel(Args args) {
    extern __shared__ __attribute__((aligned(16))) unsigned char lds_raw[];
    Frame F;
    F.lds = (LAS unsigned char*)lds_raw;
    F.tid = threadIdx.x; F.lane = F.tid & 63; F.wave = __builtin_amdgcn_readfirstlane(F.tid >> 6);
    F.G = gridDim.x; { const int bx = blockIdx.x; F.vcu = (F.G % 8 == 0) ? (bx % 8) * (F.G / 8) + bx / 8 : bx; }
    F.ws = args.ws;
    const Inputs& I = args.in;
    volatile LAS unsigned* MISC = (volatile LAS unsigned*)(F.lds + MISC_OFF);
    if (F.tid < 32) MISC[F.tid] = 0u;
    __syncthreads();
    XcdBarrier bar; bar.bar = WSP(unsigned, WS_CTL) + CW_BAR; bar.x = 0; bar.st = nullptr;
#if !MK_PER_PHASE
    bar = xcd_barrier_post(WSP(unsigned, WS_CTL) + CW_BAR, MISC + 8);
#define GRID_BAR() xcd_barrier(bar)
#else
#define GRID_BAR() do {} while (0)
#endif
    const int lo = args.ph_lo, hi = args.ph_hi;
#ifndef PH_MASK
#define PH_MASK 0xffff
#endif
#define IN(k) (((PH_MASK >> (k)) & 1) && lo <= (k) && (k) < hi)
#define SEAM(k) do { if (IN(k) && IN((k) + 1)) GRID_BAR(); } while (0)
    bf16_t* Z = WSP(bf16_t, WS_Z);
    float* x1 = args.out;

    if (IN(0)) { phase0(F, I); } SEAM(0);
    if (IN(1)) {
        phase0b(F, I);
        __syncthreads();
        pg8::Gemm g{WSP(bf16_t, WS_W3S), WSP(bf16_t, WS_HID2), 256, 256, 256};
        pg8::StaticOrder S; S.init(8, 32, F.G, (int)blockIdx.x, 256L * 256 * 2, 256L * 256 * 2);
        EpiFilt E{WSP(_Float16, WS_FILT)};
        pg8::gemm_phase<EpiFilt, pg8::StaticOrder, false>(F.lds, g, S, E);
        __syncthreads();
        weight_transposes(F, I, 0, F.vcu, F.G);
    } SEAM(1);
    if (IN(2)) {
        pg8::Gemm g{WSP(bf16_t, WS_H), WSP(bf16_t, WS_WIN_T), D, D, D};
        InOrder S; S.so.init(64, 37, F.G, (int)blockIdx.x, 256L * D * 2, 256L * D * 2); S.G = F.G; S.c = (int)blockIdx.x;
        EpiIn E{Z, WSP(float, WS_BIASP), WSP(float, WS_GATES)};
        pg8::gemm_phase<EpiIn, InOrder, true>(F.lds, g, S, E);
        const int nfull = (64 * 37 + 26) % F.G, nlight = F.G - nfull;
        __syncthreads();
        if (nfull == 0) weight_transposes(F, I, 1, (int)blockIdx.x, F.G);
        else if ((int)blockIdx.x >= nfull) weight_transposes(F, I, 1, (int)blockIdx.x - nfull, nlight);
    } SEAM(2);
    if (IN(3)) { phase2a(F, I); } SEAM(3);
    if (IN(4)) { phase2b(F, I); } SEAM(4);
    if (IN(5)) {
        pg8::Gemm g{Z + ZC_PAIR, WSP(bf16_t, WS_WA2_T), ZC, 2 * D, 2 * D};
        pg8::StaticOrder S; S.init(64, 4, F.G, (int)blockIdx.x, 256L * ZC * 2, 256L * 2 * D * 2);
        EpiMerge<true> E{Z + ZC_GA, WSP(bf16_t, WS_FSPEC), WSP(bf16_t, WS_H)};
        pg8::gemm_phase<EpiMerge<true>, pg8::StaticOrder, false>(F.lds, g, S, E);
    } SEAM(5);
    if (IN(6)) {
        pg8::Gemm g{WSP(bf16_t, WS_H), WSP(bf16_t, WS_WOUT_T), D, D, D};
        pg8::StaticOrder S; S.init(64, 4, F.G, (int)blockIdx.x, 256L * D * 2, 256L * D * 2);
        EpiRes E{I.x, WSP(float, WS_MODS), x1};
        pg8::gemm_phase<EpiRes, pg8::StaticOrder, false>(F.lds, g, S, E);
        __syncthreads();
        expert_transposes(F, I, 0, 2, F.vcu, F.G);
    } SEAM(6);
    if (IN(7)) {
        for (int blk = F.vcu; blk < M_LAT / 64; blk += F.G) route_item(F, I, x1, blk);
        __syncthreads();
        expert_transposes(F, I, 1, 2, F.vcu, F.G);
    } SEAM(7);
    if (IN(8)) { phase4b(F, I, x1); } SEAM(8);
    if (IN(9)) {
        LAS int* seg_start = (LAS int*)(F.lds + TAB_OFF); LAS int* tile_e = seg_start + 192;
        const int ntiles = moe_tables(F, seg_start, tile_e);
        pg8::Gemm g{WSP(bf16_t, WS_XS), WSP(bf16_t, WS_W13T), D, D, D};
        MoeOrder S{tile_e, ntiles, F.G, F.vcu, 256L * D * 2, 256L * D * 2, 1024L * D * 2};
        EpiMoe1 E{WSP(bf16_t, WS_FSPEC)};
        pg8::gemm_phase<EpiMoe1, MoeOrder, true>(F.lds, g, S, E);
    } SEAM(9);
    if (IN(10)) {
        LAS int* seg_start = (LAS int*)(F.lds + TAB_OFF); LAS int* tile_e = seg_start + 192;
        const int ntiles = moe_tables(F, seg_start, tile_e);
        pg8::Gemm g{WSP(bf16_t, WS_FSPEC), WSP(bf16_t, WS_W2T), DEXP, DEXP, DEXP};
        MoeOrder S{tile_e, ntiles, F.G, F.vcu, 256L * DEXP * 2, 256L * DEXP * 2, 1024L * DEXP * 2};
        EpiBf E{WSP(bf16_t, WS_XS), D};
        pg8::gemm_phase<EpiBf, MoeOrder, true>(F.lds, g, S, E);
    } SEAM(10);
    if (IN(11)) { phase6(F, I, x1); }
#undef IN
#undef SEAM
}

extern "C" void kernel_launch(void* const* d_in, const int* in_sizes, int n_in, void* d_out, int out_size, void* d_ws, size_t ws_size, hipStream_t stream) {
    static int grid = 0;
    if (grid == 0) {
        if (n_in != 32 || in_sizes[0] != M_LAT * D || out_size != M_LAT * D || ws_size < WS_END) {
            fprintf(stderr, "kernel_launch: unexpected problem (n_in %d, in0 %d, out %d, ws %zu < %zu?)\n", n_in, n_in > 0 ? in_sizes[0] : -1, out_size, ws_size, (size_t)WS_END); grid = -1; return; }
        int dev = 0, cus = 0, per_cu = 0;
        if (hipGetDevice(&dev) != hipSuccess || hipDeviceGetAttribute(&cus, hipDeviceAttributeMultiprocessorCount, dev) != hipSuccess) { grid = -1; return; }
        if (hipFuncSetAttribute((const void*)fwd_kernel, hipFuncAttributeMaxDynamicSharedMemorySize, LDS_BYTES) != hipSuccess) { fprintf(stderr, "kernel_launch: hipFuncSetAttribute failed\n"); grid = -1; return; }
        if (hipOccupancyMaxActiveBlocksPerMultiprocessor(&per_cu, (const void*)fwd_kernel, 512, LDS_BYTES) != hipSuccess || per_cu < 1) { fprintf(stderr, "kernel_launch: occupancy query says %d\n", per_cu); per_cu = 1; }
        (void)hipGetLastError();
        grid = cus;
    }
    if (grid < 0) return;
    (void)hipMemsetAsync((char*)d_ws + WS_CTL, 0, CTL_ZERO_BYTES, stream);
    Args a{};
    const float** ip = (const float**)&a.in;
    for (int i = 0; i < 32; ++i) ip[i] = (const float*)d_in[i];
    a.out = (float*)d_out; a.ws = (unsigned char*)d_ws;
#if MK_PER_PHASE
    for (int p = 0; p < N_PHASES; ++p) { a.ph_lo = p; a.ph_hi = p + 1; hipLaunchKernelGGL(fwd_kernel, dim3(grid), dim3(512), LDS_BYTES, stream, a); }
#else
    a.ph_lo = 0; a.ph_hi = N_PHASES;
    hipLaunchKernelGGL(fwd_kernel, dim3(grid), dim3(512), LDS_BYTES, stream, a);
#endif
}
```
